# Optimizing an MI355X kernel written in HIP

```python
import jax, jax.numpy as jnp
from jax import lax
import numpy as np

D_MODEL = 1024
BATCH = 8
SEQ = 2048
DEPTH = 1

GRID_W = 64
CTX_LEN = 256
D_RNN = 512
RNN_HEADS = 8
RNN_HEAD_DIM = D_RNN // RNN_HEADS
RNN_CONV_W = 4
RNN_CONV_LEFT = 2
RG_C = 8.0
D_CONV = 512
CONV_GROUPS = 8
CONV_W = 3
D_CONV_H = D_CONV // 2
D_MIX = D_RNN + D_CONV
D_IN = 2 * D_RNN + 3 * D_CONV
N_GROUPS = 4
EXPERTS_PER_GROUP = 8
N_EXPERTS = N_GROUPS * EXPERTS_PER_GROUP
TOP_K = 2
D_EXPERT = 512
MOE_BLOCK = 128
NORM_EPS = 1e-6

kernel_name = "hybrid_rglru_shortconv_hiermoe_dit"


def rmsnorm(x, g):
    xf = x.astype(jnp.float32)
    y = xf * lax.rsqrt(jnp.mean(xf * xf, axis=-1, keepdims=True) + NORM_EPS)
    return (y * g.astype(jnp.float32)).astype(x.dtype)


def shift_conv(x, w, axis, left):
    k_w = w.shape[0]
    pad = [(0, 0)] * x.ndim
    pad[axis] = (left, k_w - 1 - left)
    xp = jnp.pad(x, pad)
    n = x.shape[axis]
    return sum(lax.slice_in_dim(xp, k, k + n, axis=axis) * w[k] for k in range(k_w))


def grid_short_conv(u, w, rows):
    bn, n, ch = u.shape
    ug = u.reshape(bn, rows, GRID_W, ch)
    uh = shift_conv(ug[..., :D_CONV_H], w[:, :D_CONV_H], axis=2, left=1)
    uv = shift_conv(ug[..., D_CONV_H:], w[:, D_CONV_H:], axis=1, left=1)
    return jnp.concatenate([uh, uv], axis=-1).reshape(bn, n, ch)


def rglru_coeffs(xc, wa, ba, wx, bx, lam):
    bn, n, _ = xc.shape
    xh = xc.reshape(bn, n, RNN_HEADS, RNN_HEAD_DIM)
    r = jax.nn.sigmoid(jnp.einsum('blhi,hij->blhj', xh, wa).reshape(bn, n, D_RNN) + ba)
    i = jax.nn.sigmoid(jnp.einsum('blhi,hij->blhj', xh, wx).reshape(bn, n, D_RNN) + bx)
    log_a = (-RG_C * r.astype(jnp.float32)) * jax.nn.softplus(-lam.astype(jnp.float32))
    a = jnp.exp(log_a)
    b = jnp.sqrt(-jnp.expm1(2.0 * log_a)) * (i * xc).astype(jnp.float32)
    return a, b


def _combine(e1, e2):
    a1, b1 = e1
    a2, b2 = e2
    return a1 * a2, a2 * b1 + b2


def linear_scan(a, b, h0, reverse):
    a_cum, h = lax.associative_scan(_combine, (a, b), axis=1, reverse=reverse)
    return h + a_cum * h0[:, None]


def hier_moe(xt, wg, bg, we, be, w_gate, w_up, w_down):
    t_n, d = xt.shape
    xf = xt.astype(jnp.float32)
    g_logits = xf @ wg.astype(jnp.float32) + bg.astype(jnp.float32)
    p_group = jax.nn.softmax(g_logits, axis=-1)
    grp = jnp.argmax(g_logits, axis=-1)
    p_g = jnp.max(p_group, axis=-1, keepdims=True)
    e_logits = (xf @ we.astype(jnp.float32) + be.astype(jnp.float32)).reshape(t_n, N_GROUPS, EXPERTS_PER_GROUP)
    e_in_grp = e_logits[jnp.arange(t_n), grp]
    top_p, top_local = lax.top_k(jax.nn.softmax(e_in_grp, axis=-1), TOP_K)
    gates = p_g * top_p / jnp.sum(top_p, axis=-1, keepdims=True)
    top_e = grp[:, None] * EXPERTS_PER_GROUP + top_local

    n_assign = t_n * TOP_K
    n_blocks = (n_assign + N_EXPERTS * (MOE_BLOCK - 1) + MOE_BLOCK - 1) // MOE_BLOCK
    flat_e = top_e.reshape(n_assign).astype(jnp.int32)
    order = jnp.argsort(flat_e)
    sorted_e = flat_e[order]
    counts = jnp.bincount(flat_e, length=N_EXPERTS)
    starts = jnp.cumsum(counts) - counts
    pcounts = (counts + MOE_BLOCK - 1) // MOE_BLOCK * MOE_BLOCK
    pends = jnp.cumsum(pcounts)
    pstarts = pends - pcounts
    dest = pstarts[sorted_e] + jnp.arange(n_assign) - starts[sorted_e]
    slot_tok = jnp.full((n_blocks * MOE_BLOCK,), t_n, jnp.int32).at[dest].set((order // TOP_K).astype(jnp.int32))
    x_pad = jnp.concatenate([xt, jnp.zeros((1, d), xt.dtype)], axis=0)
    xb = x_pad[slot_tok].reshape(n_blocks, MOE_BLOCK, d)
    block_e = jnp.minimum(jnp.sum(jnp.arange(n_blocks)[:, None] * MOE_BLOCK >= pends[None, :], axis=1), N_EXPERTS - 1)

    def run_block(args):
        xblk, e = args
        return (jax.nn.silu(xblk @ w_gate[e]) * (xblk @ w_up[e])) @ w_down[e]

    yb = lax.map(run_block, (xb, block_e)).reshape(n_blocks * MOE_BLOCK, d)
    y_assign = jnp.zeros((n_assign, d), yb.dtype).at[order].set(yb[dest])
    return jnp.einsum('tkd,tk->td', y_assign.reshape(t_n, TOP_K, d), gates.astype(yb.dtype))


def block(x, ctx_s, c, c_ctx, rows, last, ada_w, ada_b, norm1_g, norm2_g, w_in, rnn_conv_w, rnn_conv_b,
          rg_wa, rg_ba, rg_wx, rg_bx, rg_lambda, sc_conv_w, w_out, router_group_w, router_group_b,
          router_exp_w, router_exp_b, exp_w_gate, exp_w_up, exp_w_down):
    bn = x.shape[0]
    d = x.shape[-1]
    mod = jax.nn.silu(c) @ ada_w + ada_b
    sh1, sc1, g1, sh2, sc2, g2 = [m[:, None] for m in jnp.split(mod, 6, axis=-1)]
    mod_c = jax.nn.silu(c_ctx) @ ada_w + ada_b
    csh1, csc1, cg1, csh2, csc2, cg2 = jnp.split(mod_c, 6, axis=-1)

    splits = [D_RNN, 2 * D_RNN, 2 * D_RNN + D_CONV, 2 * D_RNN + 2 * D_CONV]
    h_lat = rmsnorm(x, norm1_g) * (1 + sc1) + sh1
    h_ctx = rmsnorm(ctx_s, norm1_g) * (1 + csc1) + csh1
    xr_l, gr_l, v_l, bgt_l, cgt_l = jnp.split(h_lat @ w_in, splits, axis=-1)
    xr_c, gr_c, v_c, bgt_c, cgt_c = jnp.split(h_ctx @ w_in, splits, axis=-1)

    xc_l = shift_conv(xr_l, rnn_conv_w, 1, RNN_CONV_LEFT) + rnn_conv_b
    xc_c = shift_conv(xr_c, rnn_conv_w, 1, RNN_CONV_LEFT) + rnn_conv_b
    hsum_l = jnp.zeros(xr_l.shape, jnp.float32)
    hsum_c = jnp.zeros(xr_c.shape, jnp.float32)
    for di, reverse in enumerate((False, True)):
        a_c, b_c = rglru_coeffs(xc_c, rg_wa[di], rg_ba[di], rg_wx[di], rg_bx[di], rg_lambda[di])
        h_c = linear_scan(a_c, b_c, jnp.zeros((bn, D_RNN), jnp.float32), reverse)
        h0 = h_c[:, 0] if reverse else h_c[:, -1]
        a_l, b_l = rglru_coeffs(xc_l, rg_wa[di], rg_ba[di], rg_wx[di], rg_bx[di], rg_lambda[di])
        hsum_l = hsum_l + linear_scan(a_l, b_l, h0, reverse)
        if not last:
            hsum_c = hsum_c + h_c

    y_rnn_l = jax.nn.gelu(gr_l, approximate=True) * hsum_l.astype(x.dtype)
    y_conv_l = bgt_l * grid_short_conv(cgt_l * v_l, sc_conv_w, rows)
    x = x + g1 * (jnp.concatenate([y_rnn_l, y_conv_l], axis=-1) @ w_out)
    if not last:
        y_rnn_c = jax.nn.gelu(gr_c, approximate=True) * hsum_c.astype(ctx_s.dtype)
        y_conv_c = bgt_c * shift_conv(cgt_c * v_c, sc_conv_w, 1, 1)
        ctx_s = ctx_s + cg1 * (jnp.concatenate([y_rnn_c, y_conv_c], axis=-1) @ w_out)

    m_l = (rmsnorm(x, norm2_g) * (1 + sc2) + sh2).reshape(-1, d)
    moe_args = (router_group_w, router_group_b, router_exp_w, router_exp_b, exp_w_gate, exp_w_up, exp_w_down)
    if last:
        x = x + g2 * hier_moe(m_l, *moe_args).reshape(x.shape)
        return x, None
    m_c = (rmsnorm(ctx_s, norm2_g) * (1 + csc2) + csh2).reshape(-1, d)
    n_ctx_tok = m_c.shape[0]
    y_all = hier_moe(jnp.concatenate([m_c, m_l], axis=0), *moe_args)
    ctx_s = ctx_s + cg2 * y_all[:n_ctx_tok].reshape(ctx_s.shape)
    x = x + g2 * y_all[n_ctx_tok:].reshape(x.shape)
    return x, ctx_s


def setup_inputs(seed: int = 0) -> dict:
    key = jax.random.key(seed)
    ks = jax.random.split(key, 32)
    f32 = jnp.float32
    nrm = lambda k, shape, s: jax.random.normal(k, shape, f32) * s
    a0 = jax.random.uniform(ks[12], (DEPTH, 2, D_RNN), f32, minval=0.9, maxval=0.999)
    return {
        "x": nrm(ks[0], (BATCH, SEQ, D_MODEL), 1.0),
        "c": nrm(ks[1], (BATCH, D_MODEL), 1.0),
        "ctx": nrm(ks[2], (BATCH, CTX_LEN, D_MODEL), 1.0),
        "c_ctx": nrm(ks[3], (D_MODEL,), 1.0),
        "ada_w": nrm(ks[4], (DEPTH, D_MODEL, 6 * D_MODEL), 0.5 * D_MODEL ** -0.5),
        "ada_b": nrm(ks[5], (DEPTH, 6 * D_MODEL), 0.01),
        "norm1_g": 1.0 + nrm(ks[6], (DEPTH, D_MODEL), 0.02),
        "norm2_g": 1.0 + nrm(ks[7], (DEPTH, D_MODEL), 0.02),
        "w_in": nrm(ks[8], (DEPTH, D_MODEL, D_IN), D_MODEL ** -0.5),
        "rnn_conv_w": nrm(ks[9], (DEPTH, RNN_CONV_W, D_RNN), RNN_CONV_W ** -0.5),
        "rnn_conv_b": nrm(ks[10], (DEPTH, D_RNN), 0.01),
        "rg_wa": nrm(ks[11], (DEPTH, 2, RNN_HEADS, RNN_HEAD_DIM, RNN_HEAD_DIM), RNN_HEAD_DIM ** -0.5),
        "rg_ba": nrm(ks[13], (DEPTH, 2, D_RNN), 0.01),
        "rg_wx": nrm(ks[14], (DEPTH, 2, RNN_HEADS, RNN_HEAD_DIM, RNN_HEAD_DIM), RNN_HEAD_DIM ** -0.5),
        "rg_bx": nrm(ks[15], (DEPTH, 2, D_RNN), 0.01),
        "rg_lambda": jnp.log(a0) - jnp.log1p(-a0),
        "sc_conv_w": nrm(ks[16], (DEPTH, CONV_W, D_CONV), CONV_W ** -0.5),
        "w_out": nrm(ks[17], (DEPTH, D_MIX, D_MODEL), D_MIX ** -0.5),
        "router_group_w": nrm(ks[18], (DEPTH, D_MODEL, N_GROUPS), D_MODEL ** -0.5),
        "router_group_b": nrm(ks[19], (DEPTH, N_GROUPS), 0.01),
        "router_exp_w": nrm(ks[20], (DEPTH, D_MODEL, N_EXPERTS), D_MODEL ** -0.5),
        "router_exp_b": nrm(ks[21], (DEPTH, N_EXPERTS), 0.01),
        "exp_w_gate": nrm(ks[22], (DEPTH, N_EXPERTS, D_MODEL, D_EXPERT), D_MODEL ** -0.5),
        "exp_w_up": nrm(ks[23], (DEPTH, N_EXPERTS, D_MODEL, D_EXPERT), D_MODEL ** -0.5),
        "exp_w_down": nrm(ks[24], (DEPTH, N_EXPERTS, D_EXPERT, D_MODEL), D_EXPERT ** -0.5),
        "final_norm_g": 1.0 + nrm(ks[25], (D_MODEL,), 0.02),
    }


def reference(x, c, ctx, c_ctx, ada_w, ada_b, norm1_g, norm2_g, w_in, rnn_conv_w, rnn_conv_b,
              rg_wa, rg_ba, rg_wx, rg_bx, rg_lambda, sc_conv_w, w_out, router_group_w, router_group_b,
              router_exp_w, router_exp_b, exp_w_gate, exp_w_up, exp_w_down, final_norm_g):
    rows = x.shape[1] // GRID_W
    ctx_s = ctx
    for l in range(DEPTH):
        x, ctx_s = block(x, ctx_s, c, c_ctx, rows, l == DEPTH - 1,
                         ada_w[l], ada_b[l], norm1_g[l], norm2_g[l], w_in[l], rnn_conv_w[l], rnn_conv_b[l],
                         rg_wa[l], rg_ba[l], rg_wx[l], rg_bx[l], rg_lambda[l], sc_conv_w[l], w_out[l],
                         router_group_w[l], router_group_b[l], router_exp_w[l], router_exp_b[l],
                         exp_w_gate[l], exp_w_up[l], exp_w_down[l])
    return rmsnorm(x, final_norm_g)
```

```cpp
#define MK_N_LAUNCHES 1
#include <hip/hip_runtime.h>
#include <cstdio>
#include <cstdint>
namespace pg8 {
#define PG8_LAS __attribute__((address_space(3)))
typedef unsigned short bf16_t;
typedef short bf16x8 __attribute__((ext_vector_type(8)));
typedef float f32x4 __attribute__((ext_vector_type(4)));
typedef unsigned u32x4 __attribute__((ext_vector_type(4)));
constexpr int BM = 256, BK = 64, HALF = 128, HTB = HALF * BK * 2  , STAGE_BYTES = 8 * HTB, NXCD = 8, WGM = 8;

__host__ __device__ __forceinline__ int lds_byte(int r, int c) { const int st = (r >> 4) * 2 + (c >> 5), rr = r & 15, cc = c & 31, ob = rr * 64 + cc * 2; return st * 1024 + (ob ^ (((ob >> 9) & 1) << 5)); }
__host__ __device__ __forceinline__ void stage_rc(int b, int& R, int& C) { const int st = b / 1024, sb = b % 1024, swz = sb ^ (((sb >> 9) & 1) << 5); R = (st >> 1) * 16 + swz / 64; C = (st & 1) * 32 + (swz % 64) / 2; }
__host__ __device__ __forceinline__ int perm32(int rho) { const int n = rho >> 4, i = rho & 15; return 8 * (i >> 2) + 4 * n + (i & 3); }

struct Unit { int pm, pn; };
struct Gemm { const bf16_t* A; const bf16_t* Bt; int M, N, K; };

struct StaticOrder {
    int nM, nN, nwg, G, c;
    __host__ __device__ void init(int M, int N, int G_, int c_) { nM = M / BM; nN = N / BM; nwg = nM * nN; G = G_; c = c_; }
    __host__ __device__ bool next(int i, Unit& u) const {
        const long L = (long)i * G + c; if (L >= nwg) return false;
        int wgid = (int)L; { const int q = nwg / NXCD, r = nwg % NXCD, xcd = wgid % NXCD, off = wgid / NXCD; wgid = (xcd < r ? xcd * (q + 1) : r * (q + 1) + (xcd - r) * q) + off; }
        const int nig = WGM * nN, gid = wgid / nig, fm = gid * WGM, gsz = (nM - fm) < WGM ? (nM - fm) : WGM;
        u.pm = fm + ((wgid % nig) % gsz); u.pn = (wgid % nig) / gsz; return true;
    }
    __device__ __forceinline__ void a_ready(const Unit&) const {}
    __device__ __forceinline__ void done(const Unit&) const {}
};
__device__ __forceinline__ unsigned cvt_pk_bf16(float lo, float hi) { unsigned r; asm volatile("v_cvt_pk_bf16_f32 %0, %1, %2" : "=v"(r) : "v"(lo), "v"(hi)); return r; }
struct EpiInProj {
    static constexpr bool PERM = true, AFTER_DRAIN = false;
    bf16_t* Z; bf16_t* Zc;
    __device__ __forceinline__ void operator()(const f32x4 (&acc)[2][2][4][2], const Unit& u, int wr, int wc, int fr, int fq) const {
        const bool isctx = u.pm >= 64;
        bf16_t* base = isctx ? Zc : Z; const int ldc = isctx ? 512 : 2560; const int prow = isctx ? u.pm - 64 : u.pm;
        const int row0 = prow * BM + wr * 64 + fr, col0 = u.pn * BM + wc * 32 + 8 * fq;
#pragma unroll
        for (int ai = 0; ai < 2; ++ai)
#pragma unroll
            for (int m = 0; m < 4; ++m) { bf16_t* rowp = base + (size_t)(row0 + ai * HALF + m * 16) * ldc + col0;
#pragma unroll
                for (int bj = 0; bj < 2; ++bj) { const f32x4 v0 = acc[ai][bj][m][0], v1 = acc[ai][bj][m][1];
                    u32x4 w; w.x = cvt_pk_bf16(v0[0], v0[1]); w.y = cvt_pk_bf16(v0[2], v0[3]); w.z = cvt_pk_bf16(v1[0], v1[1]); w.w = cvt_pk_bf16(v1[2], v1[3]);
                    *(u32x4*)(rowp + bj * HALF) = w; } }
    }
};
struct EpiOutProj {
    static constexpr bool PERM = false, AFTER_DRAIN = false;
    const float* x; float* X1; const float* mod;
    __device__ __forceinline__ void operator()(const f32x4 (&acc)[2][2][4][2], const Unit& u, int wr, int wc, int fr, int fq) const {
        const int b = u.pm >> 3;
        const int row0 = u.pm * BM + wr * 64 + fr, col0 = u.pn * BM + wc * 32 + 4 * fq;
        f32x4 gv[2][2];
#pragma unroll
        for (int bj = 0; bj < 2; ++bj)
#pragma unroll
            for (int n = 0; n < 2; ++n) gv[bj][n] = *(const f32x4*)(mod + (size_t)b * 6144 + 2048 + col0 + bj * HALF + n * 16);
#pragma unroll
        for (int ai = 0; ai < 2; ++ai)
#pragma unroll
            for (int m = 0; m < 4; ++m) { const size_t off = (size_t)(row0 + ai * HALF + m * 16) * 1024 + col0;
#pragma unroll
                for (int bj = 0; bj < 2; ++bj)
#pragma unroll
                    for (int n = 0; n < 2; ++n) { const f32x4 xv = *(const f32x4*)(x + off + bj * HALF + n * 16);
                        *(f32x4*)(X1 + off + bj * HALF + n * 16) = xv + gv[bj][n] * acc[ai][bj][m][n]; } }
    }
};
__device__ __forceinline__ float silu_f(float g) { return g * __builtin_amdgcn_rcpf(1.0f + __builtin_amdgcn_exp2f(-1.4426950408889634f * g)); }
struct EpiGateUp {
    static constexpr bool PERM = true, AFTER_DRAIN = false;
    bf16_t* H;
    __device__ __forceinline__ void operator()(const f32x4 (&acc)[2][2][4][2], const Unit& u, int wr, int wc, int fr, int fq) const {
        const int row0 = u.pm * BM + wr * 64 + fr, col0 = (u.pn & 3) * 128 + wc * 32 + 8 * fq;
#pragma unroll
        for (int ai = 0; ai < 2; ++ai)
#pragma unroll
            for (int m = 0; m < 4; ++m) { bf16_t* rowp = H + (size_t)(row0 + ai * HALF + m * 16) * 512 + col0;
                const f32x4 g0 = acc[ai][0][m][0], g1 = acc[ai][0][m][1], u0 = acc[ai][1][m][0], u1 = acc[ai][1][m][1];
                u32x4 w;
                w.x = cvt_pk_bf16(silu_f(g0[0]) * u0[0], silu_f(g0[1]) * u0[1]); w.y = cvt_pk_bf16(silu_f(g0[2]) * u0[2], silu_f(g0[3]) * u0[3]);
                w.z = cvt_pk_bf16(silu_f(g1[0]) * u1[0], silu_f(g1[1]) * u1[1]); w.w = cvt_pk_bf16(silu_f(g1[2]) * u1[2], silu_f(g1[3]) * u1[3]);
                *(u32x4*)rowp = w; }
    }
};
struct EpiDown {
    static constexpr bool PERM = true, AFTER_DRAIN = false;
    bf16_t* YA; const int* slotmap; const float* gatew;
    __device__ __forceinline__ void operator()(const f32x4 (&acc)[2][2][4][2], const Unit& u, int wr, int wc, int fr, int fq) const {
        const int row0 = u.pm * BM + wr * 64 + fr, col0 = (u.pn & 3) * BM + wc * 32 + 8 * fq;
#pragma unroll
        for (int ai = 0; ai < 2; ++ai)
#pragma unroll
            for (int m = 0; m < 4; ++m) { const int asg = slotmap[row0 + ai * HALF + m * 16];
                if (asg >= 0) { const float gw = gatew[asg]; bf16_t* rowp = YA + (size_t)asg * 1024 + col0;
#pragma unroll
                    for (int bj = 0; bj < 2; ++bj) { const f32x4 v0 = acc[ai][bj][m][0] * gw, v1 = acc[ai][bj][m][1] * gw;
                        u32x4 w; w.x = cvt_pk_bf16(v0[0], v0[1]); w.y = cvt_pk_bf16(v0[2], v0[3]); w.z = cvt_pk_bf16(v1[0], v1[1]); w.w = cvt_pk_bf16(v1[2], v1[3]);
                        *(u32x4*)(rowp + bj * HALF) = w; } } }
    }
};
struct OrderInProj {
    int G, c;
    __device__ __forceinline__ bool next(int i, Unit& u) const {
        const long L = (long)i * G + c; if (L >= 656) return false;
        if (L < 640) { int wgid = (int)L; const int xcd = wgid % NXCD, off = wgid / NXCD; wgid = xcd * 80 + off;
            const int nig = WGM * 10; const int fm = (wgid / nig) * WGM; u.pm = fm + ((wgid % nig) % WGM); u.pn = (wgid % nig) / WGM; }
        else { const int j = (int)L - 640; u.pm = 64 + (j >> 1); u.pn = j & 1; }
        return true;
    }
    __device__ __forceinline__ void a_ready(const Unit&) const {}
    __device__ __forceinline__ void done(const Unit&) const {}
};
struct OrderMoE {
    int G, c, NU; const PG8_LAS int* TE;
    __device__ __forceinline__ bool next(int i, Unit& u) const {
        const long L = (long)i * G + c; if (L >= NU) return false;
        const int q = NU / NXCD, r = NU % NXCD, xcd = (int)(L % NXCD), off = (int)(L / NXCD);
        const int id = (xcd < r ? xcd * (q + 1) : r * (q + 1) + (xcd - r) * q) + off;
        const int tile = id >> 2; u.pm = tile; u.pn = __builtin_amdgcn_readfirstlane(TE[tile]) * 4 + (id & 3); return true;
    }
    __device__ __forceinline__ void a_ready(const Unit&) const {}
    __device__ __forceinline__ void done(const Unit&) const {}
};
template <class Epi, class Sched, bool ALIGN_EPI = false, bool SP2 = false>
__device__ __forceinline__ void gemm_phase(PG8_LAS unsigned char* lds, const Gemm g, const Sched& S, const Epi& E) {
    const int tid = threadIdx.x, wid = __builtin_amdgcn_readfirstlane(tid >> 6), lane = tid & 63, wr = wid >> 2, wc = wid & 3, fr = lane & 15, fq = lane >> 4;
    const int K = g.K, nt = K / BK;
    unsigned voffA[2], voffB[2];
#pragma unroll
    for (int i = 0; i < 2; ++i) { int R, C; stage_rc(tid * 16 + i * 8192, R, C); const int Rb = Epi::PERM ? ((R & ~31) + perm32(R & 31)) : R;
        voffA[i] = (unsigned)(R * K + C) * 2u; voffB[i] = (unsigned)(Rb * K + C) * 2u; }
    const size_t kstep = (size_t)(BK * 2);
    const size_t hstep = (size_t)HALF * K * 2;
    const size_t tstep = 2 * hstep;
    const unsigned ldsw = (unsigned)wid * 1024u;
    const int aoff = lds_byte(wr * 64 + fr, fq * 8), boff = lds_byte(wc * 32 + fr, fq * 8);
#define PG8_SA(b, h) (((b) * 2 + (h)) * HTB)
#define PG8_SB(b, h) ((4 + (b) * 2 + (h)) * HTB)
#define PG8_STAGE(bufoff, gbase, voff) do { _Pragma("unroll") for (int _i = 0; _i < 2; ++_i) \
        __builtin_amdgcn_global_load_lds((const unsigned*)((const char*)(gbase) + (voff)[_i]), (PG8_LAS unsigned*)(lds + (bufoff) + ldsw + _i * 8192), 16, 0, 0); } while (0)
#define PG8_LDA(dst, b, h) do { _Pragma("unroll") for (int m = 0; m < 4; ++m) _Pragma("unroll") for (int k = 0; k < 2; ++k) dst[m][k] = *(const PG8_LAS bf16x8*)(lds + PG8_SA(b, h) + aoff + m * 2048 + k * 1024); } while (0)
#define PG8_LDB(dst, b, h) do { _Pragma("unroll") for (int n = 0; n < 2; ++n) _Pragma("unroll") for (int k = 0; k < 2; ++k) dst[n][k] = *(const PG8_LAS bf16x8*)(lds + PG8_SB(b, h) + boff + n * 2048 + k * 1024); } while (0)
#define PG8_MMA(ai, bj, At, Bt) do { __builtin_amdgcn_s_setprio(1); _Pragma("unroll") for (int m = 0; m < 4; ++m) _Pragma("unroll") for (int n = 0; n < 2; ++n) _Pragma("unroll") for (int k = 0; k < 2; ++k) \
        acc[ai][bj][m][n] = __builtin_amdgcn_mfma_f32_16x16x32_bf16(Bt[n][k], At[m][k], acc[ai][bj][m][n], 0, 0, 0); __builtin_amdgcn_s_setprio(0); } while (0)
#define PG8_WAIT_V(n) asm volatile("s_waitcnt vmcnt(" #n ")" ::: "memory")
#define PG8_WAIT_L(n) asm volatile("s_waitcnt lgkmcnt(" #n ")" ::: "memory")
#define PG8_BAR __builtin_amdgcn_s_barrier()
#define PG8_SCHED __builtin_amdgcn_sched_barrier(0)
    Unit cur, nxt; int ui = 0;
    if (!S.next(0, cur)) return;
    f32x4 acc[2][2][4][2];
#pragma unroll
    for (int a = 0; a < 2; ++a)
#pragma unroll
        for (int b = 0; b < 2; ++b)
#pragma unroll
            for (int m = 0; m < 4; ++m)
#pragma unroll
                for (int n = 0; n < 2; ++n) acc[a][b][m][n] = (f32x4){0.f, 0.f, 0.f, 0.f};
    bf16x8 At[4][2], B0[2][2], B1[2][2];
    const char* cA = (const char*)g.A + (size_t)cur.pm * tstep; const char* cB = (const char*)g.Bt + (size_t)cur.pn * tstep;
    S.a_ready(cur);
    if constexpr (SP2) {
        PG8_STAGE(PG8_SB(0, 0), cB, voffB); PG8_STAGE(PG8_SB(0, 1), cB + hstep, voffB); PG8_STAGE(PG8_SA(0, 0), cA, voffA); PG8_STAGE(PG8_SA(0, 1), cA + hstep, voffA);
        if (wr == 1) PG8_BAR;
        PG8_WAIT_V(2); PG8_BAR;
        PG8_STAGE(PG8_SB(1, 0), cB + kstep, voffB); PG8_STAGE(PG8_SA(1, 0), cA + kstep, voffA); PG8_STAGE(PG8_SB(1, 1), cB + hstep + kstep, voffB);
        PG8_WAIT_V(6); PG8_BAR;
    } else {
        PG8_STAGE(PG8_SB(0, 0), cB, voffB); PG8_STAGE(PG8_SA(0, 0), cA, voffA); PG8_STAGE(PG8_SB(0, 1), cB + hstep, voffB); PG8_STAGE(PG8_SA(0, 1), cA + hstep, voffA);
        if (wr == 1) PG8_BAR;
        PG8_WAIT_V(4); PG8_BAR;
        PG8_STAGE(PG8_SB(1, 0), cB + kstep, voffB); PG8_STAGE(PG8_SA(1, 0), cA + kstep, voffA); PG8_STAGE(PG8_SB(1, 1), cB + hstep + kstep, voffB);
        PG8_WAIT_V(6); PG8_BAR;
    }
    for (;;) {
        const bool has_next = S.next(ui + 1, nxt);
        const char* nA = has_next ? (const char*)g.A + (size_t)nxt.pm * tstep : cA; const char* nB = has_next ? (const char*)g.Bt + (size_t)nxt.pn * tstep : cB;
        for (int t = 0; t < nt; t += 2) {
            const bool last = (t == nt - 2);
            const char* a1 = cA + (size_t)(t + 1) * kstep;
            const char* a2 = last ? nA : cA + (size_t)(t + 2) * kstep; const char* b2 = last ? nB : cB + (size_t)(t + 2) * kstep;
            const char* a3 = a2 + kstep; const char* b3 = b2 + kstep;
            if (last && has_next) S.a_ready(nxt);
            if constexpr (SP2) {
            PG8_LDB(B0, 0, 0); PG8_LDB(B1, 0, 1); PG8_SCHED; PG8_LDA(At, 0, 0); PG8_STAGE(PG8_SA(1, 1), a1 + hstep, voffA);
            PG8_WAIT_V(8); PG8_WAIT_L(0); PG8_BAR; PG8_MMA(0, 0, At, B0); PG8_MMA(0, 1, At, B1); PG8_BAR; PG8_SCHED;
            PG8_LDA(At, 0, 1); PG8_STAGE(PG8_SB(0, 0), b2, voffB); PG8_STAGE(PG8_SB(0, 1), b2 + hstep, voffB); PG8_STAGE(PG8_SA(0, 0), a2, voffA);
            PG8_WAIT_V(8); PG8_WAIT_L(0); PG8_BAR; PG8_MMA(1, 0, At, B0); PG8_MMA(1, 1, At, B1); PG8_BAR; PG8_SCHED;
            PG8_LDB(B0, 1, 0); PG8_LDB(B1, 1, 1); PG8_SCHED; PG8_LDA(At, 1, 0); PG8_STAGE(PG8_SA(0, 1), a2 + hstep, voffA);
            PG8_WAIT_V(8); PG8_WAIT_L(0); PG8_BAR; PG8_MMA(0, 0, At, B0); PG8_MMA(0, 1, At, B1); PG8_BAR; PG8_SCHED;
            PG8_LDA(At, 1, 1); PG8_STAGE(PG8_SB(1, 0), b3, voffB); PG8_STAGE(PG8_SB(1, 1), b3 + hstep, voffB); PG8_STAGE(PG8_SA(1, 0), a3, voffA);
            PG8_WAIT_V(8); PG8_WAIT_L(0); PG8_BAR; PG8_MMA(1, 0, At, B0); PG8_MMA(1, 1, At, B1); PG8_BAR; PG8_SCHED;
            } else {
            PG8_LDB(B0, 0, 0); PG8_SCHED; PG8_LDA(At, 0, 0); PG8_STAGE(PG8_SA(1, 1), a1 + hstep, voffA);
            PG8_WAIT_L(8); PG8_BAR; PG8_WAIT_L(0); PG8_MMA(0, 0, At, B0); PG8_BAR; PG8_SCHED;
            PG8_LDB(B1, 0, 1); PG8_STAGE(PG8_SB(0, 0), b2, voffB);
            PG8_BAR; PG8_WAIT_L(0); PG8_MMA(0, 1, At, B1); PG8_BAR;
            PG8_LDA(At, 0, 1); PG8_STAGE(PG8_SA(0, 0), a2, voffA);
            PG8_BAR; PG8_WAIT_L(0); PG8_MMA(1, 0, At, B0); PG8_BAR; PG8_SCHED;
            PG8_STAGE(PG8_SB(0, 1), b2 + hstep, voffB);
            PG8_WAIT_V(6); PG8_BAR; PG8_MMA(1, 1, At, B1); PG8_BAR;
            PG8_LDB(B0, 1, 0); PG8_SCHED; PG8_LDA(At, 1, 0); PG8_STAGE(PG8_SA(0, 1), a2 + hstep, voffA);
            PG8_WAIT_L(8); PG8_BAR; PG8_WAIT_L(0); PG8_MMA(0, 0, At, B0); PG8_BAR; PG8_SCHED;
            PG8_LDB(B1, 1, 1); PG8_STAGE(PG8_SB(1, 0), b3, voffB);
            PG8_BAR; PG8_WAIT_L(0); PG8_MMA(0, 1, At, B1); PG8_BAR;
            PG8_LDA(At, 1, 1); PG8_STAGE(PG8_SA(1, 0), a3, voffA);
            PG8_BAR; PG8_WAIT_L(0); PG8_MMA(1, 0, At, B0); PG8_BAR; PG8_SCHED;
            PG8_STAGE(PG8_SB(1, 1), b3 + hstep, voffB);
            PG8_WAIT_V(6); PG8_BAR; PG8_MMA(1, 1, At, B1); PG8_BAR;
            }
        }
        if constexpr (ALIGN_EPI) { if (wr == 0) PG8_BAR; }
        if constexpr (!Epi::AFTER_DRAIN) { E(acc, cur, wr, wc, fr, fq); S.done(cur); }
        if (!has_next) break;
#pragma unroll
        for (int a = 0; a < 2; ++a)
#pragma unroll
            for (int b = 0; b < 2; ++b)
#pragma unroll
                for (int m = 0; m < 4; ++m)
#pragma unroll
                    for (int n = 0; n < 2; ++n) acc[a][b][m][n] = (f32x4){0.f, 0.f, 0.f, 0.f};
        cur = nxt; cA = nA; cB = nB; ++ui;
        if constexpr (ALIGN_EPI) { if (wr == 1) PG8_BAR; }
    }
    PG8_WAIT_V(0);
    if constexpr (!ALIGN_EPI) { if (wr == 0) PG8_BAR; }
    PG8_BAR;
    if constexpr (Epi::AFTER_DRAIN) { E.fused(acc, cur, wr, wc, fr, fq, lds, wid, lane); S.done(cur); }
#undef PG8_SA
#undef PG8_SB
#undef PG8_STAGE
#undef PG8_LDA
#undef PG8_LDB
#undef PG8_MMA
#undef PG8_WAIT_V
#undef PG8_WAIT_L
#undef PG8_BAR
#undef PG8_SCHED
}
}

#ifndef MK_N_LAUNCHES
#define MK_N_LAUNCHES 1
#endif
constexpr int N_PHASES = 11;
constexpr int NWAVES = 8;
#define GAS __attribute__((address_space(1)))
#define LAS __attribute__((address_space(3)))
typedef unsigned short bf16;
typedef unsigned v4u __attribute__((ext_vector_type(4)));
typedef unsigned v2u __attribute__((ext_vector_type(2)));
typedef float f32x4 __attribute__((ext_vector_type(4)));
typedef float f32x16 __attribute__((ext_vector_type(16)));
typedef short bf16x8 __attribute__((ext_vector_type(8)));
#define LDS_WAIT() asm volatile("s_waitcnt lgkmcnt(0)" ::: "memory")
#define RLX_AGENT __ATOMIC_RELAXED, __HIP_MEMORY_SCOPE_AGENT

constexpr int NB = 8, SEQ = 2048, DM = 1024, CTXL = 256, NTOK = NB * SEQ, NCTX = NB * CTXL, DIN = 2560, NEXP = 32;
constexpr float NORM_EPS = 1e-6f;
enum { I_X = 0, I_C, I_CTX, I_CCTX, I_ADAW, I_ADAB, I_N1G, I_N2G, I_WIN, I_RCW, I_RCB, I_RGWA, I_RGBA, I_RGWX, I_RGBX, I_RGLAM, I_SCW, I_WOUT, I_RGRW, I_RGRB, I_REW, I_REB, I_EWG, I_EWU, I_EWD, I_FNG, N_IN };

constexpr size_t MiB = 1u << 20;
constexpr size_t WS_CTL = 0, CTL_ZERO_BYTES = 1 * MiB;
constexpr size_t WS_MODP = 1 * MiB;
constexpr size_t WS_MOD = 5 * MiB;
constexpr size_t WS_WRT = 5 * MiB + 512 * 1024;
constexpr size_t WS_WRG = 5 * MiB + 768 * 1024;
constexpr size_t WS_WIN = 6 * MiB;
constexpr size_t WS_WOUT = 11 * MiB;
constexpr size_t WS_WGU = 13 * MiB;
constexpr size_t WS_WD = 77 * MiB;
constexpr size_t WS_AGG = 109 * MiB;
constexpr size_t WS_SLOT = 112 * MiB;
constexpr size_t WS_GATEW = 114 * MiB;
constexpr size_t WS_SMAP = 114 * MiB + 256 * 1024;
constexpr size_t WS_RA = 115 * MiB;
constexpr size_t WS_ZC = WS_RA + 80 * MiB;
constexpr size_t WS_RB = 197 * MiB;
constexpr size_t WS_END = 237 * MiB;
constexpr int CW_BAR = 4096;
constexpr int CW_CNT = 16384;
constexpr int RING_BYTES = 131072, LDSCTL_OFF = RING_BYTES, TBL_OFF = LDSCTL_OFF + 512, LDS_BYTES = 147456;

__device__ __forceinline__ float bflo(unsigned w) { return __uint_as_float(w << 16); }
__device__ __forceinline__ float bfhi(unsigned w) { return __uint_as_float(w & 0xffff0000u); }
__device__ __forceinline__ unsigned pk2(float lo, float hi) { return pg8::cvt_pk_bf16(lo, hi); }
__device__ __forceinline__ float wave_sum(float v) {
#pragma unroll
    for (int o = 1; o < 64; o <<= 1) v += __shfl_xor(v, o);
    return v;
}

#define XB_TMO      128
#define XB_XCNT(j)  (256  + 64 * (j))
#define XB_XSUB(j)  (1280 + 64 * (j))
#define XB_XGEN(j)  (2304 + 64 * (j))
#define XB_TOP      3328
#define XB_TOPGEN   3392
#define XCD_BAR_WORDS 3456
#define XB_SPIN_CAP (1u << 18)
__device__ __forceinline__ unsigned xb_ld(unsigned* p)              { return __hip_atomic_load(p, __ATOMIC_RELAXED, __HIP_MEMORY_SCOPE_AGENT); }
__device__ __forceinline__ unsigned xb_add(unsigned* p, unsigned v) { return __hip_atomic_fetch_add(p, v, __ATOMIC_RELAXED, __HIP_MEMORY_SCOPE_AGENT); }
__device__ __forceinline__ unsigned xb_xcc_id() { return (unsigned)__builtin_amdgcn_s_getreg((3 << 11) | 20) & 0xFu; }
#define XB_SPIN(cond, bar) do { unsigned _sp = 0; while (cond) { __builtin_amdgcn_s_sleep(1); \
    if ((++_sp & 255u) == 0u) { if (xb_ld(&(bar)[XB_TMO])) break; if (_sp > XB_SPIN_CAP) { atomicAdd(&(bar)[XB_TMO], 1u); break; } } } } while (0)
struct XcdBarrier { unsigned* bar; unsigned x; volatile LAS unsigned* st; };
__device__ __forceinline__ XcdBarrier xcd_barrier_post(unsigned* bar, volatile LAS unsigned* st) {
    XcdBarrier b; b.bar = bar; b.x = xb_xcc_id(); b.st = st;
    if (threadIdx.x == 0) (void)xb_add(&bar[XB_XCNT(b.x)], 1u);
    return b;
}
__device__ __forceinline__ void xcd_barrier_complete(unsigned* bar, unsigned x, unsigned& nloc, unsigned& nx) {
    const unsigned G = gridDim.x * gridDim.y * gridDim.z;
    unsigned sum, cnt, mine, sp = 0u;
    for (;;) {
        sum = 0u; cnt = 0u; mine = 0u;
#pragma unroll
        for (unsigned j = 0; j < 16; ++j) { const unsigned c = xb_ld(&bar[XB_XCNT(j)]); sum += c; cnt += (c > 0u) ? 1u : 0u; mine = (j == x) ? c : mine; }
        if (sum == G) break;
        __builtin_amdgcn_s_sleep(1);
        if ((++sp & 255u) == 0u) { if (xb_ld(&bar[XB_TMO])) break; if (sp > XB_SPIN_CAP) { atomicAdd(&bar[XB_TMO], 1u); break; } }
    }
    nloc = mine > 0u ? mine : 1u; nx = cnt > 0u ? cnt : 1u;
}
__device__ __forceinline__ void xcd_barrier(const XcdBarrier& b) {
    asm volatile("s_waitcnt vmcnt(0)" ::: "memory");
    __syncthreads();
    if (threadIdx.x == 0) {
        unsigned* bar = b.bar;
        __builtin_amdgcn_s_waitcnt(0);
        unsigned nloc = b.st[0], nx = b.st[1];
        if (nloc == 0u) { xcd_barrier_complete(bar, b.x, nloc, nx); b.st[0] = nloc; b.st[1] = nx; }
        const unsigned old = xb_add(&bar[XB_XSUB(b.x)], 1u);
        const unsigned gen = old / nloc;
        if (old + 1u == (gen + 1u) * nloc) {
            __builtin_amdgcn_fence(__ATOMIC_RELEASE, "agent");
            asm volatile("s_waitcnt vmcnt(0)" ::: "memory");
            const unsigned og = xb_add(&bar[XB_TOP], 1u);
            const unsigned tg = og / nx;
            if (og + 1u == (tg + 1u) * nx) xb_add(&bar[XB_TOPGEN], 1u);
            else XB_SPIN(xb_ld(&bar[XB_TOPGEN]) == tg, bar);
            __builtin_amdgcn_fence(__ATOMIC_ACQUIRE, "agent");
            xb_add(&bar[XB_XGEN(b.x)], 1u);
            asm volatile("s_waitcnt vmcnt(0)" ::: "memory");
        } else {
            XB_SPIN(xb_ld(&bar[XB_XGEN(b.x)]) == gen, bar);
            __builtin_amdgcn_fence(__ATOMIC_ACQUIRE, "agent");
            asm volatile("s_waitcnt vmcnt(0)" ::: "memory");
        }
    }
    __syncthreads();
}

struct Args { const float* in[N_IN]; float* out; unsigned char* ws; int ph_lo, ph_hi; };
struct Frame { LAS unsigned char* lds; int tid, lane, wave, G, bid; };

__device__ __forceinline__ void tr_item(const float* W, int N, bf16* WT, int KP, int drow0, int k0, int n0, LAS float* scr, int lane) {
#pragma unroll 8
    for (int i = 0; i < 32; ++i) { const int kk = 2 * i + (lane >> 5); scr[kk * 33 + (lane & 31)] = W[(size_t)(k0 + kk) * N + n0 + (lane & 31)]; }
    LDS_WAIT(); asm volatile("" ::: "memory");
    const int c = lane & 7;
#pragma unroll
    for (int j = 0; j < 4; ++j) { const int n = (lane >> 3) + 8 * j; const LAS float* s = scr + (8 * c) * 33 + n;
        v4u o; o.x = pk2(s[0 * 33], s[1 * 33]); o.y = pk2(s[2 * 33], s[3 * 33]); o.z = pk2(s[4 * 33], s[5 * 33]); o.w = pk2(s[6 * 33], s[7 * 33]);
        *(v4u*)(WT + (size_t)(drow0 + n) * KP + k0 + 8 * c) = o; }
    LDS_WAIT(); asm volatile("" ::: "memory");
}
__device__ __forceinline__ void gemv_item(const Args& a, int item, LAS float* scr, int lane) {
    const int ks = item / 24, nb = item % 24, k0 = ks * 64, n0 = nb * 256 + 4 * lane;
    const float* cc = a.in[I_C]; const float* cx = a.in[I_CCTX]; const float* W = a.in[I_ADAW];
#pragma unroll
    for (int r = 0; r < 9; ++r) { const float v = r < 8 ? cc[r * 1024 + k0 + lane] : cx[k0 + lane]; scr[r * 64 + lane] = v / (1.0f + __expf(-v)); }
    LDS_WAIT(); asm volatile("" ::: "memory");
    f32x4 acc[9];
#pragma unroll
    for (int r = 0; r < 9; ++r) acc[r] = (f32x4){0.f, 0.f, 0.f, 0.f};
#pragma unroll 4
    for (int kk = 0; kk < 64; ++kk) { const f32x4 w = *(const f32x4*)(W + (size_t)(k0 + kk) * 6144 + n0);
#pragma unroll
        for (int r = 0; r < 9; ++r) acc[r] += scr[r * 64 + kk] * w; }
    float* MODP = (float*)(a.ws + WS_MODP);
#pragma unroll
    for (int r = 0; r < 9; ++r) *(f32x4*)(MODP + ((size_t)ks * 9 + r) * 6144 + n0) = acc[r];
    LDS_WAIT(); asm volatile("" ::: "memory");
}
constexpr int IT_GEMV = 384, IT_WRT = 72, IT_WIN = 16 * 80, IT_WOUT = 16 * 32, IT_RG = 64, IT_GATE = 8192, IT_UP = 8192, IT_DOWN = 8192;
constexpr int IT_TOTAL = IT_GEMV + IT_WRT + IT_WIN + IT_WOUT + IT_RG + IT_GATE + IT_UP + IT_DOWN;
__device__ __forceinline__ void p0_prep(const Args& a, Frame& F) {
    LAS float* scr = (LAS float*)(F.lds + F.wave * 16384);
    const int gw = F.wave * F.G + F.bid, NGW = F.G * NWAVES, lane = F.lane;
    bf16* WinT = (bf16*)(a.ws + WS_WIN); bf16* WoutT = (bf16*)(a.ws + WS_WOUT); bf16* WrgT = (bf16*)(a.ws + WS_WRG);
    bf16* WguT = (bf16*)(a.ws + WS_WGU); bf16* WdT = (bf16*)(a.ws + WS_WD); float* WrT = (float*)(a.ws + WS_WRT);
    for (int it = gw; it < IT_TOTAL; it += NGW) {
        int r = it;
        if (r < IT_GEMV) { gemv_item(a, r, scr, lane); continue; } r -= IT_GEMV;
        if (r < IT_WRT) { const float* rgw = a.in[I_RGRW]; const float* rew = a.in[I_REW];
#pragma unroll
            for (int i = 0; i < 8; ++i) { const int idx = r * 512 + lane + 64 * i, j = idx >> 10, k = idx & 1023; WrT[idx] = j < 4 ? rgw[k * 4 + j] : rew[k * 32 + (j - 4)]; }
            continue; } r -= IT_WRT;
        if (r < IT_WIN) { const int kb = r / 80, nb = r % 80; tr_item(a.in[I_WIN], 2560, WinT, 1024, 32 * nb, 64 * kb, 32 * nb, scr, lane); continue; } r -= IT_WIN;
        if (r < IT_WOUT) { const int kb = r / 32, nb = r % 32; tr_item(a.in[I_WOUT], 1024, WoutT, 1024, 32 * nb, 64 * kb, 32 * nb, scr, lane); continue; } r -= IT_WOUT;
        if (r < IT_RG) { const int mat = r >> 1, nb = r & 1, g = mat >> 4, d = (mat >> 3) & 1, h = mat & 7;
            const float* src = (g ? a.in[I_RGWX] : a.in[I_RGWA]) + (size_t)(d * 8 + h) * 4096;
            tr_item(src, 64, WrgT, 64, h * 256 + d * 128 + g * 64 + 32 * nb, 0, 32 * nb, scr, lane); continue; } r -= IT_RG;
        if (r < IT_GATE + IT_UP) { const int up = r >= IT_GATE ? 1 : 0; const int q = r - up * IT_GATE; const int e = q >> 8, it2 = q & 255, kb = it2 >> 4, nb = it2 & 15, n0 = 32 * nb;
            const float* src = (up ? a.in[I_EWU] : a.in[I_EWG]) + (size_t)e * 524288;
            tr_item(src, 512, WguT, 1024, e * 1024 + (n0 >> 7) * 256 + up * 128 + (n0 & 127), 64 * kb, n0, scr, lane); continue; } r -= IT_GATE + IT_UP;
        { const int e = r >> 8, it2 = r & 255, kb = it2 >> 5, nb = it2 & 31;
            tr_item(a.in[I_EWD] + (size_t)e * 524288, 1024, WdT, 512, e * 1024 + 32 * nb, 64 * kb, 32 * nb, scr, lane); }
    }
}

__device__ __forceinline__ void norm_row_mod(const float* src, bf16* dst, const LAS float* GS, const LAS float* SH, int lane) {
    const f32x4* xr = (const f32x4*)src + lane; f32x4 v[4]; float ss = 0.f;
#pragma unroll
    for (int j = 0; j < 4; ++j) { v[j] = xr[64 * j]; ss += (v[j].x * v[j].x + v[j].y * v[j].y) + (v[j].z * v[j].z + v[j].w * v[j].w); }
    const float rstd = 1.0f / sqrtf(wave_sum(ss) * (1.0f / 1024.0f) + NORM_EPS);
#pragma unroll
    for (int j = 0; j < 4; ++j) { const f32x4 g = *(const LAS f32x4*)(GS + 4 * lane + 256 * j), s = *(const LAS f32x4*)(SH + 4 * lane + 256 * j);
        const f32x4 y = (v[j] * rstd) * g + s; v2u o; o.x = pk2(y.x, y.y); o.y = pk2(y.z, y.w);
        *(v2u*)(dst + 4 * lane + 256 * j) = o; }
}
__device__ __forceinline__ void p1_norm(const Args& a, Frame& F) {
    const float* MODP = (const float*)(a.ws + WS_MODP); float* MOD = (float*)(a.ws + WS_MOD); bf16* XN = (bf16*)(a.ws + WS_RB);
    const float* adab = a.in[I_ADAB]; const float* n1g = a.in[I_N1G];
    LAS float* GS = (LAS float*)F.lds; LAS float* SH = GS + 1024; LAS float* GSC = GS + 2048; LAS float* SHC = GS + 3072;
    for (int blk = F.bid; blk < 256; blk += F.G) {
        const int b = blk >> 5;
        for (int k = F.tid; k < 1024; k += NWAVES * 64) {
            float s_sh = adab[k], s_sc = adab[1024 + k], c_sh = s_sh, c_sc = s_sc;
#pragma unroll 4
            for (int ks = 0; ks < 16; ++ks) { const float* base = MODP + (size_t)ks * 9 * 6144;
                s_sh += base[b * 6144 + k]; s_sc += base[b * 6144 + 1024 + k]; c_sh += base[8 * 6144 + k]; c_sc += base[8 * 6144 + 1024 + k]; }
            const float g = n1g[k]; GS[k] = g * (1.0f + s_sc); SH[k] = s_sh; GSC[k] = g * (1.0f + c_sc); SHC[k] = c_sh;
        }
        if (F.tid < 216) { const int r = F.tid / 24, n = blk * 24 + F.tid % 24; float s = adab[n];
#pragma unroll 4
            for (int ks = 0; ks < 16; ++ks) s += MODP[((size_t)ks * 9 + r) * 6144 + n];
            MOD[r * 6144 + n] = s; }
        __syncthreads();
#pragma unroll 1
        for (int j = 0; j < 9; ++j) { const bool isctx = j == 8;
            const int row = isctx ? NTOK + blk * 8 + F.wave : blk * 64 + F.wave * 8 + j;
            const float* src = isctx ? a.in[I_CTX] + (size_t)(blk * 8 + F.wave) * 1024 : a.in[I_X] + (size_t)row * 1024;
            norm_row_mod(src, XN + (size_t)row * 1024, isctx ? GSC : GS, isctx ? SHC : SH, F.lane); }
        __syncthreads();
    }
}

__device__ __forceinline__ void ld8(const bf16* p, float (&f)[8]) { const v4u w = *(const v4u*)p;
    f[0] = bflo(w.x); f[1] = bfhi(w.x); f[2] = bflo(w.y); f[3] = bfhi(w.y); f[4] = bflo(w.z); f[5] = bfhi(w.z); f[6] = bflo(w.w); f[7] = bfhi(w.w); }
__device__ __forceinline__ v4u pack8(const float (&f)[8]) { v4u w; w.x = pk2(f[0], f[1]); w.y = pk2(f[2], f[3]); w.z = pk2(f[4], f[5]); w.w = pk2(f[6], f[7]); return w; }

__device__ __forceinline__ void yconv_item(const Args& a, Frame& F, int b, int r) {
    const bf16* Z = (const bf16*)(a.ws + WS_RA); bf16* Y = (bf16*)(a.ws + WS_RB); const float* scw = a.in[I_SCW];
    const int cg = F.tid & 63, c0 = cg * 8; const bool vert = cg >= 32; const int stride = vert ? 64 : 1;
    float wk[3][8];
#pragma unroll
    for (int k = 0; k < 3; ++k)
#pragma unroll
        for (int i = 0; i < 8; ++i) wk[k][i] = scw[k * 512 + c0 + i];
#pragma unroll 2
    for (int j = 0; j < 8; ++j) { const int w = (F.tid >> 6) + 8 * j, t = r * 64 + w;
        float acc[8];
#pragma unroll
        for (int i = 0; i < 8; ++i) acc[i] = 0.f;
#pragma unroll
        for (int k = 0; k < 3; ++k) { const int p = (vert ? r : w) + k - 1; const bool valid = p >= 0 && p < (vert ? 32 : 64);
            const int tn = valid ? t + (k - 1) * stride : t; const bf16* zr = Z + (size_t)(b * SEQ + tn) * DIN;
            float cv[8], vv[8]; ld8(zr + 2048 + c0, cv); ld8(zr + 1024 + c0, vv);
            const float m = valid ? 1.0f : 0.0f;
#pragma unroll
            for (int i = 0; i < 8; ++i) acc[i] += (wk[k][i] * m) * (cv[i] * vv[i]); }
        float bg[8]; ld8(Z + (size_t)(b * SEQ + t) * DIN + 1536 + c0, bg);
#pragma unroll
        for (int i = 0; i < 8; ++i) acc[i] *= bg[i];
        *(v4u*)(Y + (size_t)(b * SEQ + t) * 1024 + 512 + c0) = pack8(acc); }
}

constexpr int SC_XC = 0, SC_AB = 9216, SC_BB = 9216 + 32768, SC_SEG = 9216 + 65536, SC_HIN = SC_SEG + 4096;
template <bool PASS2>
__device__ __forceinline__ void scan_tile(const Args& a, Frame& F, int b, int h, int vc) {
    const int tid = F.tid, lane = F.lane, wave = F.wave;
    LAS bf16* XC = (LAS bf16*)(F.lds + SC_XC);
    LAS float* AB = (LAS float*)(F.lds + SC_AB);
    LAS float* BB = (LAS float*)(F.lds + SC_BB);
    LAS float* SEG = (LAS float*)(F.lds + SC_SEG);
    LAS float* HIN = (LAS float*)(F.lds + SC_HIN);
    const bf16* Z = (const bf16*)(a.ws + WS_RA); const bf16* Zc = (const bf16*)(a.ws + WS_ZC);
    const bf16* WrgT = (const bf16*)(a.ws + WS_WRG); float* AGG = (float*)(a.ws + WS_AGG);
    const bool isctx = vc < 4;
    const int s0 = isctx ? vc * 64 : (vc - 4) * 64, Ls = isctx ? CTXL : SEQ, pitch = isctx ? 512 : DIN;
    const bf16* src = isctx ? Zc + (size_t)b * CTXL * 512 : Z + (size_t)b * SEQ * DIN;
    { const int s = tid >> 3, ig = tid & 7, col = h * 64 + ig * 8;
      const float* cw = a.in[I_RCW]; const float* cb = a.in[I_RCB];
      float acc[8];
#pragma unroll
      for (int i = 0; i < 8; ++i) acc[i] = cb[col + i];
#pragma unroll
      for (int k = 0; k < 4; ++k) { const int sp = s0 + s + k - 2; const bool valid = sp >= 0 && sp < Ls; const int spc = valid ? sp : s0 + s;
          float xv[8]; ld8(src + (size_t)spc * pitch + col, xv); const float m = valid ? 1.0f : 0.0f;
#pragma unroll
          for (int i = 0; i < 8; ++i) acc[i] += (cw[k * 512 + col + i] * m) * xv[i]; }
      *(LAS v4u*)(XC + s * 72 + ig * 8) = pack8(acc); }
    __syncthreads();
    { const int d = wave >> 2, chh = (wave >> 1) & 1, shf = wave & 1, r = lane & 31, hh = lane >> 5;
      f32x16 accr, acci;
#pragma unroll
      for (int i = 0; i < 16; ++i) { accr[i] = 0.f; acci[i] = 0.f; }
      const bf16* wr_ = WrgT + (size_t)(h * 256 + d * 128 + chh * 32 + r) * 64 + hh * 8;
#pragma unroll
      for (int ks = 0; ks < 4; ++ks) {
          const bf16x8 af = *(const LAS bf16x8*)(XC + (shf * 32 + r) * 72 + ks * 16 + hh * 8);
          const bf16x8 br = *(const bf16x8*)(wr_ + ks * 16), bi = *(const bf16x8*)(wr_ + 64 * 64 + ks * 16);
          accr = __builtin_amdgcn_mfma_f32_32x32x16_bf16(af, br, accr, 0, 0, 0);
          acci = __builtin_amdgcn_mfma_f32_32x32x16_bf16(af, bi, acci, 0, 0, 0); }
      const int ch = chh * 32 + r, gch = d * 512 + h * 64 + ch;
      const float ba = a.in[I_RGBA][gch], bx = a.in[I_RGBX][gch], lam = a.in[I_RGLAM][gch];
      const float Kc = -8.0f * 1.4426950408889634f * log1pf(expf(-lam));
#pragma unroll
      for (int reg = 0; reg < 16; ++reg) { const int s = shf * 32 + (reg & 3) + 8 * (reg >> 2) + 4 * hh;
          const float rr = __builtin_amdgcn_rcpf(1.0f + __builtin_amdgcn_exp2f(-1.4426950408889634f * (accr[reg] + ba)));
          const float ii = __builtin_amdgcn_rcpf(1.0f + __builtin_amdgcn_exp2f(-1.4426950408889634f * (acci[reg] + bx)));
          const float av = __builtin_amdgcn_exp2f(Kc * rr);
          const float xcv = __uint_as_float((unsigned)XC[s * 72 + ch] << 16);
          const float bv = sqrtf(fmaxf(fmaf(-av, av, 1.0f), 0.0f)) * (ii * xcv);
          AB[(d * 64 + s) * 64 + ch] = av; BB[(d * 64 + s) * 64 + ch] = bv; } }
    __syncthreads();
    const int d2 = tid >> 8, seg = (tid >> 6) & 3, c = tid & 63;
    { float P = 1.0f, Sv = 0.0f;
#pragma unroll
      for (int j = 0; j < 16; ++j) { const int vs = seg * 16 + j, s = d2 ? 63 - vs : vs; const float av = AB[(d2 * 64 + s) * 64 + c], bv = BB[(d2 * 64 + s) * 64 + c]; Sv = av * Sv + bv; P *= av; }
      SEG[((d2 * 4 + seg) * 64 + c) * 2 + 0] = P; SEG[((d2 * 4 + seg) * 64 + c) * 2 + 1] = Sv; }
    if (PASS2 && tid < 128) {
        const int dd = tid >> 6, cc = tid & 63; const float* ag = AGG + ((size_t)b * 36 * 2 + dd) * 1024 + (h * 64 + cc) * 2;
        float hc = 0.0f;
        if (dd == 0) { for (int k = 0; k < vc; ++k) { const float p = ag[(size_t)k * 2048], s = ag[(size_t)k * 2048 + 1]; hc = p * hc + s; } }
        else { for (int k = 3; k >= 0; --k) { const float p = ag[(size_t)k * 2048], s = ag[(size_t)k * 2048 + 1]; hc = p * hc + s; }
               for (int k = 35; k > vc; --k) { const float p = ag[(size_t)k * 2048], s = ag[(size_t)k * 2048 + 1]; hc = p * hc + s; } }
        HIN[dd * 64 + cc] = hc; }
    __syncthreads();
    if (!PASS2) {
        if (seg == 0) { float Pt = 1.0f, St = 0.0f;
#pragma unroll
            for (int k = 0; k < 4; ++k) { const float p = SEG[((d2 * 4 + k) * 64 + c) * 2], s = SEG[((d2 * 4 + k) * 64 + c) * 2 + 1]; St = p * St + s; Pt *= p; }
            float* ag = AGG + (((size_t)b * 36 + vc) * 2 + d2) * 1024 + (h * 64 + c) * 2; ag[0] = Pt; ag[1] = St; }
    } else {
        float hv = HIN[d2 * 64 + c];
        for (int k = 0; k < seg; ++k) { const float p = SEG[((d2 * 4 + k) * 64 + c) * 2], s = SEG[((d2 * 4 + k) * 64 + c) * 2 + 1]; hv = p * hv + s; }
#pragma unroll
        for (int j = 0; j < 16; ++j) { const int vs = seg * 16 + j, s = d2 ? 63 - vs : vs; const float av = AB[(d2 * 64 + s) * 64 + c], bv = BB[(d2 * 64 + s) * 64 + c]; hv = av * hv + bv; BB[(d2 * 64 + s) * 64 + c] = hv; }
        __syncthreads();
        { const int s = tid >> 3, cg8 = (tid & 7) * 8; const size_t trow = (size_t)b * SEQ + s0 + s;
          float g[8], o[8]; ld8(Z + trow * DIN + 512 + h * 64 + cg8, g);
#pragma unroll
          for (int i = 0; i < 8; ++i) { const float hs = BB[(0 * 64 + s) * 64 + cg8 + i] + BB[(1 * 64 + s) * 64 + cg8 + i];
              const float z = g[i] + 0.044715f * g[i] * g[i] * g[i];
              const float ge = g[i] * __builtin_amdgcn_rcpf(1.0f + __builtin_amdgcn_exp2f(-1.5957691216057308f * 1.4426950408889634f * z));
              o[i] = ge * hs; }
          *(v4u*)((bf16*)(a.ws + WS_RB) + trow * 1024 + h * 64 + cg8) = pack8(o); }
    }
    __syncthreads();
}

__device__ __forceinline__ float red8(const float (&p)[8], int lane) {
    const bool b0 = lane & 1, b1 = lane & 2, b2 = lane & 4;
    float q[4], r2[2];
#pragma unroll
    for (int i = 0; i < 4; ++i) { const float keep = b0 ? p[i + 4] : p[i], send = b0 ? p[i] : p[i + 4]; q[i] = keep + __shfl_xor(send, 1); }
#pragma unroll
    for (int i = 0; i < 2; ++i) { const float keep = b1 ? q[i + 2] : q[i], send = b1 ? q[i] : q[i + 2]; r2[i] = keep + __shfl_xor(send, 2); }
    float s; { const float keep = b2 ? r2[1] : r2[0], send = b2 ? r2[0] : r2[1]; s = keep + __shfl_xor(send, 4); }
    s += __shfl_xor(s, 8); s += __shfl_xor(s, 16); s += __shfl_xor(s, 32);
    return s;
}
__device__ __forceinline__ void p6_route(const Args& a, Frame& F) {
    const float* X1 = a.out; const float* MOD = (const float*)(a.ws + WS_MOD); const float* WrT = (const float*)(a.ws + WS_WRT);
    bf16* ML = (bf16*)(a.ws + WS_RB); int* SLOT = (int*)(a.ws + WS_SLOT); float* GATEW = (float*)(a.ws + WS_GATEW); unsigned* CNT = (unsigned*)(a.ws + WS_CTL) + CW_CNT;
    const float* n2g = a.in[I_N2G]; const float* rgb = a.in[I_RGRB]; const float* reb = a.in[I_REB];
    const int lane = F.lane;
    for (int g = F.bid * NWAVES + F.wave; g < NTOK / 8; g += F.G * NWAVES) {
        const int row0 = g * 8, b = row0 >> 11;
        f32x4 v[8][4]; float ss[8];
#pragma unroll
        for (int r = 0; r < 8; ++r) { ss[r] = 0.f;
#pragma unroll
            for (int j = 0; j < 4; ++j) { v[r][j] = *(const f32x4*)(X1 + (size_t)(row0 + r) * 1024 + 4 * lane + 256 * j);
                ss[r] += (v[r][j].x * v[r][j].x + v[r][j].y * v[r][j].y) + (v[r][j].z * v[r][j].z + v[r][j].w * v[r][j].w); } }
#pragma unroll
        for (int r = 0; r < 8; ++r) ss[r] = 1.0f / sqrtf(wave_sum(ss[r]) * (1.0f / 1024.0f) + NORM_EPS);
#pragma unroll
        for (int j = 0; j < 4; ++j) { const int col = 4 * lane + 256 * j;
            const f32x4 gn = *(const f32x4*)(n2g + col), sc = *(const f32x4*)(MOD + (size_t)b * 6144 + 4096 + col), sh = *(const f32x4*)(MOD + (size_t)b * 6144 + 3072 + col);
            const f32x4 gs = gn * (sc + 1.0f);
#pragma unroll
            for (int r = 0; r < 8; ++r) { v[r][j] = (v[r][j] * ss[r]) * gs + sh; v2u o; o.x = pk2(v[r][j].x, v[r][j].y); o.y = pk2(v[r][j].z, v[r][j].w);
                *(v2u*)(ML + (size_t)(row0 + r) * 1024 + col) = o; } }
        LAS float* LG = (LAS float*)(F.lds + F.wave * 2048);
        const int rid = 4 * (lane & 1) + 2 * ((lane >> 1) & 1) + ((lane >> 2) & 1);
#pragma unroll 2
        for (int jj = 0; jj < 36; ++jj) { f32x4 w[4];
#pragma unroll
            for (int j = 0; j < 4; ++j) w[j] = *(const f32x4*)(WrT + jj * 1024 + 4 * lane + 256 * j);
            float p[8];
#pragma unroll
            for (int r = 0; r < 8; ++r) { float s = 0.f;
#pragma unroll
                for (int j = 0; j < 4; ++j) s += (v[r][j].x * w[j].x + v[r][j].y * w[j].y) + (v[r][j].z * w[j].z + v[r][j].w * w[j].w);
                p[r] = s; }
            const float tot = red8(p, lane) + (jj < 4 ? rgb[jj] : reb[jj - 4]);
            if (lane < 8) LG[rid * 36 + jj] = tot; }
        LDS_WAIT(); asm volatile("" ::: "memory");
        float lg[36];
#pragma unroll
        for (int jj = 0; jj < 36; ++jj) lg[jj] = LG[(lane < 8 ? rid : 0) * 36 + jj];
        int grp = 0; float gm = lg[0];
#pragma unroll
        for (int j = 1; j < 4; ++j) if (lg[j] > gm) { gm = lg[j]; grp = j; }
        float gz = 0.f;
#pragma unroll
        for (int j = 0; j < 4; ++j) gz += __expf(lg[j] - gm);
        const float pg = 1.0f / gz;
        float el[8];
#pragma unroll
        for (int i = 0; i < 8; ++i) el[i] = grp == 0 ? lg[4 + i] : grp == 1 ? lg[12 + i] : grp == 2 ? lg[20 + i] : lg[28 + i];
        int i1 = 0; float m1 = el[0];
#pragma unroll
        for (int i = 1; i < 8; ++i) if (el[i] > m1) { m1 = el[i]; i1 = i; }
        int i2 = -1; float m2 = -3.0e38f;
#pragma unroll
        for (int i = 0; i < 8; ++i) if (i != i1 && el[i] > m2) { m2 = el[i]; i2 = i; }
        const float e2 = __expf(m2 - m1), den = 1.0f / (1.0f + e2);
        if (lane < 8) { const int tok = row0 + rid;
            const int ea = grp * 8 + i1, eb = grp * 8 + i2;
            const unsigned pa = __hip_atomic_fetch_add(CNT + 64 * ea, 1u, RLX_AGENT); SLOT[ea * 16384 + pa] = tok * 2;     GATEW[tok * 2] = pg * den;
            const unsigned pb = __hip_atomic_fetch_add(CNT + 64 * eb, 1u, RLX_AGENT); SLOT[eb * 16384 + pb] = tok * 2 + 1; GATEW[tok * 2 + 1] = pg * e2 * den; }
    }
}

__device__ __forceinline__ void build_tiles(const Args& a, Frame& F) {
    LAS int* T = (LAS int*)(F.lds + TBL_OFF); unsigned* CNT = (unsigned*)(a.ws + WS_CTL) + CW_CNT;
    if (F.tid < 32) T[F.tid] = (int)__hip_atomic_load(CNT + 64 * F.tid, RLX_AGENT);
    __syncthreads();
    if (F.tid == 0) { int acc = 0;
        for (int e = 0; e < 32; ++e) { const int n = (T[e] + 255) >> 8; T[32 + e] = acc; for (int t = 0; t < n; ++t) T[96 + acc + t] = e; acc += n; }
        T[64] = acc; }
    __syncthreads();
}
__device__ __forceinline__ void p7_gather(const Args& a, Frame& F) {
    build_tiles(a, F);
    const LAS int* T = (const LAS int*)(F.lds + TBL_OFF);
    const bf16* ML = (const bf16*)(a.ws + WS_RB); bf16* XG = (bf16*)(a.ws + WS_RA); const int* SLOT = (const int*)(a.ws + WS_SLOT); int* SMAP = (int*)(a.ws + WS_SMAP);
    const int nrows = T[64] * 256;
    for (int sr = F.bid * NWAVES + F.wave; sr < nrows; sr += F.G * NWAVES) {
        const int e = T[96 + (sr >> 8)], pos = sr - T[32 + e] * 256;
        v4u x0 = (v4u){0u, 0u, 0u, 0u}, x1 = x0; int asg = -1;
        if (pos < T[e]) { asg = SLOT[e * 16384 + pos]; const v4u* s = (const v4u*)(ML + (size_t)(asg >> 1) * 1024); x0 = s[F.lane]; x1 = s[64 + F.lane]; }
        v4u* d = (v4u*)(XG + (size_t)sr * 1024); d[F.lane] = x0; d[64 + F.lane] = x1;
        if (F.lane == 0) SMAP[sr] = asg;
    }
}
__device__ __forceinline__ void p10_final(const Args& a, Frame& F) {
    float* X1 = a.out; const float* MOD = (const float*)(a.ws + WS_MOD); const bf16* YA = (const bf16*)(a.ws + WS_RA); const float* fng = a.in[I_FNG];
    const int lane = F.lane;
    for (int t = F.bid * NWAVES + F.wave; t < NTOK; t += F.G * NWAVES) {
        const int b = t >> 11; f32x4 v[4]; float ss = 0.f;
#pragma unroll
        for (int j = 0; j < 4; ++j) { const int col = 4 * lane + 256 * j;
            const f32x4 x = *(const f32x4*)(X1 + (size_t)t * 1024 + col), g2 = *(const f32x4*)(MOD + (size_t)b * 6144 + 5120 + col);
            const v2u ya = *(const v2u*)(YA + (size_t)(2 * t) * 1024 + col), yb = *(const v2u*)(YA + (size_t)(2 * t + 1) * 1024 + col);
            f32x4 y; y.x = bflo(ya.x) + bflo(yb.x); y.y = bfhi(ya.x) + bfhi(yb.x); y.z = bflo(ya.y) + bflo(yb.y); y.w = bfhi(ya.y) + bfhi(yb.y);
            v[j] = x + g2 * y; ss += (v[j].x * v[j].x + v[j].y * v[j].y) + (v[j].z * v[j].z + v[j].w * v[j].w); }
        const float rstd = 1.0f / sqrtf(wave_sum(ss) * (1.0f / 1024.0f) + NORM_EPS);
#pragma unroll
        for (int j = 0; j < 4; ++j) { const int col = 4 * lane + 256 * j; const f32x4 g = *(const f32x4*)(fng + col);
            *(f32x4*)(X1 + (size_t)t * 1024 + col) = (v[j] * rstd) * g; }
    }
}

__global__ void __launch_bounds__(NWAVES * 64, 2) mk_fwd(Args a) {
    extern __shared__ __attribute__((aligned(16))) unsigned char lds_raw[];
    Frame F; F.lds = (LAS unsigned char*)lds_raw; F.tid = threadIdx.x; F.lane = F.tid & 63; F.wave = __builtin_amdgcn_readfirstlane(F.tid >> 6); F.G = gridDim.x; F.bid = blockIdx.x;
    for (int u = F.tid; u < (LDS_BYTES - LDSCTL_OFF) / 4; u += NWAVES * 64) ((LAS unsigned*)(F.lds + LDSCTL_OFF))[u] = 0u;
    __syncthreads();
    const int lo = a.ph_lo, hi = a.ph_hi;
    XcdBarrier bar; bar.bar = (unsigned*)(a.ws + WS_CTL) + CW_BAR; bar.x = 0; bar.st = nullptr;
    if (hi - lo > 1) bar = xcd_barrier_post((unsigned*)(a.ws + WS_CTL) + CW_BAR, (volatile LAS unsigned*)(F.lds + LDSCTL_OFF) + 8);
#ifndef PHMASK
#define PHMASK 0x7ff
#endif
#define IN(k) (((PHMASK >> (k)) & 1) && lo <= (k) && (k) < hi)
#define SEAM(k) do { if (IN(k) && IN((k) + 1)) xcd_barrier(bar); } while (0)

    if (IN(0)) { p0_prep(a, F); } SEAM(0);
    if (IN(1)) { p1_norm(a, F); } SEAM(1);
    if (IN(2)) {
        pg8::Gemm g{(const bf16*)(a.ws + WS_RB), (const bf16*)(a.ws + WS_WIN), NTOK + NCTX, DIN, DM}; pg8::OrderInProj S{F.G, F.bid};
        pg8::EpiInProj E{(bf16*)(a.ws + WS_RA), (bf16*)(a.ws + WS_ZC)};
        pg8::gemm_phase<pg8::EpiInProj, pg8::OrderInProj, true, true>(F.lds, g, S, E); }
    SEAM(2);
    if (IN(3)) {
        for (int it = F.bid; it < 256; it += F.G) yconv_item(a, F, it >> 5, it & 31);
        for (int t = F.bid; t < NB * 8 * 36; t += F.G) { const int vc = t % 36, bh = t / 36; scan_tile<false>(a, F, bh >> 3, bh & 7, vc); } }
    SEAM(3);
    if (IN(4)) {
        for (int t = F.bid; t < NB * 8 * 32; t += F.G) { const int vc = 4 + (t & 31), bh = t >> 5; scan_tile<true>(a, F, bh >> 3, bh & 7, vc); } }
    SEAM(4);
    if (IN(5)) {
        pg8::Gemm g{(const bf16*)(a.ws + WS_RB), (const bf16*)(a.ws + WS_WOUT), NTOK, DM, DM}; pg8::StaticOrder S; S.init(NTOK, DM, F.G, F.bid);
        pg8::EpiOutProj E{a.in[I_X], a.out, (const float*)(a.ws + WS_MOD)};
        pg8::gemm_phase<pg8::EpiOutProj, pg8::StaticOrder, true, true>(F.lds, g, S, E); }
    SEAM(5);
    if (IN(6)) { p6_route(a, F); } SEAM(6);
    if (IN(7)) { p7_gather(a, F); } SEAM(7);
    if (IN(8)) {
        build_tiles(a, F); const LAS int* T = (const LAS int*)(F.lds + TBL_OFF);
        pg8::Gemm g{(const bf16*)(a.ws + WS_RA), (const bf16*)(a.ws + WS_WGU), 0, 0, DM}; pg8::OrderMoE S{F.G, F.bid, T[64] * 4, T + 96};
        pg8::EpiGateUp E{(bf16*)(a.ws + WS_RB)};
        pg8::gemm_phase<pg8::EpiGateUp, pg8::OrderMoE, true, true>(F.lds, g, S, E); }
    SEAM(8);
    if (IN(9)) {
        build_tiles(a, F); const LAS int* T = (const LAS int*)(F.lds + TBL_OFF);
        pg8::Gemm g{(const bf16*)(a.ws + WS_RB), (const bf16*)(a.ws + WS_WD), 0, 0, 512}; pg8::OrderMoE S{F.G, F.bid, T[64] * 4, T + 96};
        pg8::EpiDown E{(bf16*)(a.ws + WS_RA), (const int*)(a.ws + WS_SMAP), (const float*)(a.ws + WS_GATEW)};
        pg8::gemm_phase<pg8::EpiDown, pg8::OrderMoE, true, true>(F.lds, g, S, E); }
    SEAM(9);
    if (IN(10)) { p10_final(a, F); }
#undef IN
#undef SEAM
}

extern "C" void kernel_launch(void* const* d_in, const int* in_sizes, int n_in, void* d_out, int out_size, void* d_ws, size_t ws_size, hipStream_t stream) {
    static int grid = 0;
    if (grid == 0) {
        if (n_in != N_IN || out_size != NTOK * DM || ws_size < WS_END) { fprintf(stderr, "kernel_launch: unexpected shapes: n_in %d out %d ws %zu (need %zu)\n", n_in, out_size, ws_size, (size_t)WS_END); grid = -1; return; }
        int dev = 0, cus = 0, per_cu = 0;
        if (hipGetDevice(&dev) != hipSuccess || hipDeviceGetAttribute(&cus, hipDeviceAttributeMultiprocessorCount, dev) != hipSuccess) { grid = -1; return; }
        if (hipFuncSetAttribute((const void*)mk_fwd, hipFuncAttributeMaxDynamicSharedMemorySize, LDS_BYTES) != hipSuccess) { fprintf(stderr, "kernel_launch: hipFuncSetAttribute failed\n"); grid = -1; return; }
        if (hipOccupancyMaxActiveBlocksPerMultiprocessor(&per_cu, (const void*)mk_fwd, NWAVES * 64, LDS_BYTES) != hipSuccess || per_cu < 1) { fprintf(stderr, "kernel_launch: occupancy query says %d blocks per CU\n", per_cu); (void)hipGetLastError(); grid = -1; return; }
        grid = cus;
        if (grid > 256) grid = 256;
    }
    if (grid < 0) return;
    (void)hipMemsetAsync((char*)d_ws + WS_CTL, 0, CTL_ZERO_BYTES, stream);
    Args a{};
    for (int i = 0; i < N_IN; ++i) a.in[i] = (const float*)d_in[i];
    a.out = (float*)d_out; a.ws = (unsigned char*)d_ws;
    if (MK_N_LAUNCHES == 1) {
        a.ph_lo = 0; a.ph_hi = N_PHASES;
        void* args[] = {&a};
        hipError_t e = hipLaunchCooperativeKernel((const void*)mk_fwd, dim3(grid), dim3(NWAVES * 64), args, LDS_BYTES, stream);
        if (e != hipSuccess) fprintf(stderr, "kernel_launch: cooperative launch failed: %s (grid %d)\n", hipGetErrorString(e), grid);
    } else {
        for (int p = 0; p < N_PHASES; ++p) { a.ph_lo = p; a.ph_hi = p + 1; hipLaunchKernelGGL(mk_fwd, dim3(grid), dim3(NWAVES * 64), LDS_BYTES, stream, a); }
    }
}
```

```cpp
#define MK_N_LAUNCHES 1
#include <hip/hip_runtime.h>
#include <cstdio>
#include <cstdint>
namespace pg8 {
#define PG8_LAS __attribute__((address_space(3)))
typedef unsigned short bf16_t;
typedef short bf16x8 __attribute__((ext_vector_type(8)));
typedef float f32x4 __attribute__((ext_vector_type(4)));
typedef unsigned u32x4 __attribute__((ext_vector_type(4)));
constexpr int BM = 256, BK = 64, HALF = 128, HTB = HALF * BK * 2  , STAGE_BYTES = 8 * HTB, NXCD = 8, WGM = 8;

__host__ __device__ __forceinline__ int lds_byte(int r, int c) { const int st = (r >> 4) * 2 + (c >> 5), rr = r & 15, cc = c & 31, ob = rr * 64 + cc * 2; return st * 1024 + (ob ^ (((ob >> 9) & 1) << 5)); }
__host__ __device__ __forceinline__ void stage_rc(int b, int& R, int& C) { const int st = b / 1024, sb = b % 1024, swz = sb ^ (((sb >> 9) & 1) << 5); R = (st >> 1) * 16 + swz / 64; C = (st & 1) * 32 + (swz % 64) / 2; }
__host__ __device__ __forceinline__ int perm32(int rho) { const int n = rho >> 4, i = rho & 15; return 8 * (i >> 2) + 4 * n + (i & 3); }

struct Unit { int pm, pn; };
struct Gemm { const bf16_t* A; const bf16_t* Bt; int M, N, K; };

struct StaticOrder {
    int nM, nN, nwg, G, c;
    __host__ __device__ void init(int M, int N, int G_, int c_) { nM = M / BM; nN = N / BM; nwg = nM * nN; G = G_; c = c_; }
    __host__ __device__ bool next(int i, Unit& u) const {
        const long L = (long)i * G + c; if (L >= nwg) return false;
        int wgid = (int)L; { const int q = nwg / NXCD, r = nwg % NXCD, xcd = wgid % NXCD, off = wgid / NXCD; wgid = (xcd < r ? xcd * (q + 1) : r * (q + 1) + (xcd - r) * q) + off; }
        const int nig = WGM * nN, gid = wgid / nig, fm = gid * WGM, gsz = (nM - fm) < WGM ? (nM - fm) : WGM;
        u.pm = fm + ((wgid % nig) % gsz); u.pn = (wgid % nig) / gsz; return true;
    }
    __device__ __forceinline__ void a_ready(const Unit&) const {}
    __device__ __forceinline__ void done(const Unit&) const {}
};
__device__ __forceinline__ unsigned cvt_pk_bf16(float lo, float hi) { unsigned r; asm volatile("v_cvt_pk_bf16_f32 %0, %1, %2" : "=v"(r) : "v"(lo), "v"(hi)); return r; }
struct EpiInProj {
    static constexpr bool PERM = true, AFTER_DRAIN = false;
    bf16_t* Z; bf16_t* Zc;
    __device__ __forceinline__ void operator()(const f32x4 (&acc)[2][2][4][2], const Unit& u, int wr, int wc, int fr, int fq) const {
        const bool isctx = u.pm >= 64;
        bf16_t* base = isctx ? Zc : Z; const int ldc = isctx ? 512 : 2560; const int prow = isctx ? u.pm - 64 : u.pm;
        const int row0 = prow * BM + wr * 64 + fr, col0 = u.pn * BM + wc * 32 + 8 * fq;
#pragma unroll
        for (int ai = 0; ai < 2; ++ai)
#pragma unroll
            for (int m = 0; m < 4; ++m) { bf16_t* rowp = base + (size_t)(row0 + ai * HALF + m * 16) * ldc + col0;
#pragma unroll
                for (int bj = 0; bj < 2; ++bj) { const f32x4 v0 = acc[ai][bj][m][0], v1 = acc[ai][bj][m][1];
                    u32x4 w; w.x = cvt_pk_bf16(v0[0], v0[1]); w.y = cvt_pk_bf16(v0[2], v0[3]); w.z = cvt_pk_bf16(v1[0], v1[1]); w.w = cvt_pk_bf16(v1[2], v1[3]);
                    *(u32x4*)(rowp + bj * HALF) = w; } }
    }
};
struct EpiOutProj {
    static constexpr bool PERM = false, AFTER_DRAIN = false;
    const float* x; float* X1; const float* mod;
    __device__ __forceinline__ void operator()(const f32x4 (&acc)[2][2][4][2], const Unit& u, int wr, int wc, int fr, int fq) const {
        const int b = u.pm >> 3;
        const int row0 = u.pm * BM + wr * 64 + fr, col0 = u.pn * BM + wc * 32 + 4 * fq;
        f32x4 gv[2][2];
#pragma unroll
        for (int bj = 0; bj < 2; ++bj)
#pragma unroll
            for (int n = 0; n < 2; ++n) gv[bj][n] = *(const f32x4*)(mod + (size_t)b * 6144 + 2048 + col0 + bj * HALF + n * 16);
#pragma unroll
        for (int ai = 0; ai < 2; ++ai)
#pragma unroll
            for (int m = 0; m < 4; ++m) { const size_t off = (size_t)(row0 + ai * HALF + m * 16) * 1024 + col0;
#pragma unroll
                for (int bj = 0; bj < 2; ++bj)
#pragma unroll
                    for (int n = 0; n < 2; ++n) { const f32x4 xv = *(const f32x4*)(x + off + bj * HALF + n * 16);
                        *(f32x4*)(X1 + off + bj * HALF + n * 16) = xv + gv[bj][n] * acc[ai][bj][m][n]; } }
    }
};
__device__ __forceinline__ float silu_f(float g) { return g * __builtin_amdgcn_rcpf(1.0f + __builtin_amdgcn_exp2f(-1.4426950408889634f * g)); }
struct EpiGateUp {
    static constexpr bool PERM = true, AFTER_DRAIN = false;
    bf16_t* H;
    __device__ __forceinline__ void operator()(const f32x4 (&acc)[2][2][4][2], const Unit& u, int wr, int wc, int fr, int fq) const {
        const int row0 = u.pm * BM + wr * 64 + fr, col0 = (u.pn & 3) * 128 + wc * 32 + 8 * fq;
#pragma unroll
        for (int ai = 0; ai < 2; ++ai)
#pragma unroll
            for (int m = 0; m < 4; ++m) { bf16_t* rowp = H + (size_t)(row0 + ai * HALF + m * 16) * 512 + col0;
                const f32x4 g0 = acc[ai][0][m][0], g1 = acc[ai][0][m][1], u0 = acc[ai][1][m][0], u1 = acc[ai][1][m][1];
                u32x4 w;
                w.x = cvt_pk_bf16(silu_f(g0[0]) * u0[0], silu_f(g0[1]) * u0[1]); w.y = cvt_pk_bf16(silu_f(g0[2]) * u0[2], silu_f(g0[3]) * u0[3]);
                w.z = cvt_pk_bf16(silu_f(g1[0]) * u1[0], silu_f(g1[1]) * u1[1]); w.w = cvt_pk_bf16(silu_f(g1[2]) * u1[2], silu_f(g1[3]) * u1[3]);
                *(u32x4*)rowp = w; }
    }
};
struct EpiDown {
    static constexpr bool PERM = true, AFTER_DRAIN = false;
    bf16_t* YA; const int* slotmap; const float* gatew;
    __device__ __forceinline__ void operator()(const f32x4 (&acc)[2][2][4][2], const Unit& u, int wr, int wc, int fr, int fq) const {
        const int row0 = u.pm * BM + wr * 64 + fr, col0 = (u.pn & 3) * BM + wc * 32 + 8 * fq;
#pragma unroll
        for (int ai = 0; ai < 2; ++ai)
#pragma unroll
            for (int m = 0; m < 4; ++m) { const int asg = slotmap[row0 + ai * HALF + m * 16];
                if (asg >= 0) { const float gw = gatew[asg]; bf16_t* rowp = YA + (size_t)asg * 1024 + col0;
#pragma unroll
                    for (int bj = 0; bj < 2; ++bj) { const f32x4 v0 = acc[ai][bj][m][0] * gw, v1 = acc[ai][bj][m][1] * gw;
                        u32x4 w; w.x = cvt_pk_bf16(v0[0], v0[1]); w.y = cvt_pk_bf16(v0[2], v0[3]); w.z = cvt_pk_bf16(v1[0], v1[1]); w.w = cvt_pk_bf16(v1[2], v1[3]);
                        *(u32x4*)(rowp + bj * HALF) = w; } } }
    }
};
struct OrderInProj {
    int G, c;
    __device__ __forceinline__ bool next(int i, Unit& u) const {
        const long L = (long)i * G + c; if (L >= 656) return false;
        if (L < 640) { int wgid = (int)L; const int xcd = wgid % NXCD, off = wgid / NXCD; wgid = xcd * 80 + off;
            const int nig = WGM * 10; const int fm = (wgid / nig) * WGM; u.pm = fm + ((wgid % nig) % WGM); u.pn = (wgid % nig) / WGM; }
        else { const int j = (int)L - 640; u.pm = 64 + (j >> 1); u.pn = j & 1; }
        return true;
    }
    __device__ __forceinline__ void a_ready(const Unit&) const {}
    __device__ __forceinline__ void done(const Unit&) const {}
};
struct OrderMoE {
    int G, c, NU; const PG8_LAS int* TE;
    __device__ __forceinline__ bool next(int i, Unit& u) const {
        const long L = (long)i * G + c; if (L >= NU) return false;
        const int q = NU / NXCD, r = NU % NXCD, xcd = (int)(L % NXCD), off = (int)(L / NXCD);
        const int id = (xcd < r ? xcd * (q + 1) : r * (q + 1) + (xcd - r) * q) + off;
        const int tile = id >> 2; u.pm = tile; u.pn = __builtin_amdgcn_readfirstlane(TE[tile]) * 4 + (id & 3); return true;
    }
    __device__ __forceinline__ void a_ready(const Unit&) const {}
    __device__ __forceinline__ void done(const Unit&) const {}
};
template <class Epi, class Sched, bool ALIGN_EPI = false, bool SP2 = false>
__device__ __forceinline__ void gemm_phase(PG8_LAS unsigned char* lds, const Gemm g, const Sched& S, const Epi& E) {
    const int tid = threadIdx.x, wid = __builtin_amdgcn_readfirstlane(tid >> 6), lane = tid & 63, wr = wid >> 2, wc = wid & 3, fr = lane & 15, fq = lane >> 4;
    const int K = g.K, nt = K / BK;
    unsigned voffA[2], voffB[2];
#pragma unroll
    for (int i = 0; i < 2; ++i) { int R, C; stage_rc(tid * 16 + i * 8192, R, C); const int Rb = Epi::PERM ? ((R & ~31) + perm32(R & 31)) : R;
        voffA[i] = (unsigned)(R * K + C) * 2u; voffB[i] = (unsigned)(Rb * K + C) * 2u; }
    const size_t kstep = (size_t)(BK * 2);
    const size_t hstep = (size_t)HALF * K * 2;
    const size_t tstep = 2 * hstep;
    const unsigned ldsw = (unsigned)wid * 1024u;
    const int aoff = lds_byte(wr * 64 + fr, fq * 8), boff = lds_byte(wc * 32 + fr, fq * 8);
#define PG8_SA(b, h) (((b) * 2 + (h)) * HTB)
#define PG8_SB(b, h) ((4 + (b) * 2 + (h)) * HTB)
#define PG8_STAGE(bufoff, gbase, voff) do { _Pragma("unroll") for (int _i = 0; _i < 2; ++_i) \
        __builtin_amdgcn_global_load_lds((const unsigned*)((const char*)(gbase) + (voff)[_i]), (PG8_LAS unsigned*)(lds + (bufoff) + ldsw + _i * 8192), 16, 0, 0); } while (0)
#define PG8_LDA(dst, b, h) do { _Pragma("unroll") for (int m = 0; m < 4; ++m) _Pragma("unroll") for (int k = 0; k < 2; ++k) dst[m][k] = *(const PG8_LAS bf16x8*)(lds + PG8_SA(b, h) + aoff + m * 2048 + k * 1024); } while (0)
#define PG8_LDB(dst, b, h) do { _Pragma("unroll") for (int n = 0; n < 2; ++n) _Pragma("unroll") for (int k = 0; k < 2; ++k) dst[n][k] = *(const PG8_LAS bf16x8*)(lds + PG8_SB(b, h) + boff + n * 2048 + k * 1024); } while (0)
#define PG8_MMA(ai, bj, At, Bt) do { __builtin_amdgcn_s_setprio(1); _Pragma("unroll") for (int m = 0; m < 4; ++m) _Pragma("unroll") for (int n = 0; n < 2; ++n) _Pragma("unroll") for (int k = 0; k < 2; ++k) \
        acc[ai][bj][m][n] = __builtin_amdgcn_mfma_f32_16x16x32_bf16(Bt[n][k], At[m][k], acc[ai][bj][m][n], 0, 0, 0); __builtin_amdgcn_s_setprio(0); } while (0)
#define PG8_WAIT_V(n) asm volatile("s_waitcnt vmcnt(" #n ")" ::: "memory")
#define PG8_WAIT_L(n) asm volatile("s_waitcnt lgkmcnt(" #n ")" ::: "memory")
#define PG8_BAR __builtin_amdgcn_s_barrier()
#define PG8_SCHED __builtin_amdgcn_sched_barrier(0)
    Unit cur, nxt; int ui = 0;
    if (!S.next(0, cur)) return;
    f32x4 acc[2][2][4][2];
#pragma unroll
    for (int a = 0; a < 2; ++a)
#pragma unroll
        for (int b = 0; b < 2; ++b)
#pragma unroll
            for (int m = 0; m < 4; ++m)
#pragma unroll
                for (int n = 0; n < 2; ++n) acc[a][b][m][n] = (f32x4){0.f, 0.f, 0.f, 0.f};
    bf16x8 At[4][2], B0[2][2], B1[2][2];
    const char* cA = (const char*)g.A + (size_t)cur.pm * tstep; const char* cB = (const char*)g.Bt + (size_t)cur.pn * tstep;
    S.a_ready(cur);
    if constexpr (SP2) {
        PG8_STAGE(PG8_SB(0, 0), cB, voffB); PG8_STAGE(PG8_SB(0, 1), cB + hstep, voffB); PG8_STAGE(PG8_SA(0, 0), cA, voffA); PG8_STAGE(PG8_SA(0, 1), cA + hstep, voffA);
        if (wr == 1) PG8_BAR;
        PG8_WAIT_V(2); PG8_BAR;
        PG8_STAGE(PG8_SB(1, 0), cB + kstep, voffB); PG8_STAGE(PG8_SA(1, 0), cA + kstep, voffA); PG8_STAGE(PG8_SB(1, 1), cB + hstep + kstep, voffB);
        PG8_WAIT_V(6); PG8_BAR;
    } else {
        PG8_STAGE(PG8_SB(0, 0), cB, voffB); PG8_STAGE(PG8_SA(0, 0), cA, voffA); PG8_STAGE(PG8_SB(0, 1), cB + hstep, voffB); PG8_STAGE(PG8_SA(0, 1), cA + hstep, voffA);
        if (wr == 1) PG8_BAR;
        PG8_WAIT_V(4); PG8_BAR;
        PG8_STAGE(PG8_SB(1, 0), cB + kstep, voffB); PG8_STAGE(PG8_SA(1, 0), cA + kstep, voffA); PG8_STAGE(PG8_SB(1, 1), cB + hstep + kstep, voffB);
        PG8_WAIT_V(6); PG8_BAR;
    }
    for (;;) {
        const bool has_next = S.next(ui + 1, nxt);
        const char* nA = has_next ? (const char*)g.A + (size_t)nxt.pm * tstep : cA; const char* nB = has_next ? (const char*)g.Bt + (size_t)nxt.pn * tstep : cB;
        for (int t = 0; t < nt; t += 2) {
            const bool last = (t == nt - 2);
            const char* a1 = cA + (size_t)(t + 1) * kstep;
            const char* a2 = last ? nA : cA + (size_t)(t + 2) * kstep; const char* b2 = last ? nB : cB + (size_t)(t + 2) * kstep;
            const char* a3 = a2 + kstep; const char* b3 = b2 + kstep;
            if (last && has_next) S.a_ready(nxt);
            if constexpr (SP2) {
            PG8_LDB(B0, 0, 0); PG8_LDB(B1, 0, 1); PG8_SCHED; PG8_LDA(At, 0, 0); PG8_STAGE(PG8_SA(1, 1), a1 + hstep, voffA);
            PG8_WAIT_V(8); PG8_WAIT_L(0); PG8_BAR; PG8_MMA(0, 0, At, B0); PG8_MMA(0, 1, At, B1); PG8_BAR; PG8_SCHED;
            PG8_LDA(At, 0, 1); PG8_STAGE(PG8_SB(0, 0), b2, voffB); PG8_STAGE(PG8_SB(0, 1), b2 + hstep, voffB); PG8_STAGE(PG8_SA(0, 0), a2, voffA);
            PG8_WAIT_V(8); PG8_WAIT_L(0); PG8_BAR; PG8_MMA(1, 0, At, B0); PG8_MMA(1, 1, At, B1); PG8_BAR; PG8_SCHED;
            PG8_LDB(B0, 1, 0); PG8_LDB(B1, 1, 1); PG8_SCHED; PG8_LDA(At, 1, 0); PG8_STAGE(PG8_SA(0, 1), a2 + hstep, voffA);
            PG8_WAIT_V(8); PG8_WAIT_L(0); PG8_BAR; PG8_MMA(0, 0, At, B0); PG8_MMA(0, 1, At, B1); PG8_BAR; PG8_SCHED;
            PG8_LDA(At, 1, 1); PG8_STAGE(PG8_SB(1, 0), b3, voffB); PG8_STAGE(PG8_SB(1, 1), b3 + hstep, voffB); PG8_STAGE(PG8_SA(1, 0), a3, voffA);
            PG8_WAIT_V(8); PG8_WAIT_L(0); PG8_BAR; PG8_MMA(1, 0, At, B0); PG8_MMA(1, 1, At, B1); PG8_BAR; PG8_SCHED;
            } else {
            PG8_LDB(B0, 0, 0); PG8_SCHED; PG8_LDA(At, 0, 0); PG8_STAGE(PG8_SA(1, 1), a1 + hstep, voffA);
            PG8_WAIT_L(8); PG8_BAR; PG8_WAIT_L(0); PG8_MMA(0, 0, At, B0); PG8_BAR; PG8_SCHED;
            PG8_LDB(B1, 0, 1); PG8_STAGE(PG8_SB(0, 0), b2, voffB);
            PG8_BAR; PG8_WAIT_L(0); PG8_MMA(0, 1, At, B1); PG8_BAR;
            PG8_LDA(At, 0, 1); PG8_STAGE(PG8_SA(0, 0), a2, voffA);
            PG8_BAR; PG8_WAIT_L(0); PG8_MMA(1, 0, At, B0); PG8_BAR; PG8_SCHED;
            PG8_STAGE(PG8_SB(0, 1), b2 + hstep, voffB);
            PG8_WAIT_V(6); PG8_BAR; PG8_MMA(1, 1, At, B1); PG8_BAR;
            PG8_LDB(B0, 1, 0); PG8_SCHED; PG8_LDA(At, 1, 0); PG8_STAGE(PG8_SA(0, 1), a2 + hstep, voffA);
            PG8_WAIT_L(8); PG8_BAR; PG8_WAIT_L(0); PG8_MMA(0, 0, At, B0); PG8_BAR; PG8_SCHED;
            PG8_LDB(B1, 1, 1); PG8_STAGE(PG8_SB(1, 0), b3, voffB);
            PG8_BAR; PG8_WAIT_L(0); PG8_MMA(0, 1, At, B1); PG8_BAR;
            PG8_LDA(At, 1, 1); PG8_STAGE(PG8_SA(1, 0), a3, voffA);
            PG8_BAR; PG8_WAIT_L(0); PG8_MMA(1, 0, At, B0); PG8_BAR; PG8_SCHED;
            PG8_STAGE(PG8_SB(1, 1), b3 + hstep, voffB);
            PG8_WAIT_V(6); PG8_BAR; PG8_MMA(1, 1, At, B1); PG8_BAR;
            }
        }
        if constexpr (ALIGN_EPI) { if (wr == 0) PG8_BAR; }
        if constexpr (!Epi::AFTER_DRAIN) { E(acc, cur, wr, wc, fr, fq); S.done(cur); }
        if (!has_next) break;
#pragma unroll
        for (int a = 0; a < 2; ++a)
#pragma unroll
            for (int b = 0; b < 2; ++b)
#pragma unroll
                for (int m = 0; m < 4; ++m)
#pragma unroll
                    for (int n = 0; n < 2; ++n) acc[a][b][m][n] = (f32x4){0.f, 0.f, 0.f, 0.f};
        cur = nxt; cA = nA; cB = nB; ++ui;
        if constexpr (ALIGN_EPI) { if (wr == 1) PG8_BAR; }
    }
    PG8_WAIT_V(0);
    if constexpr (!ALIGN_EPI) { if (wr == 0) PG8_BAR; }
    PG8_BAR;
    if constexpr (Epi::AFTER_DRAIN) { E.fused(acc, cur, wr, wc, fr, fq, lds, wid, lane); S.done(cur); }
#undef PG8_SA
#undef PG8_SB
#undef PG8_STAGE
#undef PG8_LDA
#undef PG8_LDB
#undef PG8_MMA
#undef PG8_WAIT_V
#undef PG8_WAIT_L
#undef PG8_BAR
#undef PG8_SCHED
}
}

#ifndef MK_N_LAUNCHES
#define MK_N_LAUNCHES 1
#endif
constexpr int N_PHASES = 11;
constexpr int NWAVES = 8;
#define GAS __attribute__((address_space(1)))
#define LAS __attribute__((address_space(3)))
typedef unsigned short bf16;
typedef unsigned v4u __attribute__((ext_vector_type(4)));
typedef unsigned v2u __attribute__((ext_vector_type(2)));
typedef float f32x4 __attribute__((ext_vector_type(4)));
typedef float f32x16 __attribute__((ext_vector_type(16)));
typedef short bf16x8 __attribute__((ext_vector_type(8)));
#define LDS_WAIT() asm volatile("s_waitcnt lgkmcnt(0)" ::: "memory")
#define RLX_AGENT __ATOMIC_RELAXED, __HIP_MEMORY_SCOPE_AGENT

constexpr int NB = 8, SEQ = 2048, DM = 1024, CTXL = 256, NTOK = NB * SEQ, NCTX = NB * CTXL, DIN = 2560, NEXP = 32;
constexpr float NORM_EPS = 1e-6f;
enum { I_X = 0, I_C, I_CTX, I_CCTX, I_ADAW, I_ADAB, I_N1G, I_N2G, I_WIN, I_RCW, I_RCB, I_RGWA, I_RGBA, I_RGWX, I_RGBX, I_RGLAM, I_SCW, I_WOUT, I_RGRW, I_RGRB, I_REW, I_REB, I_EWG, I_EWU, I_EWD, I_FNG, N_IN };

constexpr size_t MiB = 1u << 20;
constexpr size_t WS_CTL = 0, CTL_ZERO_BYTES = 1 * MiB;
constexpr size_t WS_MODP = 1 * MiB;
constexpr size_t WS_MOD = 5 * MiB;
constexpr size_t WS_WRT = 5 * MiB + 512 * 1024;
constexpr size_t WS_WRG = 5 * MiB + 768 * 1024;
constexpr size_t WS_WIN = 6 * MiB;
constexpr size_t WS_WOUT = 11 * MiB;
constexpr size_t WS_WGU = 13 * MiB;
constexpr size_t WS_WD = 77 * MiB;
constexpr size_t WS_AGG = 109 * MiB;
constexpr size_t WS_SLOT = 112 * MiB;
constexpr size_t WS_GATEW = 114 * MiB;
constexpr size_t WS_SMAP = 114 * MiB + 256 * 1024;
constexpr size_t WS_RA = 115 * MiB;
constexpr size_t WS_ZC = WS_RA + 80 * MiB;
constexpr size_t WS_RB = 197 * MiB;
constexpr size_t WS_END = 237 * MiB;
constexpr int CW_BAR = 4096;
constexpr int CW_CNT = 16384;
constexpr int RING_BYTES = 131072, LDSCTL_OFF = 133120, TBL_OFF = LDSCTL_OFF + 512, LDS_BYTES = 147456;

__device__ __forceinline__ float bflo(unsigned w) { return __uint_as_float(w << 16); }
__device__ __forceinline__ float bfhi(unsigned w) { return __uint_as_float(w & 0xffff0000u); }
__device__ __forceinline__ unsigned pk2(float lo, float hi) { return pg8::cvt_pk_bf16(lo, hi); }
__device__ __forceinline__ float wave_sum(float v) {
#pragma unroll
    for (int o = 1; o < 64; o <<= 1) v += __shfl_xor(v, o);
    return v;
}

#define XB_TMO      128
#define XB_XCNT(j)  (256  + 64 * (j))
#define XB_XSUB(j)  (1280 + 64 * (j))
#define XB_XGEN(j)  (2304 + 64 * (j))
#define XB_TOP      3328
#define XB_TOPGEN   3392
#define XCD_BAR_WORDS 3456
#define XB_SPIN_CAP (1u << 18)
__device__ __forceinline__ unsigned xb_ld(unsigned* p)              { return __hip_atomic_load(p, __ATOMIC_RELAXED, __HIP_MEMORY_SCOPE_AGENT); }
__device__ __forceinline__ unsigned xb_add(unsigned* p, unsigned v) { return __hip_atomic_fetch_add(p, v, __ATOMIC_RELAXED, __HIP_MEMORY_SCOPE_AGENT); }
__device__ __forceinline__ unsigned xb_xcc_id() { return (unsigned)__builtin_amdgcn_s_getreg((3 << 11) | 20) & 0xFu; }
#define XB_SPIN(cond, bar) do { unsigned _sp = 0; while (cond) { __builtin_amdgcn_s_sleep(1); \
    if ((++_sp & 255u) == 0u) { if (xb_ld(&(bar)[XB_TMO])) break; if (_sp > XB_SPIN_CAP) { atomicAdd(&(bar)[XB_TMO], 1u); break; } } } } while (0)
struct XcdBarrier { unsigned* bar; unsigned x; volatile LAS unsigned* st; };
__device__ __forceinline__ XcdBarrier xcd_barrier_post(unsigned* bar, volatile LAS unsigned* st) {
    XcdBarrier b; b.bar = bar; b.x = xb_xcc_id(); b.st = st;
    if (threadIdx.x == 0) (void)xb_add(&bar[XB_XCNT(b.x)], 1u);
    return b;
}
__device__ __forceinline__ void xcd_barrier_complete(unsigned* bar, unsigned x, unsigned& nloc, unsigned& nx) {
    const unsigned G = gridDim.x * gridDim.y * gridDim.z;
    unsigned sum, cnt, mine, sp = 0u;
    for (;;) {
        sum = 0u; cnt = 0u; mine = 0u;
#pragma unroll
        for (unsigned j = 0; j < 16; ++j) { const unsigned c = xb_ld(&bar[XB_XCNT(j)]); sum += c; cnt += (c > 0u) ? 1u : 0u; mine = (j == x) ? c : mine; }
        if (sum == G) break;
        __builtin_amdgcn_s_sleep(1);
        if ((++sp & 255u) == 0u) { if (xb_ld(&bar[XB_TMO])) break; if (sp > XB_SPIN_CAP) { atomicAdd(&bar[XB_TMO], 1u); break; } }
    }
    nloc = mine > 0u ? mine : 1u; nx = cnt > 0u ? cnt : 1u;
}
__device__ __forceinline__ void xcd_barrier(const XcdBarrier& b) {
    asm volatile("s_waitcnt vmcnt(0)" ::: "memory");
    __syncthreads();
    if (threadIdx.x == 0) {
        unsigned* bar = b.bar;
        __builtin_amdgcn_s_waitcnt(0);
        unsigned nloc = b.st[0], nx = b.st[1];
        if (nloc == 0u) { xcd_barrier_complete(bar, b.x, nloc, nx); b.st[0] = nloc; b.st[1] = nx; }
        const unsigned old = xb_add(&bar[XB_XSUB(b.x)], 1u);
        const unsigned gen = old / nloc;
        if (old + 1u == (gen + 1u) * nloc) {
            __builtin_amdgcn_fence(__ATOMIC_RELEASE, "agent");
            asm volatile("s_waitcnt vmcnt(0)" ::: "memory");
            const unsigned og = xb_add(&bar[XB_TOP], 1u);
            const unsigned tg = og / nx;
            if (og + 1u == (tg + 1u) * nx) xb_add(&bar[XB_TOPGEN], 1u);
            else XB_SPIN(xb_ld(&bar[XB_TOPGEN]) == tg, bar);
            __builtin_amdgcn_fence(__ATOMIC_ACQUIRE, "agent");
            xb_add(&bar[XB_XGEN(b.x)], 1u);
            asm volatile("s_waitcnt vmcnt(0)" ::: "memory");
        } else {
            XB_SPIN(xb_ld(&bar[XB_XGEN(b.x)]) == gen, bar);
            __builtin_amdgcn_fence(__ATOMIC_ACQUIRE, "agent");
            asm volatile("s_waitcnt vmcnt(0)" ::: "memory");
        }
    }
    __syncthreads();
}

struct Args { const float* in[N_IN]; float* out; unsigned char* ws; int ph_lo, ph_hi; };
struct Frame { LAS unsigned char* lds; int tid, lane, wave, G, bid; };

struct TrItem { const float* src; bf16* dst; int N, KP; };
__device__ __forceinline__ void tr_load(const TrItem& t, f32x4 (&v)[16]) {
#pragma unroll
    for (int i = 0; i < 16; ++i) v[i] = *(const f32x4*)(t.src + (size_t)(4 * i) * t.N);
}
__device__ __forceinline__ void tr_finish(const TrItem& t, const f32x4 (&v)[16], LAS float* scr, int lane) {
    const int kq = lane >> 4, nb = 4 * (lane & 15);
#pragma unroll
    for (int i = 0; i < 16; ++i) { const int kk = 4 * i + kq;
        scr[(nb + 0) * 65 + kk] = v[i].x; scr[(nb + 1) * 65 + kk] = v[i].y; scr[(nb + 2) * 65 + kk] = v[i].z; scr[(nb + 3) * 65 + kk] = v[i].w; }
    LDS_WAIT(); asm volatile("" ::: "memory");
    const int c = lane & 7;
#pragma unroll
    for (int j = 0; j < 8; ++j) { const int n = (lane >> 3) + 8 * j; const LAS float* sp = scr + n * 65 + 8 * c;
        v4u o; o.x = pk2(sp[0], sp[1]); o.y = pk2(sp[2], sp[3]); o.z = pk2(sp[4], sp[5]); o.w = pk2(sp[6], sp[7]);
        *(v4u*)(t.dst + (size_t)(8 * j) * t.KP) = o; }
    LDS_WAIT(); asm volatile("" ::: "memory");
}
__device__ __forceinline__ void gemv_item(const Args& a, int item, LAS float* scr, int lane) {
    const int ks = item / 24, nb = item % 24, k0 = ks * 64, n0 = nb * 256 + 4 * lane;
    const float* cc = a.in[I_C]; const float* cx = a.in[I_CCTX]; const float* W = a.in[I_ADAW];
#pragma unroll
    for (int r = 0; r < 9; ++r) { const float v = r < 8 ? cc[r * 1024 + k0 + lane] : cx[k0 + lane]; scr[r * 64 + lane] = v / (1.0f + __expf(-v)); }
    LDS_WAIT(); asm volatile("" ::: "memory");
    f32x4 acc[9];
#pragma unroll
    for (int r = 0; r < 9; ++r) acc[r] = (f32x4){0.f, 0.f, 0.f, 0.f};
#pragma unroll 16
    for (int kk = 0; kk < 64; ++kk) { const f32x4 w = *(const f32x4*)(W + (size_t)(k0 + kk) * 6144 + n0);
#pragma unroll
        for (int r = 0; r < 9; ++r) acc[r] += scr[r * 64 + kk] * w; }
    float* MODP = (float*)(a.ws + WS_MODP);
#pragma unroll
    for (int r = 0; r < 9; ++r) *(f32x4*)(MODP + ((size_t)ks * 9 + r) * 6144 + n0) = acc[r];
    LDS_WAIT(); asm volatile("" ::: "memory");
}
constexpr int IT_GEMV = 384, IT_WRT = 72;
constexpr int TT_WIN = 16 * 40, TT_WOUT = 16 * 16, TT_RG = 32, TT_GU = 8192, TT_DOWN = 4096, TT_TOTAL = TT_WIN + TT_WOUT + TT_RG + TT_GU + TT_DOWN;
__device__ __forceinline__ TrItem tr_decode(const Args& a, int r, int lane) {
    const float* W; bf16* WT; int N, KP, drow0, k0, n0;
    if (r < TT_WIN) { const int kb = r / 40, nb = r % 40; W = a.in[I_WIN]; WT = (bf16*)(a.ws + WS_WIN); N = 2560; KP = 1024; drow0 = 64 * nb; k0 = 64 * kb; n0 = 64 * nb; }
    else if (r < TT_WIN + TT_WOUT) { const int q = r - TT_WIN, kb = q >> 4, nb = q & 15; W = a.in[I_WOUT]; WT = (bf16*)(a.ws + WS_WOUT); N = 1024; KP = 1024; drow0 = 64 * nb; k0 = 64 * kb; n0 = 64 * nb; }
    else if (r < TT_WIN + TT_WOUT + TT_RG) { const int mat = r - TT_WIN - TT_WOUT, g = mat >> 4, d = (mat >> 3) & 1, h = mat & 7;
        W = (g ? a.in[I_RGWX] : a.in[I_RGWA]) + (size_t)(d * 8 + h) * 4096; WT = (bf16*)(a.ws + WS_WRG); N = 64; KP = 64; drow0 = h * 256 + d * 128 + g * 64; k0 = 0; n0 = 0; }
    else if (r < TT_WIN + TT_WOUT + TT_RG + TT_GU) { int q = r - TT_WIN - TT_WOUT - TT_RG; const int up = q >> 12; q &= 4095; const int e = q >> 7, it2 = q & 127, kb = it2 >> 3, nb = it2 & 7;
        n0 = 64 * nb; k0 = 64 * kb; W = (up ? a.in[I_EWU] : a.in[I_EWG]) + (size_t)e * 524288; WT = (bf16*)(a.ws + WS_WGU); N = 512; KP = 1024; drow0 = e * 1024 + (n0 >> 7) * 256 + up * 128 + (n0 & 127); }
    else { const int q = r - TT_WIN - TT_WOUT - TT_RG - TT_GU, e = q >> 7, it2 = q & 127, kb = it2 >> 4, nb = it2 & 15;
        n0 = 64 * nb; k0 = 64 * kb; W = a.in[I_EWD] + (size_t)e * 524288; WT = (bf16*)(a.ws + WS_WD); N = 1024; KP = 512; drow0 = e * 1024 + n0; }
    TrItem t; t.N = N; t.KP = KP;
    t.src = W + (size_t)(k0 + (lane >> 4)) * N + n0 + 4 * (lane & 15);
    t.dst = WT + (size_t)(drow0 + (lane >> 3)) * KP + k0 + 8 * (lane & 7);
    return t;
}
__device__ __forceinline__ void p0_prep(const Args& a, Frame& F) {
    LAS float* scr = (LAS float*)(F.lds + F.wave * 16640);
    const int gw = F.wave * F.G + F.bid, NGW = F.G * NWAVES, lane = F.lane;
    float* WrT = (float*)(a.ws + WS_WRT);
    for (int it = gw; it < IT_GEMV + IT_WRT; it += NGW) {
        if (it < IT_GEMV) { gemv_item(a, it, scr, lane); continue; }
        const int r = it - IT_GEMV; const float* rgw = a.in[I_RGRW]; const float* rew = a.in[I_REW];
#pragma unroll
        for (int i = 0; i < 8; ++i) { const int idx = r * 512 + lane + 64 * i, j = idx >> 10, k = idx & 1023; WrT[idx] = j < 4 ? rgw[k * 4 + j] : rew[k * 32 + (j - 4)]; }
    }
    f32x4 vA[16], vB[16]; TrItem tA, tB;
    int it = gw;
    if (it < TT_TOTAL) { tA = tr_decode(a, TT_TOTAL - 1 - it, lane); tr_load(tA, vA); }
    while (it < TT_TOTAL) {
        int it2 = it + NGW;
        if (it2 < TT_TOTAL) { tB = tr_decode(a, TT_TOTAL - 1 - it2, lane); tr_load(tB, vB); }
        tr_finish(tA, vA, scr, lane);
        it = it2; if (it >= TT_TOTAL) break;
        it2 = it + NGW;
        if (it2 < TT_TOTAL) { tA = tr_decode(a, TT_TOTAL - 1 - it2, lane); tr_load(tA, vA); }
        tr_finish(tB, vB, scr, lane);
        it = it2;
    }
}

__device__ __forceinline__ void norm_row_mod(const float* src, bf16* dst, const LAS float* GS, const LAS float* SH, int lane) {
    const f32x4* xr = (const f32x4*)src + lane; f32x4 v[4]; float ss = 0.f;
#pragma unroll
    for (int j = 0; j < 4; ++j) { v[j] = xr[64 * j]; ss += (v[j].x * v[j].x + v[j].y * v[j].y) + (v[j].z * v[j].z + v[j].w * v[j].w); }
    const float rstd = 1.0f / sqrtf(wave_sum(ss) * (1.0f / 1024.0f) + NORM_EPS);
#pragma unroll
    for (int j = 0; j < 4; ++j) { const f32x4 g = *(const LAS f32x4*)(GS + 4 * lane + 256 * j), s = *(const LAS f32x4*)(SH + 4 * lane + 256 * j);
        const f32x4 y = (v[j] * rstd) * g + s; v2u o; o.x = pk2(y.x, y.y); o.y = pk2(y.z, y.w);
        *(v2u*)(dst + 4 * lane + 256 * j) = o; }
}
__device__ __forceinline__ void p1_norm(const Args& a, Frame& F) {
    const float* MODP = (const float*)(a.ws + WS_MODP); float* MOD = (float*)(a.ws + WS_MOD); bf16* XN = (bf16*)(a.ws + WS_RB);
    const float* adab = a.in[I_ADAB]; const float* n1g = a.in[I_N1G];
    LAS float* GS = (LAS float*)F.lds; LAS float* SH = GS + 1024; LAS float* GSC = GS + 2048; LAS float* SHC = GS + 3072;
    for (int blk = F.bid; blk < 256; blk += F.G) {
        const int b = blk >> 5;
        for (int k = F.tid; k < 1024; k += NWAVES * 64) {
            float s_sh = adab[k], s_sc = adab[1024 + k], c_sh = s_sh, c_sc = s_sc;
#pragma unroll 4
            for (int ks = 0; ks < 16; ++ks) { const float* base = MODP + (size_t)ks * 9 * 6144;
                s_sh += base[b * 6144 + k]; s_sc += base[b * 6144 + 1024 + k]; c_sh += base[8 * 6144 + k]; c_sc += base[8 * 6144 + 1024 + k]; }
            const float g = n1g[k]; GS[k] = g * (1.0f + s_sc); SH[k] = s_sh; GSC[k] = g * (1.0f + c_sc); SHC[k] = c_sh;
        }
        if (F.tid < 216) { const int r = F.tid / 24, n = blk * 24 + F.tid % 24; float s = adab[n];
#pragma unroll 4
            for (int ks = 0; ks < 16; ++ks) s += MODP[((size_t)ks * 9 + r) * 6144 + n];
            MOD[r * 6144 + n] = s; }
        __syncthreads();
#pragma unroll 1
        for (int j = 0; j < 9; ++j) { const bool isctx = j == 8;
            const int row = isctx ? NTOK + blk * 8 + F.wave : blk * 64 + F.wave * 8 + j;
            const float* src = isctx ? a.in[I_CTX] + (size_t)(blk * 8 + F.wave) * 1024 : a.in[I_X] + (size_t)row * 1024;
            norm_row_mod(src, XN + (size_t)row * 1024, isctx ? GSC : GS, isctx ? SHC : SH, F.lane); }
        __syncthreads();
    }
}

__device__ __forceinline__ void ld8(const bf16* p, float (&f)[8]) { const v4u w = *(const v4u*)p;
    f[0] = bflo(w.x); f[1] = bfhi(w.x); f[2] = bflo(w.y); f[3] = bfhi(w.y); f[4] = bflo(w.z); f[5] = bfhi(w.z); f[6] = bflo(w.w); f[7] = bfhi(w.w); }
__device__ __forceinline__ v4u pack8(const float (&f)[8]) { v4u w; w.x = pk2(f[0], f[1]); w.y = pk2(f[2], f[3]); w.z = pk2(f[4], f[5]); w.w = pk2(f[6], f[7]); return w; }

__device__ __forceinline__ void yconv_item(const Args& a, Frame& F, int b, int r) {
    const bf16* Z = (const bf16*)(a.ws + WS_RA); bf16* Y = (bf16*)(a.ws + WS_RB); const float* scw = a.in[I_SCW];
    const int cg = F.tid & 63, c0 = cg * 8; const bool vert = cg >= 32; const int stride = vert ? 64 : 1;
    float wk[3][8];
#pragma unroll
    for (int k = 0; k < 3; ++k)
#pragma unroll
        for (int i = 0; i < 8; ++i) wk[k][i] = scw[k * 512 + c0 + i];
#pragma unroll 2
    for (int j = 0; j < 8; ++j) { const int w = (F.tid >> 6) + 8 * j, t = r * 64 + w;
        float acc[8];
#pragma unroll
        for (int i = 0; i < 8; ++i) acc[i] = 0.f;
#pragma unroll
        for (int k = 0; k < 3; ++k) { const int p = (vert ? r : w) + k - 1; const bool valid = p >= 0 && p < (vert ? 32 : 64);
            const int tn = valid ? t + (k - 1) * stride : t; const bf16* zr = Z + (size_t)(b * SEQ + tn) * DIN;
            float cv[8], vv[8]; ld8(zr + 2048 + c0, cv); ld8(zr + 1024 + c0, vv);
            const float m = valid ? 1.0f : 0.0f;
#pragma unroll
            for (int i = 0; i < 8; ++i) acc[i] += (wk[k][i] * m) * (cv[i] * vv[i]); }
        float bg[8]; ld8(Z + (size_t)(b * SEQ + t) * DIN + 1536 + c0, bg);
#pragma unroll
        for (int i = 0; i < 8; ++i) acc[i] *= bg[i];
        *(v4u*)(Y + (size_t)(b * SEQ + t) * 1024 + 512 + c0) = pack8(acc); }
}

constexpr int SC_XC = 0, SC_AB = 9216, SC_BB = 9216 + 32768, SC_SEG = 9216 + 65536, SC_HALL = SC_SEG + 4096;
template <bool PASS2>
__device__ __forceinline__ void scan_range(const Args& a, Frame& F, int b, int h, int vc0, int nvc) {
    const int tid = F.tid, lane = F.lane, wave = F.wave;
    LAS bf16* XC = (LAS bf16*)(F.lds + SC_XC);
    LAS float* AB = (LAS float*)(F.lds + SC_AB);
    LAS float* BB = (LAS float*)(F.lds + SC_BB);
    LAS float* SEG = (LAS float*)(F.lds + SC_SEG);
    LAS float* HALL = (LAS float*)(F.lds + SC_HALL);
    const bf16* Z = (const bf16*)(a.ws + WS_RA); const bf16* Zc = (const bf16*)(a.ws + WS_ZC);
    const bf16* WrgT = (const bf16*)(a.ws + WS_WRG); float* AGG = (float*)(a.ws + WS_AGG); bf16* Y = (bf16*)(a.ws + WS_RB);
    const int d = wave >> 2, chh = (wave >> 1) & 1, shf = wave & 1, r = lane & 31, hh = lane >> 5;
    bf16x8 br[4], bi[4];
    { const bf16* wr_ = WrgT + (size_t)(h * 256 + d * 128 + chh * 32 + r) * 64 + hh * 8;
#pragma unroll
      for (int ks = 0; ks < 4; ++ks) { br[ks] = *(const bf16x8*)(wr_ + ks * 16); bi[ks] = *(const bf16x8*)(wr_ + 64 * 64 + ks * 16); } }
    const int ch = chh * 32 + r, gch = d * 512 + h * 64 + ch;
    const float ba = a.in[I_RGBA][gch] * -1.4426950408889634f, bx = a.in[I_RGBX][gch] * -1.4426950408889634f;
    const float Kc = -8.0f * 1.4426950408889634f * log1pf(expf(-a.in[I_RGLAM][gch]));
    const int cs = tid >> 3, ig = tid & 7, col = h * 64 + ig * 8;
    float cwv[4][8], cbv[8];
#pragma unroll
    for (int i = 0; i < 8; ++i) { cbv[i] = a.in[I_RCB][col + i];
#pragma unroll
        for (int k = 0; k < 4; ++k) cwv[k][i] = a.in[I_RCW][k * 512 + col + i]; }
    const int d2 = tid >> 8, seg = (tid >> 6) & 3, c = tid & 63;
    if (PASS2 && tid < 128) {
        const int dd = tid >> 6, cc = tid & 63; const float* ag = AGG + ((size_t)b * 36 * 2 + dd) * 1024 + (h * 64 + cc) * 2;
        float pv[36], sv[36];
#pragma unroll
        for (int k = 0; k < 36; ++k) { pv[k] = ag[(size_t)k * 2048]; sv[k] = ag[(size_t)k * 2048 + 1]; }
        float hc = 0.0f;
        if (dd == 0) {
#pragma unroll
            for (int k = 0; k < 36; ++k) { const int t = k - vc0; if (t >= 0 && t < nvc) HALL[(t * 2 + 0) * 64 + cc] = hc; hc = pv[k] * hc + sv[k]; }
        } else {
#pragma unroll
            for (int k = 3; k >= 0; --k) hc = pv[k] * hc + sv[k];
#pragma unroll
            for (int k = 35; k >= 4; --k) { const int t = k - vc0; if (t >= 0 && t < nvc) HALL[(t * 2 + 1) * 64 + cc] = hc; hc = pv[k] * hc + sv[k]; }
        }
    }
    v4u xq[4]; v4u gq = (v4u){0u, 0u, 0u, 0u}, gqn = gq;
    { const int vc = vc0; const bool isctx = vc < 4; const int s0 = isctx ? vc * 64 : (vc - 4) * 64, Ls = isctx ? CTXL : SEQ, pitch = isctx ? 512 : DIN;
      const bf16* src = isctx ? Zc + (size_t)b * CTXL * 512 : Z + (size_t)b * SEQ * DIN;
#pragma unroll
      for (int k = 0; k < 4; ++k) { const int sp = s0 + cs + k - 2; const int spc = (sp >= 0 && sp < Ls) ? sp : s0 + cs; xq[k] = *(const v4u*)(src + (size_t)spc * pitch + col); }
      if (PASS2) gq = *(const v4u*)(Z + ((size_t)b * SEQ + s0 + cs) * DIN + 512 + col); }
#pragma unroll 1
    for (int t = 0; t < nvc; ++t) {
        const int vc = vc0 + t; const bool isctx = vc < 4; const int s0 = isctx ? vc * 64 : (vc - 4) * 64, Ls = isctx ? CTXL : SEQ;
        { float acc[8];
#pragma unroll
          for (int i = 0; i < 8; ++i) acc[i] = cbv[i];
#pragma unroll
          for (int k = 0; k < 4; ++k) { const int sp = s0 + cs + k - 2; const float m = (sp >= 0 && sp < Ls) ? 1.0f : 0.0f;
              const v4u w = xq[k]; const float xv[8] = {bflo(w.x), bfhi(w.x), bflo(w.y), bfhi(w.y), bflo(w.z), bfhi(w.z), bflo(w.w), bfhi(w.w)};
#pragma unroll
              for (int i = 0; i < 8; ++i) acc[i] += (cwv[k][i] * m) * xv[i]; }
          *(LAS v4u*)(XC + cs * 72 + ig * 8) = pack8(acc); }
        if (t + 1 < nvc) { const int vn = vc + 1; const bool cx = vn < 4; const int s0n = cx ? vn * 64 : (vn - 4) * 64, Lsn = cx ? CTXL : SEQ, pitch = cx ? 512 : DIN;
            const bf16* src = cx ? Zc + (size_t)b * CTXL * 512 : Z + (size_t)b * SEQ * DIN;
#pragma unroll
            for (int k = 0; k < 4; ++k) { const int sp = s0n + cs + k - 2; const int spc = (sp >= 0 && sp < Lsn) ? sp : s0n + cs; xq[k] = *(const v4u*)(src + (size_t)spc * pitch + col); }
            if (PASS2) gqn = *(const v4u*)(Z + ((size_t)b * SEQ + s0n + cs) * DIN + 512 + col); }
        __syncthreads();
        { f32x16 accr, acci;
#pragma unroll
          for (int i = 0; i < 16; ++i) { accr[i] = 0.f; acci[i] = 0.f; }
#pragma unroll
          for (int ks = 0; ks < 4; ++ks) {
              const bf16x8 af = *(const LAS bf16x8*)(XC + (shf * 32 + r) * 72 + ks * 16 + hh * 8);
              accr = __builtin_amdgcn_mfma_f32_32x32x16_bf16(af, br[ks], accr, 0, 0, 0);
              acci = __builtin_amdgcn_mfma_f32_32x32x16_bf16(af, bi[ks], acci, 0, 0, 0); }
#pragma unroll
          for (int reg = 0; reg < 16; ++reg) { const int s = shf * 32 + (reg & 3) + 8 * (reg >> 2) + 4 * hh;
              const float rr = __builtin_amdgcn_rcpf(1.0f + __builtin_amdgcn_exp2f(fmaf(accr[reg], -1.4426950408889634f, ba)));
              const float ii = __builtin_amdgcn_rcpf(1.0f + __builtin_amdgcn_exp2f(fmaf(acci[reg], -1.4426950408889634f, bx)));
              const float av = __builtin_amdgcn_exp2f(Kc * rr);
              const float xcv = __uint_as_float((unsigned)XC[s * 72 + ch] << 16);
              const float bv = __builtin_amdgcn_sqrtf(fmaxf(fmaf(-av, av, 1.0f), 0.0f)) * (ii * xcv);
              AB[(d * 64 + s) * 64 + ch] = av; BB[(d * 64 + s) * 64 + ch] = bv; } }
        __syncthreads();
        float av16[16], bv16[16];
        { float P = 1.0f, Sv = 0.0f;
#pragma unroll
          for (int j = 0; j < 16; ++j) { const int vs = seg * 16 + j, s = d2 ? 63 - vs : vs; av16[j] = AB[(d2 * 64 + s) * 64 + c]; bv16[j] = BB[(d2 * 64 + s) * 64 + c]; }
#pragma unroll
          for (int j = 0; j < 16; ++j) { Sv = av16[j] * Sv + bv16[j]; P *= av16[j]; }
          SEG[((d2 * 4 + seg) * 64 + c) * 2 + 0] = P; SEG[((d2 * 4 + seg) * 64 + c) * 2 + 1] = Sv; }
        __syncthreads();
        if (!PASS2) {
            if (seg == 0) { float Pt = 1.0f, St = 0.0f;
#pragma unroll
                for (int k = 0; k < 4; ++k) { const float p = SEG[((d2 * 4 + k) * 64 + c) * 2], sg = SEG[((d2 * 4 + k) * 64 + c) * 2 + 1]; St = p * St + sg; Pt *= p; }
                float* ag = AGG + (((size_t)b * 36 + vc) * 2 + d2) * 1024 + (h * 64 + c) * 2; ag[0] = Pt; ag[1] = St; }
        } else {
            float hv = HALL[(t * 2 + d2) * 64 + c];
            for (int k = 0; k < seg; ++k) { const float p = SEG[((d2 * 4 + k) * 64 + c) * 2], sg = SEG[((d2 * 4 + k) * 64 + c) * 2 + 1]; hv = p * hv + sg; }
#pragma unroll
            for (int j = 0; j < 16; ++j) { const int vs = seg * 16 + j, s = d2 ? 63 - vs : vs; hv = av16[j] * hv + bv16[j]; BB[(d2 * 64 + s) * 64 + c] = hv; }
            __syncthreads();
            { const size_t trow = (size_t)b * SEQ + s0 + cs;
              const float g[8] = {bflo(gq.x), bfhi(gq.x), bflo(gq.y), bfhi(gq.y), bflo(gq.z), bfhi(gq.z), bflo(gq.w), bfhi(gq.w)}; float o[8];
              const f32x4 h0a = *(const LAS f32x4*)(BB + (0 * 64 + cs) * 64 + ig * 8), h0b = *(const LAS f32x4*)(BB + (0 * 64 + cs) * 64 + ig * 8 + 4);
              const f32x4 h1a = *(const LAS f32x4*)(BB + (1 * 64 + cs) * 64 + ig * 8), h1b = *(const LAS f32x4*)(BB + (1 * 64 + cs) * 64 + ig * 8 + 4);
              const float hs[8] = {h0a.x + h1a.x, h0a.y + h1a.y, h0a.z + h1a.z, h0a.w + h1a.w, h0b.x + h1b.x, h0b.y + h1b.y, h0b.z + h1b.z, h0b.w + h1b.w};
#pragma unroll
              for (int i = 0; i < 8; ++i) { const float z = g[i] + 0.044715f * g[i] * g[i] * g[i];
                  const float ge = g[i] * __builtin_amdgcn_rcpf(1.0f + __builtin_amdgcn_exp2f(-1.5957691216057308f * 1.4426950408889634f * z));
                  o[i] = ge * hs[i]; }
              *(v4u*)(Y + trow * 1024 + col) = pack8(o); }
            gq = gqn;
        }
    }
    __syncthreads();
}

__device__ __forceinline__ float red8(const float (&p)[8], int lane) {
    const bool b0 = lane & 1, b1 = lane & 2, b2 = lane & 4;
    float q[4], r2[2];
#pragma unroll
    for (int i = 0; i < 4; ++i) { const float keep = b0 ? p[i + 4] : p[i], send = b0 ? p[i] : p[i + 4]; q[i] = keep + __shfl_xor(send, 1); }
#pragma unroll
    for (int i = 0; i < 2; ++i) { const float keep = b1 ? q[i + 2] : q[i], send = b1 ? q[i] : q[i + 2]; r2[i] = keep + __shfl_xor(send, 2); }
    float s; { const float keep = b2 ? r2[1] : r2[0], send = b2 ? r2[0] : r2[1]; s = keep + __shfl_xor(send, 4); }
    s += __shfl_xor(s, 8); s += __shfl_xor(s, 16); s += __shfl_xor(s, 32);
    return s;
}
__device__ __forceinline__ void p6_route(const Args& a, Frame& F, bool commit) {
    const float* X1 = a.out; const float* MOD = (const float*)(a.ws + WS_MOD); const float* WrT = (const float*)(a.ws + WS_WRT);
    bf16* ML = (bf16*)(a.ws + WS_RB); int* SLOT = (int*)(a.ws + WS_SLOT); float* GATEW = (float*)(a.ws + WS_GATEW); unsigned* CNT = (unsigned*)(a.ws + WS_CTL) + CW_CNT;
    const float* n2g = a.in[I_N2G]; const float* rgb = a.in[I_RGRB]; const float* reb = a.in[I_REB];
    const int lane = F.lane;
    for (int g = F.bid * NWAVES + F.wave; g < NTOK / 8; g += F.G * NWAVES) {
        const int row0 = g * 8, b = row0 >> 11;
        f32x4 v[8][4]; float ss[8];
#pragma unroll
        for (int r = 0; r < 8; ++r) { ss[r] = 0.f;
#pragma unroll
            for (int j = 0; j < 4; ++j) { v[r][j] = *(const f32x4*)(X1 + (size_t)(row0 + r) * 1024 + 4 * lane + 256 * j);
                ss[r] += (v[r][j].x * v[r][j].x + v[r][j].y * v[r][j].y) + (v[r][j].z * v[r][j].z + v[r][j].w * v[r][j].w); } }
#pragma unroll
        for (int r = 0; r < 8; ++r) ss[r] = 1.0f / sqrtf(wave_sum(ss[r]) * (1.0f / 1024.0f) + NORM_EPS);
#pragma unroll
        for (int j = 0; j < 4; ++j) { const int col = 4 * lane + 256 * j;
            const f32x4 gn = *(const f32x4*)(n2g + col), sc = *(const f32x4*)(MOD + (size_t)b * 6144 + 4096 + col), sh = *(const f32x4*)(MOD + (size_t)b * 6144 + 3072 + col);
            const f32x4 gs = gn * (sc + 1.0f);
#pragma unroll
            for (int r = 0; r < 8; ++r) { v[r][j] = (v[r][j] * ss[r]) * gs + sh; v2u o; o.x = pk2(v[r][j].x, v[r][j].y); o.y = pk2(v[r][j].z, v[r][j].w);
                *(v2u*)(ML + (size_t)(row0 + r) * 1024 + col) = o; } }
        LAS float* LG = (LAS float*)(F.lds + F.wave * 2048);
        const int rid = 4 * (lane & 1) + 2 * ((lane >> 1) & 1) + ((lane >> 2) & 1);
#pragma unroll 2
        for (int jj = 0; jj < 36; ++jj) { f32x4 w[4];
#pragma unroll
            for (int j = 0; j < 4; ++j) w[j] = *(const f32x4*)(WrT + jj * 1024 + 4 * lane + 256 * j);
            float p[8];
#pragma unroll
            for (int r = 0; r < 8; ++r) { float s = 0.f;
#pragma unroll
                for (int j = 0; j < 4; ++j) s += (v[r][j].x * w[j].x + v[r][j].y * w[j].y) + (v[r][j].z * w[j].z + v[r][j].w * w[j].w);
                p[r] = s; }
            const float tot = red8(p, lane) + (jj < 4 ? rgb[jj] : reb[jj - 4]);
            if (lane < 8) LG[rid * 36 + jj] = tot; }
        LDS_WAIT(); asm volatile("" ::: "memory");
        float lg[36];
#pragma unroll
        for (int jj = 0; jj < 36; ++jj) lg[jj] = LG[(lane < 8 ? rid : 0) * 36 + jj];
        int grp = 0; float gm = lg[0];
#pragma unroll
        for (int j = 1; j < 4; ++j) if (lg[j] > gm) { gm = lg[j]; grp = j; }
        float gz = 0.f;
#pragma unroll
        for (int j = 0; j < 4; ++j) gz += __expf(lg[j] - gm);
        const float pg = 1.0f / gz;
        float el[8];
#pragma unroll
        for (int i = 0; i < 8; ++i) el[i] = grp == 0 ? lg[4 + i] : grp == 1 ? lg[12 + i] : grp == 2 ? lg[20 + i] : lg[28 + i];
        int i1 = 0; float m1 = el[0];
#pragma unroll
        for (int i = 1; i < 8; ++i) if (el[i] > m1) { m1 = el[i]; i1 = i; }
        int i2 = -1; float m2 = -3.0e38f;
#pragma unroll
        for (int i = 0; i < 8; ++i) if (i != i1 && el[i] > m2) { m2 = el[i]; i2 = i; }
        const float e2 = __expf(m2 - m1), den = 1.0f / (1.0f + e2);
        if (lane < 8 && commit) { const int tok = row0 + rid;
            const int ea = grp * 8 + i1, eb = grp * 8 + i2;
            const unsigned pa = __hip_atomic_fetch_add(CNT + 64 * ea, 1u, RLX_AGENT); SLOT[ea * 16384 + pa] = tok * 2;     GATEW[tok * 2] = pg * den;
            const unsigned pb = __hip_atomic_fetch_add(CNT + 64 * eb, 1u, RLX_AGENT); SLOT[eb * 16384 + pb] = tok * 2 + 1; GATEW[tok * 2 + 1] = pg * e2 * den; }
    }
}

__device__ __forceinline__ void build_tiles(const Args& a, Frame& F) {
    LAS int* T = (LAS int*)(F.lds + TBL_OFF); unsigned* CNT = (unsigned*)(a.ws + WS_CTL) + CW_CNT;
    if (F.tid < 32) T[F.tid] = (int)__hip_atomic_load(CNT + 64 * F.tid, RLX_AGENT);
    __syncthreads();
    if (F.tid == 0) { int acc = 0;
        for (int e = 0; e < 32; ++e) { const int n = (T[e] + 255) >> 8; T[32 + e] = acc; for (int t = 0; t < n; ++t) T[96 + acc + t] = e; acc += n; }
        T[64] = acc; }
    __syncthreads();
}
__device__ __forceinline__ void p7_gather(const Args& a, Frame& F) {
    build_tiles(a, F);
    const LAS int* T = (const LAS int*)(F.lds + TBL_OFF);
    const bf16* ML = (const bf16*)(a.ws + WS_RB); bf16* XG = (bf16*)(a.ws + WS_RA); const int* SLOT = (const int*)(a.ws + WS_SLOT); int* SMAP = (int*)(a.ws + WS_SMAP);
    const int nrows = T[64] * 256;
    for (int sr = F.bid * NWAVES + F.wave; sr < nrows; sr += F.G * NWAVES) {
        const int e = T[96 + (sr >> 8)], pos = sr - T[32 + e] * 256;
        v4u x0 = (v4u){0u, 0u, 0u, 0u}, x1 = x0; int asg = -1;
        if (pos < T[e]) { asg = SLOT[e * 16384 + pos]; const v4u* s = (const v4u*)(ML + (size_t)(asg >> 1) * 1024); x0 = s[F.lane]; x1 = s[64 + F.lane]; }
        v4u* d = (v4u*)(XG + (size_t)sr * 1024); d[F.lane] = x0; d[64 + F.lane] = x1;
        if (F.lane == 0) SMAP[sr] = asg;
    }
}
__device__ __forceinline__ void p10_final(const Args& a, Frame& F, bool commit) {
    float* X1 = a.out; float* OUT = commit ? a.out : (float*)(a.ws + WS_WGU); const float* MOD = (const float*)(a.ws + WS_MOD); const bf16* YA = (const bf16*)(a.ws + WS_RA); const float* fng = a.in[I_FNG];
    const int lane = F.lane;
    for (int t = F.bid * NWAVES + F.wave; t < NTOK; t += F.G * NWAVES) {
        const int b = t >> 11; f32x4 v[4]; float ss = 0.f;
#pragma unroll
        for (int j = 0; j < 4; ++j) { const int col = 4 * lane + 256 * j;
            const f32x4 x = *(const f32x4*)(X1 + (size_t)t * 1024 + col), g2 = *(const f32x4*)(MOD + (size_t)b * 6144 + 5120 + col);
            const v2u ya = *(const v2u*)(YA + (size_t)(2 * t) * 1024 + col), yb = *(const v2u*)(YA + (size_t)(2 * t + 1) * 1024 + col);
            f32x4 y; y.x = bflo(ya.x) + bflo(yb.x); y.y = bfhi(ya.x) + bfhi(yb.x); y.z = bflo(ya.y) + bflo(yb.y); y.w = bfhi(ya.y) + bfhi(yb.y);
            v[j] = x + g2 * y; ss += (v[j].x * v[j].x + v[j].y * v[j].y) + (v[j].z * v[j].z + v[j].w * v[j].w); }
        const float rstd = 1.0f / sqrtf(wave_sum(ss) * (1.0f / 1024.0f) + NORM_EPS);
#pragma unroll
        for (int j = 0; j < 4; ++j) { const int col = 4 * lane + 256 * j; const f32x4 g = *(const f32x4*)(fng + col);
            *(f32x4*)(OUT + (size_t)t * 1024 + col) = (v[j] * rstd) * g; }
    }
}

__global__ void __launch_bounds__(NWAVES * 64, 2) mk_fwd(Args a) {
    extern __shared__ __attribute__((aligned(16))) unsigned char lds_raw[];
    Frame F; F.lds = (LAS unsigned char*)lds_raw; F.tid = threadIdx.x; F.lane = F.tid & 63; F.wave = __builtin_amdgcn_readfirstlane(F.tid >> 6); F.G = gridDim.x; F.bid = blockIdx.x;
    for (int u = F.tid; u < (LDS_BYTES - LDSCTL_OFF) / 4; u += NWAVES * 64) ((LAS unsigned*)(F.lds + LDSCTL_OFF))[u] = 0u;
    __syncthreads();
    const int lo = a.ph_lo, hi = a.ph_hi;
    XcdBarrier bar; bar.bar = (unsigned*)(a.ws + WS_CTL) + CW_BAR; bar.x = 0; bar.st = nullptr;
    if (hi - lo > 1) bar = xcd_barrier_post((unsigned*)(a.ws + WS_CTL) + CW_BAR, (volatile LAS unsigned*)(F.lds + LDSCTL_OFF) + 8);
#ifndef PHMASK
#define PHMASK 0x7ff
#endif
#define IN(k) (((PHMASK >> (k)) & 1) && lo <= (k) && (k) < hi)
#define SEAM(k) do { if (IN(k) && IN((k) + 1)) xcd_barrier(bar); } while (0)
#ifndef PROBE_REP
#define PROBE_REP (-1)
#endif
#ifndef PROBE_N
#define PROBE_N 3
#endif
#ifndef PROBE_T
#define PROBE_T (-1)
#endif
#define TBEG(k) unsigned long long tb_ = 0; if (PROBE_T == (k) || PROBE_T == 99) tb_ = __builtin_amdgcn_s_memrealtime();
#define TEND(k) if (PROBE_T == (k) || PROBE_T == 99) { const unsigned long long te_ = __builtin_amdgcn_s_memrealtime(); while (__builtin_amdgcn_s_memrealtime() - te_ < te_ - tb_) __builtin_amdgcn_s_sleep(8); }
#define REPS(k) for (int rep_ = 0; rep_ < ((PROBE_REP == (k)) ? PROBE_N : 1); ++rep_)

    if (IN(0)) { TBEG(0) REPS(0) { p0_prep(a, F); } TEND(0) } SEAM(0);
    if (IN(1)) { TBEG(1) REPS(1) { p1_norm(a, F); } TEND(1) } SEAM(1);
    if (IN(2)) { TBEG(2) { {
        pg8::Gemm g{(const bf16*)(a.ws + WS_RB), (const bf16*)(a.ws + WS_WIN), NTOK + NCTX, DIN, DM}; pg8::OrderInProj S{F.G, F.bid};
        pg8::EpiInProj E{(bf16*)(a.ws + WS_RA), (bf16*)(a.ws + WS_ZC)};
        pg8::gemm_phase<pg8::EpiInProj, pg8::OrderInProj, true, true>(F.lds, g, S, E); }
    if (PROBE_REP == 2) {
        pg8::Gemm g{(const bf16*)(a.ws + WS_RB), (const bf16*)(a.ws + WS_WIN), NTOK + NCTX, DIN, DM}; pg8::OrderInProj S{F.G, F.bid};
        pg8::EpiInProj E{(bf16*)(a.ws + WS_RA), (bf16*)(a.ws + WS_ZC)};
        pg8::gemm_phase<pg8::EpiInProj, pg8::OrderInProj, true, true>(F.lds, g, S, E); } }
    TEND(2) } SEAM(2);
    if (IN(3)) { TBEG(3) REPS(3) {
        for (int it = F.bid; it < 256; it += F.G) yconv_item(a, F, it >> 5, it & 31);
        for (int w = F.bid; w < 256; w += F.G) { const int bh = w >> 2; scan_range<false>(a, F, bh >> 3, bh & 7, 9 * (w & 3), 9); } }
    TEND(3) } SEAM(3);
    if (IN(4)) { TBEG(4) REPS(4) {
        for (int w = F.bid; w < 256; w += F.G) { const int bh = w >> 2; scan_range<true>(a, F, bh >> 3, bh & 7, 4 + 8 * (w & 3), 8); } }
    TEND(4) } SEAM(4);
    if (IN(5)) { TBEG(5) REPS(5) {
        pg8::Gemm g{(const bf16*)(a.ws + WS_RB), (const bf16*)(a.ws + WS_WOUT), NTOK, DM, DM}; pg8::StaticOrder S; S.init(NTOK, DM, F.G, F.bid);
        pg8::EpiOutProj E{a.in[I_X], a.out, (const float*)(a.ws + WS_MOD)};
        pg8::gemm_phase<pg8::EpiOutProj, pg8::StaticOrder, true, true>(F.lds, g, S, E); }
    TEND(5) } SEAM(5);
    if (IN(6)) { TBEG(6) REPS(6) { p6_route(a, F, rep_ == ((PROBE_REP == 6) ? PROBE_N : 1) - 1); } TEND(6) } SEAM(6);
    if (IN(7)) { TBEG(7) REPS(7) { p7_gather(a, F); } TEND(7) } SEAM(7);
    if (IN(8)) { TBEG(8) { {
        build_tiles(a, F); const LAS int* T = (const LAS int*)(F.lds + TBL_OFF);
        pg8::Gemm g{(const bf16*)(a.ws + WS_RA), (const bf16*)(a.ws + WS_WGU), 0, 0, DM}; pg8::OrderMoE S{F.G, F.bid, T[64] * 4, T + 96};
        pg8::EpiGateUp E{(bf16*)(a.ws + WS_RB)};
        pg8::gemm_phase<pg8::EpiGateUp, pg8::OrderMoE, true, true>(F.lds, g, S, E); }
    if (PROBE_REP == 8) {
        build_tiles(a, F); const LAS int* T = (const LAS int*)(F.lds + TBL_OFF);
        pg8::Gemm g{(const bf16*)(a.ws + WS_RA), (const bf16*)(a.ws + WS_WGU), 0, 0, DM}; pg8::OrderMoE S{F.G, F.bid, T[64] * 4, T + 96};
        pg8::EpiGateUp E{(bf16*)(a.ws + WS_RB)};
        pg8::gemm_phase<pg8::EpiGateUp, pg8::OrderMoE, true, true>(F.lds, g, S, E); } }
    TEND(8) } SEAM(8);
    if (IN(9)) { TBEG(9) { {
        build_tiles(a, F); const LAS int* T = (const LAS int*)(F.lds + TBL_OFF);
        pg8::Gemm g{(const bf16*)(a.ws + WS_RB), (const bf16*)(a.ws + WS_WD), 0, 0, 512}; pg8::OrderMoE S{F.G, F.bid, T[64] * 4, T + 96};
        pg8::EpiDown E{(bf16*)(a.ws + WS_RA), (const int*)(a.ws + WS_SMAP), (const float*)(a.ws + WS_GATEW)};
        pg8::gemm_phase<pg8::EpiDown, pg8::OrderMoE, true, true>(F.lds, g, S, E); }
    if (PROBE_REP == 9) {
        build_tiles(a, F); const LAS int* T = (const LAS int*)(F.lds + TBL_OFF);
        pg8::Gemm g{(const bf16*)(a.ws + WS_RB), (const bf16*)(a.ws + WS_WD), 0, 0, 512}; pg8::OrderMoE S{F.G, F.bid, T[64] * 4, T + 96};
        pg8::EpiDown E{(bf16*)(a.ws + WS_RA), (const int*)(a.ws + WS_SMAP), (const float*)(a.ws + WS_GATEW)};
        pg8::gemm_phase<pg8::EpiDown, pg8::OrderMoE, true, true>(F.lds, g, S, E); } }
    TEND(9) } SEAM(9);
    if (IN(10)) { TBEG(10) REPS(10) { p10_final(a, F, rep_ == ((PROBE_REP == 10) ? PROBE_N : 1) - 1); }
    TEND(10) }
#undef IN
#undef SEAM
}

extern "C" void kernel_launch(void* const* d_in, const int* in_sizes, int n_in, void* d_out, int out_size, void* d_ws, size_t ws_size, hipStream_t stream) {
    static int grid = 0;
    if (grid == 0) {
        if (n_in != N_IN || out_size != NTOK * DM || ws_size < WS_END) { fprintf(stderr, "kernel_launch: unexpected shapes: n_in %d out %d ws %zu (need %zu)\n", n_in, out_size, ws_size, (size_t)WS_END); grid = -1; return; }
        int dev = 0, cus = 0, per_cu = 0;
        if (hipGetDevice(&dev) != hipSuccess || hipDeviceGetAttribute(&cus, hipDeviceAttributeMultiprocessorCount, dev) != hipSuccess) { grid = -1; return; }
        if (hipFuncSetAttribute((const void*)mk_fwd, hipFuncAttributeMaxDynamicSharedMemorySize, LDS_BYTES) != hipSuccess) { fprintf(stderr, "kernel_launch: hipFuncSetAttribute failed\n"); grid = -1; return; }
        if (hipOccupancyMaxActiveBlocksPerMultiprocessor(&per_cu, (const void*)mk_fwd, NWAVES * 64, LDS_BYTES) != hipSuccess || per_cu < 1) { fprintf(stderr, "kernel_launch: occupancy query says %d blocks per CU\n", per_cu); (void)hipGetLastError(); grid = -1; return; }
        grid = cus;
        if (grid > 256) grid = 256;
    }
    if (grid < 0) return;
    (void)hipMemsetAsync((char*)d_ws + WS_CTL, 0, CTL_ZERO_BYTES, stream);
    Args a{};
    for (int i = 0; i < N_IN; ++i) a.in[i] = (const float*)d_in[i];
    a.out = (float*)d_out; a.ws = (unsigned char*)d_ws;
    if (MK_N_LAUNCHES == 1) {
        a.ph_lo = 0; a.ph_hi = N_PHASES;
        void* args[] = {&a};
        hipError_t e = hipLaunchCooperativeKernel((const void*)mk_fwd, dim3(grid), dim3(NWAVES * 64), args, LDS_BYTES, stream);
        if (e != hipSuccess) fprintf(stderr, "kernel_launch: cooperative launch failed: %s (grid %d)\n", hipGetErrorString(e), grid);
    } else {
        for (int p = 0; p < N_PHASES; ++p) { a.ph_lo = p; a.ph_hi = p + 1; hipLaunchKernelGGL(mk_fwd, dim3(grid), dim3(NWAVES * 64), LDS_BYTES, stream, a); }
    }
}
```

```cpp
#define MK_N_LAUNCHES 1
#include <hip/hip_runtime.h>
#include <cstdio>
#include <cstdint>
namespace pg8 {
#define PG8_LAS __attribute__((address_space(3)))
typedef unsigned short bf16_t;
typedef short bf16x8 __attribute__((ext_vector_type(8)));
typedef float f32x4 __attribute__((ext_vector_type(4)));
typedef unsigned u32x4 __attribute__((ext_vector_type(4)));
constexpr int BM = 256, BK = 64, HALF = 128, HTB = HALF * BK * 2  , STAGE_BYTES = 8 * HTB, NXCD = 8, WGM = 8;

__host__ __device__ __forceinline__ int lds_byte(int r, int c) { const int st = (r >> 4) * 2 + (c >> 5), rr = r & 15, cc = c & 31, ob = rr * 64 + cc * 2; return st * 1024 + (ob ^ (((ob >> 9) & 1) << 5)); }
__host__ __device__ __forceinline__ void stage_rc(int b, int& R, int& C) { const int st = b / 1024, sb = b % 1024, swz = sb ^ (((sb >> 9) & 1) << 5); R = (st >> 1) * 16 + swz / 64; C = (st & 1) * 32 + (swz % 64) / 2; }
__host__ __device__ __forceinline__ int perm32(int rho) { const int n = rho >> 4, i = rho & 15; return 8 * (i >> 2) + 4 * n + (i & 3); }

struct Unit { int pm, pn; };
struct Gemm { const bf16_t* A; const bf16_t* Bt; int M, N, K; };

struct StaticOrder {
    int nM, nN, nwg, G, c;
    __host__ __device__ void init(int M, int N, int G_, int c_) { nM = M / BM; nN = N / BM; nwg = nM * nN; G = G_; c = c_; }
    __host__ __device__ bool next(int i, Unit& u) const {
        const long L = (long)i * G + c; if (L >= nwg) return false;
        int wgid = (int)L; { const int q = nwg / NXCD, r = nwg % NXCD, xcd = wgid % NXCD, off = wgid / NXCD; wgid = (xcd < r ? xcd * (q + 1) : r * (q + 1) + (xcd - r) * q) + off; }
        const int nig = WGM * nN, gid = wgid / nig, fm = gid * WGM, gsz = (nM - fm) < WGM ? (nM - fm) : WGM;
        u.pm = fm + ((wgid % nig) % gsz); u.pn = (wgid % nig) / gsz; return true;
    }
    __device__ __forceinline__ void a_ready(const Unit&) const {}
    __device__ __forceinline__ void done(const Unit&) const {}
};
__device__ __forceinline__ unsigned cvt_pk_bf16(float lo, float hi) { unsigned r; asm volatile("v_cvt_pk_bf16_f32 %0, %1, %2" : "=v"(r) : "v"(lo), "v"(hi)); return r; }
struct EpiInProj {
    static constexpr bool PERM = true, AFTER_DRAIN = false;
    bf16_t* Z; bf16_t* Zc;
    __device__ __forceinline__ void operator()(const f32x4 (&acc)[2][2][4][2], const Unit& u, int wr, int wc, int fr, int fq) const {
        const bool isctx = u.pm >= 64;
        bf16_t* base = isctx ? Zc : Z; const int ldc = isctx ? 512 : 2560; const int prow = isctx ? u.pm - 64 : u.pm;
        const int row0 = prow * BM + wr * 64 + fr, col0 = u.pn * BM + wc * 32 + 8 * fq;
#pragma unroll
        for (int ai = 0; ai < 2; ++ai)
#pragma unroll
            for (int m = 0; m < 4; ++m) { bf16_t* rowp = base + (size_t)(row0 + ai * HALF + m * 16) * ldc + col0;
#pragma unroll
                for (int bj = 0; bj < 2; ++bj) { const f32x4 v0 = acc[ai][bj][m][0], v1 = acc[ai][bj][m][1];
                    u32x4 w; w.x = cvt_pk_bf16(v0[0], v0[1]); w.y = cvt_pk_bf16(v0[2], v0[3]); w.z = cvt_pk_bf16(v1[0], v1[1]); w.w = cvt_pk_bf16(v1[2], v1[3]);
                    *(u32x4*)(rowp + bj * HALF) = w; } }
    }
};
struct EpiOutProj {
    static constexpr bool PERM = false, AFTER_DRAIN = false;
    const float* x; float* X1; const float* mod;
    __device__ __forceinline__ void operator()(const f32x4 (&acc)[2][2][4][2], const Unit& u, int wr, int wc, int fr, int fq) const {
        const int b = u.pm >> 3;
        const int row0 = u.pm * BM + wr * 64 + fr, col0 = u.pn * BM + wc * 32 + 4 * fq;
        f32x4 gv[2][2];
#pragma unroll
        for (int bj = 0; bj < 2; ++bj)
#pragma unroll
            for (int n = 0; n < 2; ++n) gv[bj][n] = *(const f32x4*)(mod + (size_t)b * 6144 + 2048 + col0 + bj * HALF + n * 16);
#pragma unroll
        for (int ai = 0; ai < 2; ++ai)
#pragma unroll
            for (int m = 0; m < 4; ++m) { const size_t off = (size_t)(row0 + ai * HALF + m * 16) * 1024 + col0;
#pragma unroll
                for (int bj = 0; bj < 2; ++bj)
#pragma unroll
                    for (int n = 0; n < 2; ++n) { const f32x4 xv = *(const f32x4*)(x + off + bj * HALF + n * 16);
                        *(f32x4*)(X1 + off + bj * HALF + n * 16) = xv + gv[bj][n] * acc[ai][bj][m][n]; } }
    }
};
__device__ __forceinline__ float silu_f(float g) { return g * __builtin_amdgcn_rcpf(1.0f + __builtin_amdgcn_exp2f(-1.4426950408889634f * g)); }
struct EpiGateUp {
    static constexpr bool PERM = true, AFTER_DRAIN = false;
    bf16_t* H;
    __device__ __forceinline__ void operator()(const f32x4 (&acc)[2][2][4][2], const Unit& u, int wr, int wc, int fr, int fq) const {
        const int row0 = u.pm * BM + wr * 64 + fr, col0 = (u.pn & 3) * 128 + wc * 32 + 8 * fq;
#pragma unroll
        for (int ai = 0; ai < 2; ++ai)
#pragma unroll
            for (int m = 0; m < 4; ++m) { bf16_t* rowp = H + (size_t)(row0 + ai * HALF + m * 16) * 512 + col0;
                const f32x4 g0 = acc[ai][0][m][0], g1 = acc[ai][0][m][1], u0 = acc[ai][1][m][0], u1 = acc[ai][1][m][1];
                u32x4 w;
                w.x = cvt_pk_bf16(silu_f(g0[0]) * u0[0], silu_f(g0[1]) * u0[1]); w.y = cvt_pk_bf16(silu_f(g0[2]) * u0[2], silu_f(g0[3]) * u0[3]);
                w.z = cvt_pk_bf16(silu_f(g1[0]) * u1[0], silu_f(g1[1]) * u1[1]); w.w = cvt_pk_bf16(silu_f(g1[2]) * u1[2], silu_f(g1[3]) * u1[3]);
                *(u32x4*)rowp = w; }
    }
};
struct EpiDown {
    static constexpr bool PERM = true, AFTER_DRAIN = false;
    bf16_t* YA; const int* slot; const float* gatew; const PG8_LAS int* T;
    __device__ __forceinline__ void operator()(const f32x4 (&acc)[2][2][4][2], const Unit& u, int wr, int wc, int fr, int fq) const {
        const int e = u.pn >> 2, cnt = T[e], pos0 = (u.pm - T[32 + e]) * BM + wr * 64 + fr, col0 = (u.pn & 3) * BM + wc * 32 + 8 * fq;
        int asg[2][4];
#pragma unroll
        for (int ai = 0; ai < 2; ++ai)
#pragma unroll
            for (int m = 0; m < 4; ++m) { const int pos = pos0 + ai * HALF + m * 16; asg[ai][m] = pos < cnt ? slot[e * 16384 + pos] : -1; }
#pragma unroll
        for (int ai = 0; ai < 2; ++ai)
#pragma unroll
            for (int m = 0; m < 4; ++m) { const int as = asg[ai][m];
                if (as >= 0) { const float gw = gatew[as]; bf16_t* rowp = YA + (size_t)as * 1024 + col0;
#pragma unroll
                    for (int bj = 0; bj < 2; ++bj) { const f32x4 v0 = acc[ai][bj][m][0] * gw, v1 = acc[ai][bj][m][1] * gw;
                        u32x4 w; w.x = cvt_pk_bf16(v0[0], v0[1]); w.y = cvt_pk_bf16(v0[2], v0[3]); w.z = cvt_pk_bf16(v1[0], v1[1]); w.w = cvt_pk_bf16(v1[2], v1[3]);
                        *(u32x4*)(rowp + bj * HALF) = w; } } }
    }
};
struct OrderInProj {
    int G, c;
    __device__ __forceinline__ bool next(int i, Unit& u) const {
        const long L = (long)i * G + c; if (L >= 656) return false;
        if (L < 640) { int wgid = (int)L; const int xcd = wgid % NXCD, off = wgid / NXCD; wgid = xcd * 80 + off;
            const int nig = WGM * 10; const int fm = (wgid / nig) * WGM; u.pm = fm + ((wgid % nig) % WGM); u.pn = (wgid % nig) / WGM; }
        else { const int j = (int)L - 640; u.pm = 64 + (j >> 1); u.pn = j & 1; }
        return true;
    }
    __device__ __forceinline__ void a_ready(const Unit&) const {}
    __device__ __forceinline__ void done(const Unit&) const {}
};
struct OrderMoE {
    int G, c, NU; const PG8_LAS int* TE;
    __device__ __forceinline__ bool next(int i, Unit& u) const {
        const long L = (long)i * G + c; if (L >= NU) return false;
        const int q = NU / NXCD, r = NU % NXCD, xcd = (int)(L % NXCD), off = (int)(L / NXCD);
        const int id = (xcd < r ? xcd * (q + 1) : r * (q + 1) + (xcd - r) * q) + off;
        const int tile = id >> 2; u.pm = tile; u.pn = __builtin_amdgcn_readfirstlane(TE[tile]) * 4 + (id & 3); return true;
    }
    __device__ __forceinline__ void a_ready(const Unit&) const {}
    __device__ __forceinline__ void done(const Unit&) const {}
};
template <class Epi, class Sched, bool ALIGN_EPI = false, bool SP2 = false>
__device__ __forceinline__ void gemm_phase(PG8_LAS unsigned char* lds, const Gemm g, const Sched& S, const Epi& E) {
    const int tid = threadIdx.x, wid = __builtin_amdgcn_readfirstlane(tid >> 6), lane = tid & 63, wr = wid >> 2, wc = wid & 3, fr = lane & 15, fq = lane >> 4;
    const int K = g.K, nt = K / BK;
    unsigned voffA[2], voffB[2];
#pragma unroll
    for (int i = 0; i < 2; ++i) { int R, C; stage_rc(tid * 16 + i * 8192, R, C); const int Rb = Epi::PERM ? ((R & ~31) + perm32(R & 31)) : R;
        voffA[i] = (unsigned)(R * K + C) * 2u; voffB[i] = (unsigned)(Rb * K + C) * 2u; }
    const size_t kstep = (size_t)(BK * 2);
    const size_t hstep = (size_t)HALF * K * 2;
    const size_t tstep = 2 * hstep;
    const unsigned ldsw = (unsigned)wid * 1024u;
    const int aoff = lds_byte(wr * 64 + fr, fq * 8), boff = lds_byte(wc * 32 + fr, fq * 8);
#define PG8_SA(b, h) (((b) * 2 + (h)) * HTB)
#define PG8_SB(b, h) ((4 + (b) * 2 + (h)) * HTB)
#define PG8_STAGE(bufoff, gbase, voff) do { _Pragma("unroll") for (int _i = 0; _i < 2; ++_i) \
        __builtin_amdgcn_global_load_lds((const unsigned*)((const char*)(gbase) + (voff)[_i]), (PG8_LAS unsigned*)(lds + (bufoff) + ldsw + _i * 8192), 16, 0, 0); } while (0)
#define PG8_LDA(dst, b, h) do { _Pragma("unroll") for (int m = 0; m < 4; ++m) _Pragma("unroll") for (int k = 0; k < 2; ++k) dst[m][k] = *(const PG8_LAS bf16x8*)(lds + PG8_SA(b, h) + aoff + m * 2048 + k * 1024); } while (0)
#define PG8_LDB(dst, b, h) do { _Pragma("unroll") for (int n = 0; n < 2; ++n) _Pragma("unroll") for (int k = 0; k < 2; ++k) dst[n][k] = *(const PG8_LAS bf16x8*)(lds + PG8_SB(b, h) + boff + n * 2048 + k * 1024); } while (0)
#define PG8_MMA(ai, bj, At, Bt) do { __builtin_amdgcn_s_setprio(1); _Pragma("unroll") for (int m = 0; m < 4; ++m) _Pragma("unroll") for (int n = 0; n < 2; ++n) _Pragma("unroll") for (int k = 0; k < 2; ++k) \
        acc[ai][bj][m][n] = __builtin_amdgcn_mfma_f32_16x16x32_bf16(Bt[n][k], At[m][k], acc[ai][bj][m][n], 0, 0, 0); __builtin_amdgcn_s_setprio(0); } while (0)
#define PG8_WAIT_V(n) asm volatile("s_waitcnt vmcnt(" #n ")" ::: "memory")
#define PG8_WAIT_L(n) asm volatile("s_waitcnt lgkmcnt(" #n ")" ::: "memory")
#define PG8_BAR __builtin_amdgcn_s_barrier()
#define PG8_SCHED __builtin_amdgcn_sched_barrier(0)
    Unit cur, nxt; int ui = 0;
    if (!S.next(0, cur)) return;
    f32x4 acc[2][2][4][2];
#pragma unroll
    for (int a = 0; a < 2; ++a)
#pragma unroll
        for (int b = 0; b < 2; ++b)
#pragma unroll
            for (int m = 0; m < 4; ++m)
#pragma unroll
                for (int n = 0; n < 2; ++n) acc[a][b][m][n] = (f32x4){0.f, 0.f, 0.f, 0.f};
    bf16x8 At[4][2], B0[2][2], B1[2][2];
    const char* cA = (const char*)g.A + (size_t)cur.pm * tstep; const char* cB = (const char*)g.Bt + (size_t)cur.pn * tstep;
    S.a_ready(cur);
    if constexpr (SP2) {
        PG8_STAGE(PG8_SB(0, 0), cB, voffB); PG8_STAGE(PG8_SB(0, 1), cB + hstep, voffB); PG8_STAGE(PG8_SA(0, 0), cA, voffA); PG8_STAGE(PG8_SA(0, 1), cA + hstep, voffA);
        if (wr == 1) PG8_BAR;
        PG8_WAIT_V(2); PG8_BAR;
        PG8_STAGE(PG8_SB(1, 0), cB + kstep, voffB); PG8_STAGE(PG8_SA(1, 0), cA + kstep, voffA); PG8_STAGE(PG8_SB(1, 1), cB + hstep + kstep, voffB);
        PG8_WAIT_V(6); PG8_BAR;
    } else {
        PG8_STAGE(PG8_SB(0, 0), cB, voffB); PG8_STAGE(PG8_SA(0, 0), cA, voffA); PG8_STAGE(PG8_SB(0, 1), cB + hstep, voffB); PG8_STAGE(PG8_SA(0, 1), cA + hstep, voffA);
        if (wr == 1) PG8_BAR;
        PG8_WAIT_V(4); PG8_BAR;
        PG8_STAGE(PG8_SB(1, 0), cB + kstep, voffB); PG8_STAGE(PG8_SA(1, 0), cA + kstep, voffA); PG8_STAGE(PG8_SB(1, 1), cB + hstep + kstep, voffB);
        PG8_WAIT_V(6); PG8_BAR;
    }
    for (;;) {
        const bool has_next = S.next(ui + 1, nxt);
        const char* nA = has_next ? (const char*)g.A + (size_t)nxt.pm * tstep : cA; const char* nB = has_next ? (const char*)g.Bt + (size_t)nxt.pn * tstep : cB;
        for (int t = 0; t < nt; t += 2) {
            const bool last = (t == nt - 2);
            const char* a1 = cA + (size_t)(t + 1) * kstep;
            const char* a2 = last ? nA : cA + (size_t)(t + 2) * kstep; const char* b2 = last ? nB : cB + (size_t)(t + 2) * kstep;
            const char* a3 = a2 + kstep; const char* b3 = b2 + kstep;
            if (last && has_next) S.a_ready(nxt);
            if constexpr (SP2) {
            PG8_LDB(B0, 0, 0); PG8_LDB(B1, 0, 1); PG8_SCHED; PG8_LDA(At, 0, 0); PG8_STAGE(PG8_SA(1, 1), a1 + hstep, voffA);
            PG8_WAIT_V(8); PG8_WAIT_L(0); PG8_BAR; PG8_MMA(0, 0, At, B0); PG8_MMA(0, 1, At, B1); PG8_BAR; PG8_SCHED;
            PG8_LDA(At, 0, 1); PG8_STAGE(PG8_SB(0, 0), b2, voffB); PG8_STAGE(PG8_SB(0, 1), b2 + hstep, voffB); PG8_STAGE(PG8_SA(0, 0), a2, voffA);
            PG8_WAIT_V(8); PG8_WAIT_L(0); PG8_BAR; PG8_MMA(1, 0, At, B0); PG8_MMA(1, 1, At, B1); PG8_BAR; PG8_SCHED;
            PG8_LDB(B0, 1, 0); PG8_LDB(B1, 1, 1); PG8_SCHED; PG8_LDA(At, 1, 0); PG8_STAGE(PG8_SA(0, 1), a2 + hstep, voffA);
            PG8_WAIT_V(8); PG8_WAIT_L(0); PG8_BAR; PG8_MMA(0, 0, At, B0); PG8_MMA(0, 1, At, B1); PG8_BAR; PG8_SCHED;
            PG8_LDA(At, 1, 1); PG8_STAGE(PG8_SB(1, 0), b3, voffB); PG8_STAGE(PG8_SB(1, 1), b3 + hstep, voffB); PG8_STAGE(PG8_SA(1, 0), a3, voffA);
            PG8_WAIT_V(8); PG8_WAIT_L(0); PG8_BAR; PG8_MMA(1, 0, At, B0); PG8_MMA(1, 1, At, B1); PG8_BAR; PG8_SCHED;
            } else {
            PG8_LDB(B0, 0, 0); PG8_SCHED; PG8_LDA(At, 0, 0); PG8_STAGE(PG8_SA(1, 1), a1 + hstep, voffA);
            PG8_WAIT_L(8); PG8_BAR; PG8_WAIT_L(0); PG8_MMA(0, 0, At, B0); PG8_BAR; PG8_SCHED;
            PG8_LDB(B1, 0, 1); PG8_STAGE(PG8_SB(0, 0), b2, voffB);
            PG8_BAR; PG8_WAIT_L(0); PG8_MMA(0, 1, At, B1); PG8_BAR;
            PG8_LDA(At, 0, 1); PG8_STAGE(PG8_SA(0, 0), a2, voffA);
            PG8_BAR; PG8_WAIT_L(0); PG8_MMA(1, 0, At, B0); PG8_BAR; PG8_SCHED;
            PG8_STAGE(PG8_SB(0, 1), b2 + hstep, voffB);
            PG8_WAIT_V(6); PG8_BAR; PG8_MMA(1, 1, At, B1); PG8_BAR;
            PG8_LDB(B0, 1, 0); PG8_SCHED; PG8_LDA(At, 1, 0); PG8_STAGE(PG8_SA(0, 1), a2 + hstep, voffA);
            PG8_WAIT_L(8); PG8_BAR; PG8_WAIT_L(0); PG8_MMA(0, 0, At, B0); PG8_BAR; PG8_SCHED;
            PG8_LDB(B1, 1, 1); PG8_STAGE(PG8_SB(1, 0), b3, voffB);
            PG8_BAR; PG8_WAIT_L(0); PG8_MMA(0, 1, At, B1); PG8_BAR;
            PG8_LDA(At, 1, 1); PG8_STAGE(PG8_SA(1, 0), a3, voffA);
            PG8_BAR; PG8_WAIT_L(0); PG8_MMA(1, 0, At, B0); PG8_BAR; PG8_SCHED;
            PG8_STAGE(PG8_SB(1, 1), b3 + hstep, voffB);
            PG8_WAIT_V(6); PG8_BAR; PG8_MMA(1, 1, At, B1); PG8_BAR;
            }
        }
        if constexpr (ALIGN_EPI) { if (wr == 0) PG8_BAR; }
        if constexpr (!Epi::AFTER_DRAIN) { E(acc, cur, wr, wc, fr, fq); S.done(cur); }
        if (!has_next) break;
#pragma unroll
        for (int a = 0; a < 2; ++a)
#pragma unroll
            for (int b = 0; b < 2; ++b)
#pragma unroll
                for (int m = 0; m < 4; ++m)
#pragma unroll
                    for (int n = 0; n < 2; ++n) acc[a][b][m][n] = (f32x4){0.f, 0.f, 0.f, 0.f};
        cur = nxt; cA = nA; cB = nB; ++ui;
        if constexpr (ALIGN_EPI) { if (wr == 1) PG8_BAR; }
    }
    PG8_WAIT_V(0);
    if constexpr (!ALIGN_EPI) { if (wr == 0) PG8_BAR; }
    PG8_BAR;
    if constexpr (Epi::AFTER_DRAIN) { E.fused(acc, cur, wr, wc, fr, fq, lds, wid, lane); S.done(cur); }
#undef PG8_SA
#undef PG8_SB
#undef PG8_STAGE
#undef PG8_LDA
#undef PG8_LDB
#undef PG8_MMA
#undef PG8_WAIT_V
#undef PG8_WAIT_L
#undef PG8_BAR
#undef PG8_SCHED
}
template <class Epi, class Sched, bool ALIGN_EPI>
__device__ __forceinline__ void gemm_phase_g(PG8_LAS unsigned char* lds, const Gemm g, const Sched& S, const Epi& E, const PG8_LAS int* rowtab) {
    constexpr bool SP2 = true;
    const int tid = threadIdx.x, wid = __builtin_amdgcn_readfirstlane(tid >> 6), lane = tid & 63, wr = wid >> 2, wc = wid & 3, fr = lane & 15, fq = lane >> 4;
    const int K = g.K, nt = K / BK;
    unsigned voffB[2], vc0[2], vc1[2], vn0[2], vn1[2]; int RA[2]; unsigned CA2[2];
#pragma unroll
    for (int i = 0; i < 2; ++i) { int R, C; stage_rc(tid * 16 + i * 8192, R, C); const int Rb = Epi::PERM ? ((R & ~31) + perm32(R & 31)) : R;
        RA[i] = R; CA2[i] = (unsigned)C * 2u; voffB[i] = (unsigned)(Rb * K + C) * 2u; }
    const unsigned rowb = (unsigned)K * 2u;
#define PG8_ROWS(ui_, o0, o1) do { _Pragma("unroll") for (int _i = 0; _i < 2; ++_i) { (o0)[_i] = (unsigned)rowtab[(ui_) * 256 + RA[_i]] * rowb + CA2[_i]; (o1)[_i] = (unsigned)rowtab[(ui_) * 256 + 128 + RA[_i]] * rowb + CA2[_i]; } } while (0)
    const size_t kstep = (size_t)(BK * 2);
    const size_t hstep = (size_t)HALF * K * 2;
    const size_t tstep = 2 * hstep;
    const unsigned ldsw = (unsigned)wid * 1024u;
    const int aoff = lds_byte(wr * 64 + fr, fq * 8), boff = lds_byte(wc * 32 + fr, fq * 8);
#define PG8_SA(b, h) (((b) * 2 + (h)) * HTB)
#define PG8_SB(b, h) ((4 + (b) * 2 + (h)) * HTB)
#define PG8_STAGE(bufoff, gbase, voff) do { _Pragma("unroll") for (int _i = 0; _i < 2; ++_i) \
        __builtin_amdgcn_global_load_lds((const unsigned*)((const char*)(gbase) + (voff)[_i]), (PG8_LAS unsigned*)(lds + (bufoff) + ldsw + _i * 8192), 16, 0, 0); } while (0)
#define PG8_LDA(dst, b, h) do { _Pragma("unroll") for (int m = 0; m < 4; ++m) _Pragma("unroll") for (int k = 0; k < 2; ++k) dst[m][k] = *(const PG8_LAS bf16x8*)(lds + PG8_SA(b, h) + aoff + m * 2048 + k * 1024); } while (0)
#define PG8_LDB(dst, b, h) do { _Pragma("unroll") for (int n = 0; n < 2; ++n) _Pragma("unroll") for (int k = 0; k < 2; ++k) dst[n][k] = *(const PG8_LAS bf16x8*)(lds + PG8_SB(b, h) + boff + n * 2048 + k * 1024); } while (0)
#define PG8_MMA(ai, bj, At, Bt) do { __builtin_amdgcn_s_setprio(1); _Pragma("unroll") for (int m = 0; m < 4; ++m) _Pragma("unroll") for (int n = 0; n < 2; ++n) _Pragma("unroll") for (int k = 0; k < 2; ++k) \
        acc[ai][bj][m][n] = __builtin_amdgcn_mfma_f32_16x16x32_bf16(Bt[n][k], At[m][k], acc[ai][bj][m][n], 0, 0, 0); __builtin_amdgcn_s_setprio(0); } while (0)
#define PG8_WAIT_V(n) asm volatile("s_waitcnt vmcnt(" #n ")" ::: "memory")
#define PG8_WAIT_L(n) asm volatile("s_waitcnt lgkmcnt(" #n ")" ::: "memory")
#define PG8_BAR __builtin_amdgcn_s_barrier()
#define PG8_SCHED __builtin_amdgcn_sched_barrier(0)
    Unit cur, nxt; int ui = 0;
    if (!S.next(0, cur)) return;
    f32x4 acc[2][2][4][2];
#pragma unroll
    for (int a = 0; a < 2; ++a)
#pragma unroll
        for (int b = 0; b < 2; ++b)
#pragma unroll
            for (int m = 0; m < 4; ++m)
#pragma unroll
                for (int n = 0; n < 2; ++n) acc[a][b][m][n] = (f32x4){0.f, 0.f, 0.f, 0.f};
    bf16x8 At[4][2], B0[2][2], B1[2][2];
    const char* const cA = (const char*)g.A; PG8_ROWS(0, vc0, vc1); const char* cB = (const char*)g.Bt + (size_t)cur.pn * tstep;
    S.a_ready(cur);
    if constexpr (SP2) {
        PG8_STAGE(PG8_SB(0, 0), cB, voffB); PG8_STAGE(PG8_SB(0, 1), cB + hstep, voffB); PG8_STAGE(PG8_SA(0, 0), cA, vc0); PG8_STAGE(PG8_SA(0, 1), cA, vc1);
        if (wr == 1) PG8_BAR;
        PG8_WAIT_V(2); PG8_BAR;
        PG8_STAGE(PG8_SB(1, 0), cB + kstep, voffB); PG8_STAGE(PG8_SA(1, 0), cA + kstep, vc0); PG8_STAGE(PG8_SB(1, 1), cB + hstep + kstep, voffB);
        PG8_WAIT_V(6); PG8_BAR;
    }
    for (;;) {
        const bool has_next = S.next(ui + 1, nxt);
        const char* nB = has_next ? (const char*)g.Bt + (size_t)nxt.pn * tstep : cB;
        if (has_next) PG8_ROWS(ui + 1, vn0, vn1); else { vn0[0] = vc0[0]; vn0[1] = vc0[1]; vn1[0] = vc1[0]; vn1[1] = vc1[1]; }
        for (int t = 0; t < nt; t += 2) {
            const bool last = (t == nt - 2);
            const char* a1 = cA + (size_t)(t + 1) * kstep;
            const char* a2 = last ? cA : cA + (size_t)(t + 2) * kstep; const char* b2 = last ? nB : cB + (size_t)(t + 2) * kstep;
            const unsigned s0_[2] = {last ? vn0[0] : vc0[0], last ? vn0[1] : vc0[1]}, s1_[2] = {last ? vn1[0] : vc1[0], last ? vn1[1] : vc1[1]};
            const char* a3 = a2 + kstep; const char* b3 = b2 + kstep;
            if (last && has_next) S.a_ready(nxt);
            if constexpr (SP2) {
            PG8_LDB(B0, 0, 0); PG8_LDB(B1, 0, 1); PG8_SCHED; PG8_LDA(At, 0, 0); PG8_STAGE(PG8_SA(1, 1), a1, vc1);
            PG8_WAIT_V(8); PG8_WAIT_L(0); PG8_BAR; PG8_MMA(0, 0, At, B0); PG8_MMA(0, 1, At, B1); PG8_BAR; PG8_SCHED;
            PG8_LDA(At, 0, 1); PG8_STAGE(PG8_SB(0, 0), b2, voffB); PG8_STAGE(PG8_SB(0, 1), b2 + hstep, voffB); PG8_STAGE(PG8_SA(0, 0), a2, s0_);
            PG8_WAIT_V(8); PG8_WAIT_L(0); PG8_BAR; PG8_MMA(1, 0, At, B0); PG8_MMA(1, 1, At, B1); PG8_BAR; PG8_SCHED;
            PG8_LDB(B0, 1, 0); PG8_LDB(B1, 1, 1); PG8_SCHED; PG8_LDA(At, 1, 0); PG8_STAGE(PG8_SA(0, 1), a2, s1_);
            PG8_WAIT_V(8); PG8_WAIT_L(0); PG8_BAR; PG8_MMA(0, 0, At, B0); PG8_MMA(0, 1, At, B1); PG8_BAR; PG8_SCHED;
            PG8_LDA(At, 1, 1); PG8_STAGE(PG8_SB(1, 0), b3, voffB); PG8_STAGE(PG8_SB(1, 1), b3 + hstep, voffB); PG8_STAGE(PG8_SA(1, 0), a3, s0_);
            PG8_WAIT_V(8); PG8_WAIT_L(0); PG8_BAR; PG8_MMA(1, 0, At, B0); PG8_MMA(1, 1, At, B1); PG8_BAR; PG8_SCHED;
            }
        }
        if constexpr (ALIGN_EPI) { if (wr == 0) PG8_BAR; }
        if constexpr (!Epi::AFTER_DRAIN) { E(acc, cur, wr, wc, fr, fq); S.done(cur); }
        if (!has_next) break;
#pragma unroll
        for (int a = 0; a < 2; ++a)
#pragma unroll
            for (int b = 0; b < 2; ++b)
#pragma unroll
                for (int m = 0; m < 4; ++m)
#pragma unroll
                    for (int n = 0; n < 2; ++n) acc[a][b][m][n] = (f32x4){0.f, 0.f, 0.f, 0.f};
        cur = nxt; cB = nB; ++ui; vc0[0] = vn0[0]; vc0[1] = vn0[1]; vc1[0] = vn1[0]; vc1[1] = vn1[1];
        if constexpr (ALIGN_EPI) { if (wr == 1) PG8_BAR; }
    }
    PG8_WAIT_V(0);
    if constexpr (!ALIGN_EPI) { if (wr == 0) PG8_BAR; }
    PG8_BAR;
    if constexpr (Epi::AFTER_DRAIN) { E.fused(acc, cur, wr, wc, fr, fq, lds, wid, lane); S.done(cur); }
#undef PG8_ROWS
#undef PG8_SA
#undef PG8_SB
#undef PG8_STAGE
#undef PG8_LDA
#undef PG8_LDB
#undef PG8_MMA
#undef PG8_WAIT_V
#undef PG8_WAIT_L
#undef PG8_BAR
#undef PG8_SCHED
}
}

#ifndef MK_N_LAUNCHES
#define MK_N_LAUNCHES 1
#endif
constexpr int N_PHASES = 11;
constexpr int NWAVES = 8;
#define GAS __attribute__((address_space(1)))
#define LAS __attribute__((address_space(3)))
typedef unsigned short bf16;
typedef unsigned v4u __attribute__((ext_vector_type(4)));
typedef unsigned v2u __attribute__((ext_vector_type(2)));
typedef float f32x4 __attribute__((ext_vector_type(4)));
typedef float f32x16 __attribute__((ext_vector_type(16)));
typedef short bf16x8 __attribute__((ext_vector_type(8)));
#define LDS_WAIT() asm volatile("s_waitcnt lgkmcnt(0)" ::: "memory")
#define RLX_AGENT __ATOMIC_RELAXED, __HIP_MEMORY_SCOPE_AGENT

constexpr int NB = 8, SEQ = 2048, DM = 1024, CTXL = 256, NTOK = NB * SEQ, NCTX = NB * CTXL, DIN = 2560, NEXP = 32;
constexpr float NORM_EPS = 1e-6f;
enum { I_X = 0, I_C, I_CTX, I_CCTX, I_ADAW, I_ADAB, I_N1G, I_N2G, I_WIN, I_RCW, I_RCB, I_RGWA, I_RGBA, I_RGWX, I_RGBX, I_RGLAM, I_SCW, I_WOUT, I_RGRW, I_RGRB, I_REW, I_REB, I_EWG, I_EWU, I_EWD, I_FNG, N_IN };

constexpr size_t MiB = 1u << 20;
constexpr size_t WS_CTL = 0, CTL_ZERO_BYTES = 1 * MiB;
constexpr size_t WS_MODP = 1 * MiB;
constexpr size_t WS_MOD = 5 * MiB;
constexpr size_t WS_WRT = 5 * MiB + 512 * 1024;
constexpr size_t WS_WRG = 5 * MiB + 768 * 1024;
constexpr size_t WS_WIN = 6 * MiB;
constexpr size_t WS_WOUT = 11 * MiB;
constexpr size_t WS_WGU = 13 * MiB;
constexpr size_t WS_WD = 77 * MiB;
constexpr size_t WS_AGG = 109 * MiB;
constexpr size_t WS_SLOT = 112 * MiB;
constexpr size_t WS_GATEW = 114 * MiB;
constexpr size_t WS_SMAP = 114 * MiB + 256 * 1024;
constexpr size_t WS_RA = 115 * MiB;
constexpr size_t WS_ZC = WS_RA + 80 * MiB;
constexpr size_t WS_RB = 197 * MiB;
constexpr size_t WS_END = 237 * MiB;
constexpr size_t WS_YA = WS_WGU;
constexpr int CW_BAR = 4096;
constexpr int CW_CNT = 16384;
constexpr int RING_BYTES = 131072, LDSCTL_OFF = 133120, TBL_OFF = LDSCTL_OFF + 512, LDS_BYTES = 147456;

__device__ __forceinline__ float bflo(unsigned w) { return __uint_as_float(w << 16); }
__device__ __forceinline__ float bfhi(unsigned w) { return __uint_as_float(w & 0xffff0000u); }
__device__ __forceinline__ unsigned pk2(float lo, float hi) { return pg8::cvt_pk_bf16(lo, hi); }
__device__ __forceinline__ float wave_sum(float v) {
#pragma unroll
    for (int o = 1; o < 64; o <<= 1) v += __shfl_xor(v, o);
    return v;
}

#define XB_TMO      128
#define XB_XCNT(j)  (256  + 64 * (j))
#define XB_XSUB(j)  (1280 + 64 * (j))
#define XB_XGEN(j)  (2304 + 64 * (j))
#define XB_TOP      3328
#define XB_TOPGEN   3392
#define XCD_BAR_WORDS 3456
#define XB_SPIN_CAP (1u << 18)
__device__ __forceinline__ unsigned xb_ld(unsigned* p)              { return __hip_atomic_load(p, __ATOMIC_RELAXED, __HIP_MEMORY_SCOPE_AGENT); }
__device__ __forceinline__ unsigned xb_add(unsigned* p, unsigned v) { return __hip_atomic_fetch_add(p, v, __ATOMIC_RELAXED, __HIP_MEMORY_SCOPE_AGENT); }
__device__ __forceinline__ unsigned xb_xcc_id() { return (unsigned)__builtin_amdgcn_s_getreg((3 << 11) | 20) & 0xFu; }
#define XB_SPIN(cond, bar) do { unsigned _sp = 0; while (cond) { __builtin_amdgcn_s_sleep(1); \
    if ((++_sp & 255u) == 0u) { if (xb_ld(&(bar)[XB_TMO])) break; if (_sp > XB_SPIN_CAP) { atomicAdd(&(bar)[XB_TMO], 1u); break; } } } } while (0)
struct XcdBarrier { unsigned* bar; unsigned x; volatile LAS unsigned* st; };
__device__ __forceinline__ XcdBarrier xcd_barrier_post(unsigned* bar, volatile LAS unsigned* st) {
    XcdBarrier b; b.bar = bar; b.x = xb_xcc_id(); b.st = st;
    if (threadIdx.x == 0) (void)xb_add(&bar[XB_XCNT(b.x)], 1u);
    return b;
}
__device__ __forceinline__ void xcd_barrier_complete(unsigned* bar, unsigned x, unsigned& nloc, unsigned& nx) {
    const unsigned G = gridDim.x * gridDim.y * gridDim.z;
    unsigned sum, cnt, mine, sp = 0u;
    for (;;) {
        sum = 0u; cnt = 0u; mine = 0u;
#pragma unroll
        for (unsigned j = 0; j < 16; ++j) { const unsigned c = xb_ld(&bar[XB_XCNT(j)]); sum += c; cnt += (c > 0u) ? 1u : 0u; mine = (j == x) ? c : mine; }
        if (sum == G) break;
        __builtin_amdgcn_s_sleep(1);
        if ((++sp & 255u) == 0u) { if (xb_ld(&bar[XB_TMO])) break; if (sp > XB_SPIN_CAP) { atomicAdd(&bar[XB_TMO], 1u); break; } }
    }
    nloc = mine > 0u ? mine : 1u; nx = cnt > 0u ? cnt : 1u;
}
__device__ __forceinline__ void xcd_barrier(const XcdBarrier& b) {
    asm volatile("s_waitcnt vmcnt(0)" ::: "memory");
    __syncthreads();
    if (threadIdx.x == 0) {
        unsigned* bar = b.bar;
        __builtin_amdgcn_s_waitcnt(0);
        unsigned nloc = b.st[0], nx = b.st[1];
        if (nloc == 0u) { xcd_barrier_complete(bar, b.x, nloc, nx); b.st[0] = nloc; b.st[1] = nx; }
        const unsigned old = xb_add(&bar[XB_XSUB(b.x)], 1u);
        const unsigned gen = old / nloc;
        if (old + 1u == (gen + 1u) * nloc) {
            __builtin_amdgcn_fence(__ATOMIC_RELEASE, "agent");
            asm volatile("s_waitcnt vmcnt(0)" ::: "memory");
            const unsigned og = xb_add(&bar[XB_TOP], 1u);
            const unsigned tg = og / nx;
            if (og + 1u == (tg + 1u) * nx) xb_add(&bar[XB_TOPGEN], 1u);
            else XB_SPIN(xb_ld(&bar[XB_TOPGEN]) == tg, bar);
            __builtin_amdgcn_fence(__ATOMIC_ACQUIRE, "agent");
            xb_add(&bar[XB_XGEN(b.x)], 1u);
            asm volatile("s_waitcnt vmcnt(0)" ::: "memory");
        } else {
            XB_SPIN(xb_ld(&bar[XB_XGEN(b.x)]) == gen, bar);
            __builtin_amdgcn_fence(__ATOMIC_ACQUIRE, "agent");
            asm volatile("s_waitcnt vmcnt(0)" ::: "memory");
        }
    }
    __syncthreads();
}

struct Args { const float* in[N_IN]; float* out; unsigned char* ws; int ph_lo, ph_hi; };
struct Frame { LAS unsigned char* lds; int tid, lane, wave, G, bid; };

struct TrItem { const float* src; bf16* dst; int N, KP; };
__device__ __forceinline__ void tr_load(const TrItem& t, f32x4 (&v)[16]) {
#pragma unroll
    for (int i = 0; i < 16; ++i) v[i] = *(const f32x4*)(t.src + (size_t)(4 * i) * t.N);
}
__device__ __forceinline__ void tr_finish(const TrItem& t, const f32x4 (&v)[16], LAS float* scr, int lane) {
    const int kq = lane >> 4, nb = 4 * (lane & 15);
#pragma unroll
    for (int i = 0; i < 16; ++i) { const int kk = 4 * i + kq;
        scr[(nb + 0) * 65 + kk] = v[i].x; scr[(nb + 1) * 65 + kk] = v[i].y; scr[(nb + 2) * 65 + kk] = v[i].z; scr[(nb + 3) * 65 + kk] = v[i].w; }
    LDS_WAIT(); asm volatile("" ::: "memory");
    const int c = lane & 7;
#pragma unroll
    for (int j = 0; j < 8; ++j) { const int n = (lane >> 3) + 8 * j; const LAS float* sp = scr + n * 65 + 8 * c;
        v4u o; o.x = pk2(sp[0], sp[1]); o.y = pk2(sp[2], sp[3]); o.z = pk2(sp[4], sp[5]); o.w = pk2(sp[6], sp[7]);
        *(v4u*)(t.dst + (size_t)(8 * j) * t.KP) = o; }
    LDS_WAIT(); asm volatile("" ::: "memory");
}
__device__ __forceinline__ void gemv_item(const Args& a, int item, LAS float* scr, int lane) {
    const int ks = item / 24, nb = item % 24, k0 = ks * 64, n0 = nb * 256 + 4 * lane;
    const float* cc = a.in[I_C]; const float* cx = a.in[I_CCTX]; const float* W = a.in[I_ADAW];
#pragma unroll
    for (int r = 0; r < 9; ++r) { const float v = r < 8 ? cc[r * 1024 + k0 + lane] : cx[k0 + lane]; scr[r * 64 + lane] = v / (1.0f + __expf(-v)); }
    LDS_WAIT(); asm volatile("" ::: "memory");
    f32x4 acc[9];
#pragma unroll
    for (int r = 0; r < 9; ++r) acc[r] = (f32x4){0.f, 0.f, 0.f, 0.f};
#pragma unroll 16
    for (int kk = 0; kk < 64; ++kk) { const f32x4 w = *(const f32x4*)(W + (size_t)(k0 + kk) * 6144 + n0);
#pragma unroll
        for (int r = 0; r < 9; ++r) acc[r] += scr[r * 64 + kk] * w; }
    float* MODP = (float*)(a.ws + WS_MODP);
#pragma unroll
    for (int r = 0; r < 9; ++r) *(f32x4*)(MODP + ((size_t)ks * 9 + r) * 6144 + n0) = acc[r];
    LDS_WAIT(); asm volatile("" ::: "memory");
}
constexpr int IT_GEMV = 384, IT_WRT = 72;
constexpr int TT_WIN = 16 * 40, TT_WOUT = 16 * 16, TT_RG = 32, TT_GU = 8192, TT_DOWN = 4096, TT_TOTAL = TT_WIN + TT_WOUT + TT_RG + TT_GU + TT_DOWN;
__device__ __forceinline__ TrItem tr_decode(const Args& a, int r, int lane) {
    const float* W; bf16* WT; int N, KP, drow0, k0, n0;
    if (r < TT_WIN) { const int kb = r / 40, nb = r % 40; W = a.in[I_WIN]; WT = (bf16*)(a.ws + WS_WIN); N = 2560; KP = 1024; drow0 = 64 * nb; k0 = 64 * kb; n0 = 64 * nb; }
    else if (r < TT_WIN + TT_WOUT) { const int q = r - TT_WIN, kb = q >> 4, nb = q & 15; W = a.in[I_WOUT]; WT = (bf16*)(a.ws + WS_WOUT); N = 1024; KP = 1024; drow0 = 64 * nb; k0 = 64 * kb; n0 = 64 * nb; }
    else if (r < TT_WIN + TT_WOUT + TT_RG) { const int mat = r - TT_WIN - TT_WOUT, g = mat >> 4, d = (mat >> 3) & 1, h = mat & 7;
        W = (g ? a.in[I_RGWX] : a.in[I_RGWA]) + (size_t)(d * 8 + h) * 4096; WT = (bf16*)(a.ws + WS_WRG); N = 64; KP = 64; drow0 = h * 256 + d * 128 + g * 64; k0 = 0; n0 = 0; }
    else if (r < TT_WIN + TT_WOUT + TT_RG + TT_GU) { int q = r - TT_WIN - TT_WOUT - TT_RG; const int up = q >> 12; q &= 4095; const int e = q >> 7, it2 = q & 127, kb = it2 >> 3, nb = it2 & 7;
        n0 = 64 * nb; k0 = 64 * kb; W = (up ? a.in[I_EWU] : a.in[I_EWG]) + (size_t)e * 524288; WT = (bf16*)(a.ws + WS_WGU); N = 512; KP = 1024; drow0 = e * 1024 + (n0 >> 7) * 256 + up * 128 + (n0 & 127); }
    else { const int q = r - TT_WIN - TT_WOUT - TT_RG - TT_GU, e = q >> 7, it2 = q & 127, kb = it2 >> 4, nb = it2 & 15;
        n0 = 64 * nb; k0 = 64 * kb; W = a.in[I_EWD] + (size_t)e * 524288; WT = (bf16*)(a.ws + WS_WD); N = 1024; KP = 512; drow0 = e * 1024 + n0; }
    TrItem t; t.N = N; t.KP = KP;
    t.src = W + (size_t)(k0 + (lane >> 4)) * N + n0 + 4 * (lane & 15);
    t.dst = WT + (size_t)(drow0 + (lane >> 3)) * KP + k0 + 8 * (lane & 7);
    return t;
}
__device__ __forceinline__ void p0_prep(const Args& a, Frame& F) {
    LAS float* scr = (LAS float*)(F.lds + F.wave * 16640);
    const int gw = F.wave * F.G + F.bid, NGW = F.G * NWAVES, lane = F.lane;
    float* WrT = (float*)(a.ws + WS_WRT);
    for (int it = gw; it < IT_GEMV + IT_WRT; it += NGW) {
        if (it < IT_GEMV) { gemv_item(a, it, scr, lane); continue; }
        const int r = it - IT_GEMV; const float* rgw = a.in[I_RGRW]; const float* rew = a.in[I_REW];
#pragma unroll
        for (int i = 0; i < 8; ++i) { const int idx = r * 512 + lane + 64 * i, j = idx >> 10, k = idx & 1023; WrT[idx] = j < 4 ? rgw[k * 4 + j] : rew[k * 32 + (j - 4)]; }
    }
    f32x4 vA[16], vB[16]; TrItem tA, tB;
    int it = gw;
    if (it < TT_TOTAL) { tA = tr_decode(a, TT_TOTAL - 1 - it, lane); tr_load(tA, vA); }
    while (it < TT_TOTAL) {
        int it2 = it + NGW;
        if (it2 < TT_TOTAL) { tB = tr_decode(a, TT_TOTAL - 1 - it2, lane); tr_load(tB, vB); }
        tr_finish(tA, vA, scr, lane);
        it = it2; if (it >= TT_TOTAL) break;
        it2 = it + NGW;
        if (it2 < TT_TOTAL) { tA = tr_decode(a, TT_TOTAL - 1 - it2, lane); tr_load(tA, vA); }
        tr_finish(tB, vB, scr, lane);
        it = it2;
    }
}

__device__ __forceinline__ void norm_row_mod(const float* src, bf16* dst, const LAS float* GS, const LAS float* SH, int lane) {
    const f32x4* xr = (const f32x4*)src + lane; f32x4 v[4]; float ss = 0.f;
#pragma unroll
    for (int j = 0; j < 4; ++j) { v[j] = xr[64 * j]; ss += (v[j].x * v[j].x + v[j].y * v[j].y) + (v[j].z * v[j].z + v[j].w * v[j].w); }
    const float rstd = 1.0f / sqrtf(wave_sum(ss) * (1.0f / 1024.0f) + NORM_EPS);
#pragma unroll
    for (int j = 0; j < 4; ++j) { const f32x4 g = *(const LAS f32x4*)(GS + 4 * lane + 256 * j), s = *(const LAS f32x4*)(SH + 4 * lane + 256 * j);
        const f32x4 y = (v[j] * rstd) * g + s; v2u o; o.x = pk2(y.x, y.y); o.y = pk2(y.z, y.w);
        *(v2u*)(dst + 4 * lane + 256 * j) = o; }
}
__device__ __forceinline__ void p1_norm(const Args& a, Frame& F) {
    const float* MODP = (const float*)(a.ws + WS_MODP); float* MOD = (float*)(a.ws + WS_MOD); bf16* XN = (bf16*)(a.ws + WS_RB);
    const float* adab = a.in[I_ADAB]; const float* n1g = a.in[I_N1G];
    LAS float* GS = (LAS float*)F.lds; LAS float* SH = GS + 1024; LAS float* GSC = GS + 2048; LAS float* SHC = GS + 3072;
    for (int blk = F.bid; blk < 256; blk += F.G) {
        const int b = blk >> 5;
        for (int k = F.tid; k < 1024; k += NWAVES * 64) {
            float s_sh = adab[k], s_sc = adab[1024 + k], c_sh = s_sh, c_sc = s_sc;
#pragma unroll 4
            for (int ks = 0; ks < 16; ++ks) { const float* base = MODP + (size_t)ks * 9 * 6144;
                s_sh += base[b * 6144 + k]; s_sc += base[b * 6144 + 1024 + k]; c_sh += base[8 * 6144 + k]; c_sc += base[8 * 6144 + 1024 + k]; }
            const float g = n1g[k]; GS[k] = g * (1.0f + s_sc); SH[k] = s_sh; GSC[k] = g * (1.0f + c_sc); SHC[k] = c_sh;
        }
        if (F.tid < 216) { const int r = F.tid / 24, n = blk * 24 + F.tid % 24; float s = adab[n];
#pragma unroll 4
            for (int ks = 0; ks < 16; ++ks) s += MODP[((size_t)ks * 9 + r) * 6144 + n];
            MOD[r * 6144 + n] = s; }
        __syncthreads();
#pragma unroll 1
        for (int j = 0; j < 9; ++j) { const bool isctx = j == 8;
            const int row = isctx ? NTOK + blk * 8 + F.wave : blk * 64 + F.wave * 8 + j;
            const float* src = isctx ? a.in[I_CTX] + (size_t)(blk * 8 + F.wave) * 1024 : a.in[I_X] + (size_t)row * 1024;
            norm_row_mod(src, XN + (size_t)row * 1024, isctx ? GSC : GS, isctx ? SHC : SH, F.lane); }
        __syncthreads();
    }
}

__device__ __forceinline__ void ld8(const bf16* p, float (&f)[8]) { const v4u w = *(const v4u*)p;
    f[0] = bflo(w.x); f[1] = bfhi(w.x); f[2] = bflo(w.y); f[3] = bfhi(w.y); f[4] = bflo(w.z); f[5] = bfhi(w.z); f[6] = bflo(w.w); f[7] = bfhi(w.w); }
__device__ __forceinline__ v4u pack8(const float (&f)[8]) { v4u w; w.x = pk2(f[0], f[1]); w.y = pk2(f[2], f[3]); w.z = pk2(f[4], f[5]); w.w = pk2(f[6], f[7]); return w; }

__device__ __forceinline__ void yconv_item(const Args& a, Frame& F, int b, int r) {
    const bf16* Z = (const bf16*)(a.ws + WS_RA); bf16* Y = (bf16*)(a.ws + WS_RB); const float* scw = a.in[I_SCW];
    const int cg = F.tid & 63, c0 = cg * 8; const bool vert = cg >= 32; const int stride = vert ? 64 : 1;
    float wk[3][8];
#pragma unroll
    for (int k = 0; k < 3; ++k)
#pragma unroll
        for (int i = 0; i < 8; ++i) wk[k][i] = scw[k * 512 + c0 + i];
#pragma unroll 2
    for (int j = 0; j < 8; ++j) { const int w = (F.tid >> 6) + 8 * j, t = r * 64 + w;
        float acc[8];
#pragma unroll
        for (int i = 0; i < 8; ++i) acc[i] = 0.f;
#pragma unroll
        for (int k = 0; k < 3; ++k) { const int p = (vert ? r : w) + k - 1; const bool valid = p >= 0 && p < (vert ? 32 : 64);
            const int tn = valid ? t + (k - 1) * stride : t; const bf16* zr = Z + (size_t)(b * SEQ + tn) * DIN;
            float cv[8], vv[8]; ld8(zr + 2048 + c0, cv); ld8(zr + 1024 + c0, vv);
            const float m = valid ? 1.0f : 0.0f;
#pragma unroll
            for (int i = 0; i < 8; ++i) acc[i] += (wk[k][i] * m) * (cv[i] * vv[i]); }
        float bg[8]; ld8(Z + (size_t)(b * SEQ + t) * DIN + 1536 + c0, bg);
#pragma unroll
        for (int i = 0; i < 8; ++i) acc[i] *= bg[i];
        *(v4u*)(Y + (size_t)(b * SEQ + t) * 1024 + 512 + c0) = pack8(acc); }
}

constexpr int SC_XC = 0, SC_AB = 9216, SC_BB = 9216 + 32768, SC_SEG = 9216 + 65536, SC_HALL = SC_SEG + 4096;
template <bool PASS2>
__device__ __forceinline__ void scan_range(const Args& a, Frame& F, int b, int h, int vc0, int nvc) {
    const int tid = F.tid, lane = F.lane, wave = F.wave;
    LAS bf16* XC = (LAS bf16*)(F.lds + SC_XC);
    LAS float* AB = (LAS float*)(F.lds + SC_AB);
    LAS float* BB = (LAS float*)(F.lds + SC_BB);
    LAS float* SEG = (LAS float*)(F.lds + SC_SEG);
    LAS float* HALL = (LAS float*)(F.lds + SC_HALL);
    const bf16* Z = (const bf16*)(a.ws + WS_RA); const bf16* Zc = (const bf16*)(a.ws + WS_ZC);
    const bf16* WrgT = (const bf16*)(a.ws + WS_WRG); float* AGG = (float*)(a.ws + WS_AGG); bf16* Y = (bf16*)(a.ws + WS_RB);
    const int d = wave >> 2, chh = (wave >> 1) & 1, shf = wave & 1, r = lane & 31, hh = lane >> 5;
    bf16x8 br[4], bi[4];
    { const bf16* wr_ = WrgT + (size_t)(h * 256 + d * 128 + chh * 32 + r) * 64 + hh * 8;
#pragma unroll
      for (int ks = 0; ks < 4; ++ks) { br[ks] = *(const bf16x8*)(wr_ + ks * 16); bi[ks] = *(const bf16x8*)(wr_ + 64 * 64 + ks * 16); } }
    const int ch = chh * 32 + r, gch = d * 512 + h * 64 + ch;
    const float ba = a.in[I_RGBA][gch] * -1.4426950408889634f, bx = a.in[I_RGBX][gch] * -1.4426950408889634f;
    const float Kc = -8.0f * 1.4426950408889634f * log1pf(expf(-a.in[I_RGLAM][gch]));
    const int cs = tid >> 3, ig = tid & 7, col = h * 64 + ig * 8;
    float cwv[4][8], cbv[8];
#pragma unroll
    for (int i = 0; i < 8; ++i) { cbv[i] = a.in[I_RCB][col + i];
#pragma unroll
        for (int k = 0; k < 4; ++k) cwv[k][i] = a.in[I_RCW][k * 512 + col + i]; }
    const int d2 = tid >> 8, seg = (tid >> 6) & 3, c = tid & 63;
    if (PASS2 && tid < 128) {
        const int dd = tid >> 6, cc = tid & 63; const float* ag = AGG + ((size_t)b * 36 * 2 + dd) * 1024 + (h * 64 + cc) * 2;
        float pv[36], sv[36];
#pragma unroll
        for (int k = 0; k < 36; ++k) { pv[k] = ag[(size_t)k * 2048]; sv[k] = ag[(size_t)k * 2048 + 1]; }
        float hc = 0.0f;
        if (dd == 0) {
#pragma unroll
            for (int k = 0; k < 36; ++k) { const int t = k - vc0; if (t >= 0 && t < nvc) HALL[(t * 2 + 0) * 64 + cc] = hc; hc = pv[k] * hc + sv[k]; }
        } else {
#pragma unroll
            for (int k = 3; k >= 0; --k) hc = pv[k] * hc + sv[k];
#pragma unroll
            for (int k = 35; k >= 4; --k) { const int t = k - vc0; if (t >= 0 && t < nvc) HALL[(t * 2 + 1) * 64 + cc] = hc; hc = pv[k] * hc + sv[k]; }
        }
    }
    v4u xq[4]; v4u gq = (v4u){0u, 0u, 0u, 0u}, gqn = gq;
    { const int vc = vc0; const bool isctx = vc < 4; const int s0 = isctx ? vc * 64 : (vc - 4) * 64, Ls = isctx ? CTXL : SEQ, pitch = isctx ? 512 : DIN;
      const bf16* src = isctx ? Zc + (size_t)b * CTXL * 512 : Z + (size_t)b * SEQ * DIN;
#pragma unroll
      for (int k = 0; k < 4; ++k) { const int sp = s0 + cs + k - 2; const int spc = (sp >= 0 && sp < Ls) ? sp : s0 + cs; xq[k] = *(const v4u*)(src + (size_t)spc * pitch + col); }
      if (PASS2) gq = *(const v4u*)(Z + ((size_t)b * SEQ + s0 + cs) * DIN + 512 + col); }
#pragma unroll 1
    for (int t = 0; t < nvc; ++t) {
        const int vc = vc0 + t; const bool isctx = vc < 4; const int s0 = isctx ? vc * 64 : (vc - 4) * 64, Ls = isctx ? CTXL : SEQ;
        { float acc[8];
#pragma unroll
          for (int i = 0; i < 8; ++i) acc[i] = cbv[i];
#pragma unroll
          for (int k = 0; k < 4; ++k) { const int sp = s0 + cs + k - 2; const float m = (sp >= 0 && sp < Ls) ? 1.0f : 0.0f;
              const v4u w = xq[k]; const float xv[8] = {bflo(w.x), bfhi(w.x), bflo(w.y), bfhi(w.y), bflo(w.z), bfhi(w.z), bflo(w.w), bfhi(w.w)};
#pragma unroll
              for (int i = 0; i < 8; ++i) acc[i] += (cwv[k][i] * m) * xv[i]; }
          *(LAS v4u*)(XC + cs * 72 + ig * 8) = pack8(acc); }
        if (t + 1 < nvc) { const int vn = vc + 1; const bool cx = vn < 4; const int s0n = cx ? vn * 64 : (vn - 4) * 64, Lsn = cx ? CTXL : SEQ, pitch = cx ? 512 : DIN;
            const bf16* src = cx ? Zc + (size_t)b * CTXL * 512 : Z + (size_t)b * SEQ * DIN;
#pragma unroll
            for (int k = 0; k < 4; ++k) { const int sp = s0n + cs + k - 2; const int spc = (sp >= 0 && sp < Lsn) ? sp : s0n + cs; xq[k] = *(const v4u*)(src + (size_t)spc * pitch + col); }
            if (PASS2) gqn = *(const v4u*)(Z + ((size_t)b * SEQ + s0n + cs) * DIN + 512 + col); }
        __syncthreads();
        { f32x16 accr, acci;
#pragma unroll
          for (int i = 0; i < 16; ++i) { accr[i] = 0.f; acci[i] = 0.f; }
#pragma unroll
          for (int ks = 0; ks < 4; ++ks) {
              const bf16x8 af = *(const LAS bf16x8*)(XC + (shf * 32 + r) * 72 + ks * 16 + hh * 8);
              accr = __builtin_amdgcn_mfma_f32_32x32x16_bf16(af, br[ks], accr, 0, 0, 0);
              acci = __builtin_amdgcn_mfma_f32_32x32x16_bf16(af, bi[ks], acci, 0, 0, 0); }
#pragma unroll
          for (int reg = 0; reg < 16; ++reg) { const int s = shf * 32 + (reg & 3) + 8 * (reg >> 2) + 4 * hh;
              const float rr = __builtin_amdgcn_rcpf(1.0f + __builtin_amdgcn_exp2f(fmaf(accr[reg], -1.4426950408889634f, ba)));
              const float ii = __builtin_amdgcn_rcpf(1.0f + __builtin_amdgcn_exp2f(fmaf(acci[reg], -1.4426950408889634f, bx)));
              const float av = __builtin_amdgcn_exp2f(Kc * rr);
              const float xcv = __uint_as_float((unsigned)XC[s * 72 + ch] << 16);
              const float bv = __builtin_amdgcn_sqrtf(fmaxf(fmaf(-av, av, 1.0f), 0.0f)) * (ii * xcv);
              AB[(d * 64 + s) * 64 + ch] = av; BB[(d * 64 + s) * 64 + ch] = bv; } }
        __syncthreads();
        float av16[16], bv16[16];
        { float P = 1.0f, Sv = 0.0f;
#pragma unroll
          for (int j = 0; j < 16; ++j) { const int vs = seg * 16 + j, s = d2 ? 63 - vs : vs; av16[j] = AB[(d2 * 64 + s) * 64 + c]; bv16[j] = BB[(d2 * 64 + s) * 64 + c]; }
#pragma unroll
          for (int j = 0; j < 16; ++j) { Sv = av16[j] * Sv + bv16[j]; P *= av16[j]; }
          SEG[((d2 * 4 + seg) * 64 + c) * 2 + 0] = P; SEG[((d2 * 4 + seg) * 64 + c) * 2 + 1] = Sv; }
        __syncthreads();
        if (!PASS2) {
            if (seg == 0) { float Pt = 1.0f, St = 0.0f;
#pragma unroll
                for (int k = 0; k < 4; ++k) { const float p = SEG[((d2 * 4 + k) * 64 + c) * 2], sg = SEG[((d2 * 4 + k) * 64 + c) * 2 + 1]; St = p * St + sg; Pt *= p; }
                float* ag = AGG + (((size_t)b * 36 + vc) * 2 + d2) * 1024 + (h * 64 + c) * 2; ag[0] = Pt; ag[1] = St; }
        } else {
            float hv = HALL[(t * 2 + d2) * 64 + c];
            for (int k = 0; k < seg; ++k) { const float p = SEG[((d2 * 4 + k) * 64 + c) * 2], sg = SEG[((d2 * 4 + k) * 64 + c) * 2 + 1]; hv = p * hv + sg; }
#pragma unroll
            for (int j = 0; j < 16; ++j) { const int vs = seg * 16 + j, s = d2 ? 63 - vs : vs; hv = av16[j] * hv + bv16[j]; BB[(d2 * 64 + s) * 64 + c] = hv; }
            __syncthreads();
            { const size_t trow = (size_t)b * SEQ + s0 + cs;
              const float g[8] = {bflo(gq.x), bfhi(gq.x), bflo(gq.y), bfhi(gq.y), bflo(gq.z), bfhi(gq.z), bflo(gq.w), bfhi(gq.w)}; float o[8];
              const f32x4 h0a = *(const LAS f32x4*)(BB + (0 * 64 + cs) * 64 + ig * 8), h0b = *(const LAS f32x4*)(BB + (0 * 64 + cs) * 64 + ig * 8 + 4);
              const f32x4 h1a = *(const LAS f32x4*)(BB + (1 * 64 + cs) * 64 + ig * 8), h1b = *(const LAS f32x4*)(BB + (1 * 64 + cs) * 64 + ig * 8 + 4);
              const float hs[8] = {h0a.x + h1a.x, h0a.y + h1a.y, h0a.z + h1a.z, h0a.w + h1a.w, h0b.x + h1b.x, h0b.y + h1b.y, h0b.z + h1b.z, h0b.w + h1b.w};
#pragma unroll
              for (int i = 0; i < 8; ++i) { const float z = g[i] + 0.044715f * g[i] * g[i] * g[i];
                  const float ge = g[i] * __builtin_amdgcn_rcpf(1.0f + __builtin_amdgcn_exp2f(-1.5957691216057308f * 1.4426950408889634f * z));
                  o[i] = ge * hs[i]; }
              *(v4u*)(Y + trow * 1024 + col) = pack8(o); }
            gq = gqn;
        }
    }
    __syncthreads();
}

__device__ __forceinline__ float red8(const float (&p)[8], int lane) {
    const bool b0 = lane & 1, b1 = lane & 2, b2 = lane & 4;
    float q[4], r2[2];
#pragma unroll
    for (int i = 0; i < 4; ++i) { const float keep = b0 ? p[i + 4] : p[i], send = b0 ? p[i] : p[i + 4]; q[i] = keep + __shfl_xor(send, 1); }
#pragma unroll
    for (int i = 0; i < 2; ++i) { const float keep = b1 ? q[i + 2] : q[i], send = b1 ? q[i] : q[i + 2]; r2[i] = keep + __shfl_xor(send, 2); }
    float s; { const float keep = b2 ? r2[1] : r2[0], send = b2 ? r2[0] : r2[1]; s = keep + __shfl_xor(send, 4); }
    s += __shfl_xor(s, 8); s += __shfl_xor(s, 16); s += __shfl_xor(s, 32);
    return s;
}
__device__ __forceinline__ void p6_route(const Args& a, Frame& F, bool commit) {
    const float* X1 = a.out; const float* MOD = (const float*)(a.ws + WS_MOD); const float* WrT = (const float*)(a.ws + WS_WRT);
    bf16* ML = (bf16*)(a.ws + WS_RB); int* SLOT = (int*)(a.ws + WS_SLOT); float* GATEW = (float*)(a.ws + WS_GATEW); unsigned* CNT = (unsigned*)(a.ws + WS_CTL) + CW_CNT;
    const float* n2g = a.in[I_N2G]; const float* rgb = a.in[I_RGRB]; const float* reb = a.in[I_REB];
    const int lane = F.lane;
    LAS float* LG = (LAS float*)(F.lds + F.wave * 2048);
    LAS float* WL = (LAS float*)(F.lds + 16384);
    if (F.bid == 0 && F.tid < 128) *(v4u*)(ML + (size_t)NTOK * 1024 + F.tid * 8) = (v4u){0u, 0u, 0u, 0u};
    for (int base = F.bid; base < NTOK / 64; base += F.G) {
        const int row0 = (base * NWAVES + F.wave) * 8, b = row0 >> 11;
        f32x4 v[8][4]; float ss[8];
#pragma unroll
        for (int r = 0; r < 8; ++r) { ss[r] = 0.f;
#pragma unroll
            for (int j = 0; j < 4; ++j) { v[r][j] = *(const f32x4*)(X1 + (size_t)(row0 + r) * 1024 + 4 * lane + 256 * j);
                ss[r] += (v[r][j].x * v[r][j].x + v[r][j].y * v[r][j].y) + (v[r][j].z * v[r][j].z + v[r][j].w * v[r][j].w); } }
#pragma unroll
        for (int r = 0; r < 8; ++r) ss[r] = 1.0f / sqrtf(wave_sum(ss[r]) * (1.0f / 1024.0f) + NORM_EPS);
#pragma unroll
        for (int j = 0; j < 4; ++j) { const int col = 4 * lane + 256 * j;
            const f32x4 gn = *(const f32x4*)(n2g + col), sc = *(const f32x4*)(MOD + (size_t)b * 6144 + 4096 + col), sh = *(const f32x4*)(MOD + (size_t)b * 6144 + 3072 + col);
            const f32x4 gs = gn * (sc + 1.0f);
#pragma unroll
            for (int r = 0; r < 8; ++r) { v[r][j] = (v[r][j] * ss[r]) * gs + sh; v2u o; o.x = pk2(v[r][j].x, v[r][j].y); o.y = pk2(v[r][j].z, v[r][j].w);
                *(v2u*)(ML + (size_t)(row0 + r) * 1024 + col) = o; } }
        const int rid = 4 * (lane & 1) + 2 * ((lane >> 1) & 1) + ((lane >> 2) & 1);
#pragma unroll 1
        for (int half = 0; half < 2; ++half) {
            __syncthreads();
#pragma unroll
            for (int i = 0; i < 9; ++i) *(LAS f32x4*)(WL + 4 * (F.tid + 512 * i)) = *(const f32x4*)(WrT + half * 18432 + 4 * (F.tid + 512 * i));
            __syncthreads();
#pragma unroll 2
            for (int jj = 0; jj < 18; ++jj) { f32x4 w[4];
#pragma unroll
                for (int j = 0; j < 4; ++j) w[j] = *(const LAS f32x4*)(WL + jj * 1024 + 4 * lane + 256 * j);
                float p[8];
#pragma unroll
                for (int r = 0; r < 8; ++r) { f32x4 q = v[r][0] * w[0]; q = v[r][1] * w[1] + q; q = v[r][2] * w[2] + q; q = v[r][3] * w[3] + q; p[r] = (q.x + q.y) + (q.z + q.w); }
                const int jo = half * 18 + jj;
                const float tot = red8(p, lane) + (jo < 4 ? rgb[jo] : reb[jo - 4]);
                if (lane < 8) LG[rid * 36 + jo] = tot; }
        }
        LDS_WAIT(); asm volatile("" ::: "memory");
        float lg[36];
#pragma unroll
        for (int jj = 0; jj < 36; ++jj) lg[jj] = LG[(lane < 8 ? rid : 0) * 36 + jj];
        int grp = 0; float gm = lg[0];
#pragma unroll
        for (int j = 1; j < 4; ++j) if (lg[j] > gm) { gm = lg[j]; grp = j; }
        float gz = 0.f;
#pragma unroll
        for (int j = 0; j < 4; ++j) gz += __expf(lg[j] - gm);
        const float pg = 1.0f / gz;
        float el[8];
#pragma unroll
        for (int i = 0; i < 8; ++i) el[i] = grp == 0 ? lg[4 + i] : grp == 1 ? lg[12 + i] : grp == 2 ? lg[20 + i] : lg[28 + i];
        int i1 = 0; float m1 = el[0];
#pragma unroll
        for (int i = 1; i < 8; ++i) if (el[i] > m1) { m1 = el[i]; i1 = i; }
        int i2 = -1; float m2 = -3.0e38f;
#pragma unroll
        for (int i = 0; i < 8; ++i) if (i != i1 && el[i] > m2) { m2 = el[i]; i2 = i; }
        const float e2 = __expf(m2 - m1), den = 1.0f / (1.0f + e2);
        if (lane < 8 && commit) { const int tok = row0 + rid;
            const int ea = grp * 8 + i1, eb = grp * 8 + i2;
            const unsigned pa = __hip_atomic_fetch_add(CNT + 64 * ea, 1u, RLX_AGENT); SLOT[ea * 16384 + pa] = tok * 2;     GATEW[tok * 2] = pg * den;
            const unsigned pb = __hip_atomic_fetch_add(CNT + 64 * eb, 1u, RLX_AGENT); SLOT[eb * 16384 + pb] = tok * 2 + 1; GATEW[tok * 2 + 1] = pg * e2 * den; }
    }
    __syncthreads();
}

__device__ __forceinline__ void build_tiles(const Args& a, Frame& F) {
    LAS int* T = (LAS int*)(F.lds + TBL_OFF); unsigned* CNT = (unsigned*)(a.ws + WS_CTL) + CW_CNT;
    if (F.tid < 32) T[F.tid] = (int)__hip_atomic_load(CNT + 64 * F.tid, RLX_AGENT);
    __syncthreads();
    if (F.tid == 0) { int acc = 0;
        for (int e = 0; e < 32; ++e) { const int n = (T[e] + 255) >> 8; T[32 + e] = acc; for (int t = 0; t < n; ++t) T[96 + acc + t] = e; acc += n; }
        T[64] = acc; }
    __syncthreads();
}
constexpr int ROWTAB_OFF = TBL_OFF + 1024;
template <class Sched>
__device__ __forceinline__ void build_rowtab(const Args& a, Frame& F, const Sched& S) {
    const LAS int* T = (const LAS int*)(F.lds + TBL_OFF); LAS int* RT = (LAS int*)(F.lds + ROWTAB_OFF); const int* SLOT = (const int*)(a.ws + WS_SLOT);
    pg8::Unit u;
    for (int i = 0; i < 4 && S.next(i, u); ++i)
        if (F.tid < 256) { const int e = u.pn >> 2, pos = (u.pm - T[32 + e]) * 256 + F.tid; RT[i * 256 + F.tid] = pos < T[e] ? (SLOT[e * 16384 + pos] >> 1) : NTOK; }
    __syncthreads();
}
__device__ __forceinline__ void p10_final(const Args& a, Frame& F, bool commit) {
    float* X1 = a.out; float* OUT = commit ? a.out : (float*)(a.ws + WS_RA); const float* MOD = (const float*)(a.ws + WS_MOD); const bf16* YA = (const bf16*)(a.ws + WS_YA); const float* fng = a.in[I_FNG];
    const int lane = F.lane;
    for (int t = F.bid * NWAVES + F.wave; t < NTOK; t += F.G * NWAVES) {
        const int b = t >> 11; f32x4 v[4]; float ss = 0.f;
#pragma unroll
        for (int j = 0; j < 4; ++j) { const int col = 4 * lane + 256 * j;
            const f32x4 x = *(const f32x4*)(X1 + (size_t)t * 1024 + col), g2 = *(const f32x4*)(MOD + (size_t)b * 6144 + 5120 + col);
            const v2u ya = *(const v2u*)(YA + (size_t)(2 * t) * 1024 + col), yb = *(const v2u*)(YA + (size_t)(2 * t + 1) * 1024 + col);
            f32x4 y; y.x = bflo(ya.x) + bflo(yb.x); y.y = bfhi(ya.x) + bfhi(yb.x); y.z = bflo(ya.y) + bflo(yb.y); y.w = bfhi(ya.y) + bfhi(yb.y);
            v[j] = x + g2 * y; ss += (v[j].x * v[j].x + v[j].y * v[j].y) + (v[j].z * v[j].z + v[j].w * v[j].w); }
        const float rstd = 1.0f / sqrtf(wave_sum(ss) * (1.0f / 1024.0f) + NORM_EPS);
#pragma unroll
        for (int j = 0; j < 4; ++j) { const int col = 4 * lane + 256 * j; const f32x4 g = *(const f32x4*)(fng + col);
            *(f32x4*)(OUT + (size_t)t * 1024 + col) = (v[j] * rstd) * g; }
    }
}

__global__ void __launch_bounds__(NWAVES * 64, 2) mk_fwd(Args a) {
    extern __shared__ __attribute__((aligned(16))) unsigned char lds_raw[];
    Frame F; F.lds = (LAS unsigned char*)lds_raw; F.tid = threadIdx.x; F.lane = F.tid & 63; F.wave = __builtin_amdgcn_readfirstlane(F.tid >> 6); F.G = gridDim.x; F.bid = blockIdx.x;
    for (int u = F.tid; u < (LDS_BYTES - LDSCTL_OFF) / 4; u += NWAVES * 64) ((LAS unsigned*)(F.lds + LDSCTL_OFF))[u] = 0u;
    __syncthreads();
    const int lo = a.ph_lo, hi = a.ph_hi;
    XcdBarrier bar; bar.bar = (unsigned*)(a.ws + WS_CTL) + CW_BAR; bar.x = 0; bar.st = nullptr;
    if (hi - lo > 1) bar = xcd_barrier_post((unsigned*)(a.ws + WS_CTL) + CW_BAR, (volatile LAS unsigned*)(F.lds + LDSCTL_OFF) + 8);
#ifndef PHMASK
#define PHMASK 0x7ff
#endif
#define IN(k) (((PHMASK >> (k)) & 1) && lo <= (k) && (k) < hi)
#define SEAM(k) do { if (IN(k) && IN((k) + 1)) xcd_barrier(bar); } while (0)
#ifndef PROBE_REP
#define PROBE_REP (-1)
#endif
#ifndef PROBE_N
#define PROBE_N 3
#endif
#ifndef PROBE_T
#define PROBE_T (-1)
#endif
#define TBEG(k) unsigned long long tb_ = 0; if (PROBE_T == (k) || PROBE_T == 99) tb_ = __builtin_amdgcn_s_memrealtime();
#define TEND(k) if (PROBE_T == (k) || PROBE_T == 99) { const unsigned long long te_ = __builtin_amdgcn_s_memrealtime(); while (__builtin_amdgcn_s_memrealtime() - te_ < te_ - tb_) __builtin_amdgcn_s_sleep(8); }
#define REPS(k) for (int rep_ = 0; rep_ < ((PROBE_REP == (k)) ? PROBE_N : 1); ++rep_)

    if (IN(0)) { TBEG(0) REPS(0) { p0_prep(a, F); } TEND(0) } SEAM(0);
    if (IN(1)) { TBEG(1) REPS(1) { p1_norm(a, F); } TEND(1) } SEAM(1);
    if (IN(2)) { TBEG(2) { {
        pg8::Gemm g{(const bf16*)(a.ws + WS_RB), (const bf16*)(a.ws + WS_WIN), NTOK + NCTX, DIN, DM}; pg8::OrderInProj S{F.G, F.bid};
        pg8::EpiInProj E{(bf16*)(a.ws + WS_RA), (bf16*)(a.ws + WS_ZC)};
        pg8::gemm_phase<pg8::EpiInProj, pg8::OrderInProj, true, true>(F.lds, g, S, E); }
    if (PROBE_REP == 2) {
        pg8::Gemm g{(const bf16*)(a.ws + WS_RB), (const bf16*)(a.ws + WS_WIN), NTOK + NCTX, DIN, DM}; pg8::OrderInProj S{F.G, F.bid};
        pg8::EpiInProj E{(bf16*)(a.ws + WS_RA), (bf16*)(a.ws + WS_ZC)};
        pg8::gemm_phase<pg8::EpiInProj, pg8::OrderInProj, true, true>(F.lds, g, S, E); } }
    TEND(2) } SEAM(2);
    if (IN(3)) { TBEG(3) REPS(3) {
        for (int it = F.bid; it < 256; it += F.G) yconv_item(a, F, it >> 5, it & 31);
        for (int w = F.bid; w < 256; w += F.G) { const int bh = w >> 2; scan_range<false>(a, F, bh >> 3, bh & 7, 9 * (w & 3), 9); } }
    TEND(3) } SEAM(3);
    if (IN(4)) { TBEG(4) REPS(4) {
        for (int w = F.bid; w < 256; w += F.G) { const int bh = w >> 2; scan_range<true>(a, F, bh >> 3, bh & 7, 4 + 8 * (w & 3), 8); } }
    TEND(4) } SEAM(4);
    if (IN(5)) { TBEG(5) REPS(5) {
        pg8::Gemm g{(const bf16*)(a.ws + WS_RB), (const bf16*)(a.ws + WS_WOUT), NTOK, DM, DM}; pg8::StaticOrder S; S.init(NTOK, DM, F.G, F.bid);
        pg8::EpiOutProj E{a.in[I_X], a.out, (const float*)(a.ws + WS_MOD)};
        pg8::gemm_phase<pg8::EpiOutProj, pg8::StaticOrder, true, true>(F.lds, g, S, E); }
    TEND(5) } SEAM(5);
    if (IN(6)) { TBEG(6) REPS(6) { p6_route(a, F, rep_ == ((PROBE_REP == 6) ? PROBE_N : 1) - 1); } TEND(6) } if (IN(6) && IN(8)) xcd_barrier(bar);
    if (IN(8)) { TBEG(8) {
        build_tiles(a, F); const LAS int* T = (const LAS int*)(F.lds + TBL_OFF);
        pg8::Gemm g{(const bf16*)(a.ws + WS_RB), (const bf16*)(a.ws + WS_WGU), 0, 0, DM}; pg8::OrderMoE S{F.G, F.bid, T[64] * 4, T + 96};
        build_rowtab(a, F, S);
        pg8::EpiGateUp E{(bf16*)(a.ws + WS_RA)};
        pg8::gemm_phase_g<pg8::EpiGateUp, pg8::OrderMoE, true>(F.lds, g, S, E, (const LAS int*)(F.lds + ROWTAB_OFF));
        if (PROBE_REP == 8) pg8::gemm_phase_g<pg8::EpiGateUp, pg8::OrderMoE, true>(F.lds, g, S, E, (const LAS int*)(F.lds + ROWTAB_OFF)); }
    TEND(8) } SEAM(8);
    if (IN(9)) { TBEG(9) {
        build_tiles(a, F); const LAS int* T = (const LAS int*)(F.lds + TBL_OFF);
        pg8::Gemm g{(const bf16*)(a.ws + WS_RA), (const bf16*)(a.ws + WS_WD), 0, 0, 512}; pg8::OrderMoE S{F.G, F.bid, T[64] * 4, T + 96};
        pg8::EpiDown E{(bf16*)(a.ws + WS_YA), (const int*)(a.ws + WS_SLOT), (const float*)(a.ws + WS_GATEW), T};
        pg8::gemm_phase<pg8::EpiDown, pg8::OrderMoE, true, true>(F.lds, g, S, E);
        if (PROBE_REP == 9) pg8::gemm_phase<pg8::EpiDown, pg8::OrderMoE, true, true>(F.lds, g, S, E); }
    TEND(9) } SEAM(9);
    if (IN(10)) { TBEG(10) REPS(10) { p10_final(a, F, rep_ == ((PROBE_REP == 10) ? PROBE_N : 1) - 1); }
    TEND(10) }
#undef IN
#undef SEAM
}

extern "C" void kernel_launch(void* const* d_in, const int* in_sizes, int n_in, void* d_out, int out_size, void* d_ws, size_t ws_size, hipStream_t stream) {
    static int grid = 0;
    if (grid == 0) {
        if (n_in != N_IN || out_size != NTOK * DM || ws_size < WS_END) { fprintf(stderr, "kernel_launch: unexpected shapes: n_in %d out %d ws %zu (need %zu)\n", n_in, out_size, ws_size, (size_t)WS_END); grid = -1; return; }
        int dev = 0, cus = 0, per_cu = 0;
        if (hipGetDevice(&dev) != hipSuccess || hipDeviceGetAttribute(&cus, hipDeviceAttributeMultiprocessorCount, dev) != hipSuccess) { grid = -1; return; }
        if (hipFuncSetAttribute((const void*)mk_fwd, hipFuncAttributeMaxDynamicSharedMemorySize, LDS_BYTES) != hipSuccess) { fprintf(stderr, "kernel_launch: hipFuncSetAttribute failed\n"); grid = -1; return; }
        if (hipOccupancyMaxActiveBlocksPerMultiprocessor(&per_cu, (const void*)mk_fwd, NWAVES * 64, LDS_BYTES) != hipSuccess || per_cu < 1) { fprintf(stderr, "kernel_launch: occupancy query says %d blocks per CU\n", per_cu); (void)hipGetLastError(); grid = -1; return; }
        grid = cus;
        if (grid > 256) grid = 256;
    }
    if (grid < 0) return;
    (void)hipMemsetAsync((char*)d_ws + WS_CTL, 0, CTL_ZERO_BYTES, stream);
    Args a{};
    for (int i = 0; i < N_IN; ++i) a.in[i] = (const float*)d_in[i];
    a.out = (float*)d_out; a.ws = (unsigned char*)d_ws;
    if (MK_N_LAUNCHES == 1) {
        a.ph_lo = 0; a.ph_hi = N_PHASES;
        void* args[] = {&a};
        hipError_t e = hipLaunchCooperativeKernel((const void*)mk_fwd, dim3(grid), dim3(NWAVES * 64), args, LDS_BYTES, stream);
        if (e != hipSuccess) fprintf(stderr, "kernel_launch: cooperative launch failed: %s (grid %d)\n", hipGetErrorString(e), grid);
    } else {
        for (int p = 0; p < N_PHASES; ++p) { a.ph_lo = p; a.ph_hi = p + 1; hipLaunchKernelGGL(mk_fwd, dim3(grid), dim3(NWAVES * 64), LDS_BYTES, stream, a); }
    }
}
```

```cpp
#define MK_N_LAUNCHES 1
#include <hip/hip_runtime.h>
#include <cstdio>
#include <cstdint>
namespace pg8 {
#define PG8_LAS __attribute__((address_space(3)))
typedef unsigned short bf16_t;
typedef short bf16x8 __attribute__((ext_vector_type(8)));
typedef float f32x4 __attribute__((ext_vector_type(4)));
typedef unsigned u32x4 __attribute__((ext_vector_type(4)));
constexpr int BM = 256, BK = 64, HALF = 128, HTB = HALF * BK * 2  , STAGE_BYTES = 8 * HTB, NXCD = 8, WGM = 8;

__host__ __device__ __forceinline__ int lds_byte(int r, int c) { const int st = (r >> 4) * 2 + (c >> 5), rr = r & 15, cc = c & 31, ob = rr * 64 + cc * 2; return st * 1024 + (ob ^ (((ob >> 9) & 1) << 5)); }
__host__ __device__ __forceinline__ void stage_rc(int b, int& R, int& C) { const int st = b / 1024, sb = b % 1024, swz = sb ^ (((sb >> 9) & 1) << 5); R = (st >> 1) * 16 + swz / 64; C = (st & 1) * 32 + (swz % 64) / 2; }
__host__ __device__ __forceinline__ int perm32(int rho) { const int n = rho >> 4, i = rho & 15; return 8 * (i >> 2) + 4 * n + (i & 3); }

struct Unit { int pm, pn; };
struct Gemm { const bf16_t* A; const bf16_t* Bt; int M, N, K; };

struct StaticOrder {
    int nM, nN, nwg, G, c;
    __host__ __device__ void init(int M, int N, int G_, int c_) { nM = M / BM; nN = N / BM; nwg = nM * nN; G = G_; c = c_; }
    __host__ __device__ bool next(int i, Unit& u) const {
        const long L = (long)i * G + c; if (L >= nwg) return false;
        int wgid = (int)L; { const int q = nwg / NXCD, r = nwg % NXCD, xcd = wgid % NXCD, off = wgid / NXCD; wgid = (xcd < r ? xcd * (q + 1) : r * (q + 1) + (xcd - r) * q) + off; }
        const int nig = WGM * nN, gid = wgid / nig, fm = gid * WGM, gsz = (nM - fm) < WGM ? (nM - fm) : WGM;
        u.pm = fm + ((wgid % nig) % gsz); u.pn = (wgid % nig) / gsz; return true;
    }
    __device__ __forceinline__ void a_ready(const Unit&) const {}
    __device__ __forceinline__ void done(const Unit&) const {}
};
__device__ __forceinline__ unsigned cvt_pk_bf16(float lo, float hi) { unsigned r; asm volatile("v_cvt_pk_bf16_f32 %0, %1, %2" : "=v"(r) : "v"(lo), "v"(hi)); return r; }
struct EpiInProj {
    static constexpr bool PERM = true, AFTER_DRAIN = false;
    bf16_t* Z; bf16_t* Zc;
    __device__ __forceinline__ void operator()(const f32x4 (&acc)[2][2][4][2], const Unit& u, int wr, int wc, int fr, int fq) const {
        const bool isctx = u.pm >= 64;
        bf16_t* base = isctx ? Zc : Z; const int ldc = isctx ? 512 : 2560; const int prow = isctx ? u.pm - 64 : u.pm;
        const int row0 = prow * BM + wr * 64 + fr, col0 = u.pn * BM + wc * 32 + 8 * fq;
#pragma unroll
        for (int ai = 0; ai < 2; ++ai)
#pragma unroll
            for (int m = 0; m < 4; ++m) { bf16_t* rowp = base + (size_t)(row0 + ai * HALF + m * 16) * ldc + col0;
#pragma unroll
                for (int bj = 0; bj < 2; ++bj) { const f32x4 v0 = acc[ai][bj][m][0], v1 = acc[ai][bj][m][1];
                    u32x4 w; w.x = cvt_pk_bf16(v0[0], v0[1]); w.y = cvt_pk_bf16(v0[2], v0[3]); w.z = cvt_pk_bf16(v1[0], v1[1]); w.w = cvt_pk_bf16(v1[2], v1[3]);
                    *(u32x4*)(rowp + bj * HALF) = w; } }
    }
};
struct EpiOutProj {
    static constexpr bool PERM = false, AFTER_DRAIN = false;
    const float* x; float* X1; const float* mod;
    __device__ __forceinline__ void operator()(const f32x4 (&acc)[2][2][4][2], const Unit& u, int wr, int wc, int fr, int fq) const {
        const int b = u.pm >> 3;
        const int row0 = u.pm * BM + wr * 64 + fr, col0 = u.pn * BM + wc * 32 + 4 * fq;
        f32x4 gv[2][2];
#pragma unroll
        for (int bj = 0; bj < 2; ++bj)
#pragma unroll
            for (int n = 0; n < 2; ++n) gv[bj][n] = *(const f32x4*)(mod + (size_t)b * 6144 + 2048 + col0 + bj * HALF + n * 16);
#pragma unroll
        for (int ai = 0; ai < 2; ++ai)
#pragma unroll
            for (int m = 0; m < 4; ++m) { const size_t off = (size_t)(row0 + ai * HALF + m * 16) * 1024 + col0;
#pragma unroll
                for (int bj = 0; bj < 2; ++bj)
#pragma unroll
                    for (int n = 0; n < 2; ++n) { const f32x4 xv = *(const f32x4*)(x + off + bj * HALF + n * 16);
                        *(f32x4*)(X1 + off + bj * HALF + n * 16) = xv + gv[bj][n] * acc[ai][bj][m][n]; } }
    }
};
__device__ __forceinline__ float silu_f(float g) { return g * __builtin_amdgcn_rcpf(1.0f + __builtin_amdgcn_exp2f(-1.4426950408889634f * g)); }
struct EpiGateUp {
    static constexpr bool PERM = true, AFTER_DRAIN = false;
    bf16_t* H;
    __device__ __forceinline__ void operator()(const f32x4 (&acc)[2][2][4][2], const Unit& u, int wr, int wc, int fr, int fq) const {
        const int row0 = u.pm * BM + wr * 64 + fr, col0 = (u.pn & 3) * 128 + wc * 32 + 8 * fq;
#pragma unroll
        for (int ai = 0; ai < 2; ++ai)
#pragma unroll
            for (int m = 0; m < 4; ++m) { bf16_t* rowp = H + (size_t)(row0 + ai * HALF + m * 16) * 512 + col0;
                const f32x4 g0 = acc[ai][0][m][0], g1 = acc[ai][0][m][1], u0 = acc[ai][1][m][0], u1 = acc[ai][1][m][1];
                u32x4 w;
                w.x = cvt_pk_bf16(silu_f(g0[0]) * u0[0], silu_f(g0[1]) * u0[1]); w.y = cvt_pk_bf16(silu_f(g0[2]) * u0[2], silu_f(g0[3]) * u0[3]);
                w.z = cvt_pk_bf16(silu_f(g1[0]) * u1[0], silu_f(g1[1]) * u1[1]); w.w = cvt_pk_bf16(silu_f(g1[2]) * u1[2], silu_f(g1[3]) * u1[3]);
                *(u32x4*)rowp = w; }
    }
};
struct EpiDown {
    static constexpr bool PERM = true, AFTER_DRAIN = false;
    bf16_t* YA; const int* slot; const float* gatew; const PG8_LAS int* T;
    __device__ __forceinline__ void operator()(const f32x4 (&acc)[2][2][4][2], const Unit& u, int wr, int wc, int fr, int fq) const {
        const int e = u.pn >> 2, cnt = T[e], pos0 = (u.pm - T[32 + e]) * BM + wr * 64 + fr, col0 = (u.pn & 3) * BM + wc * 32 + 8 * fq;
        int asg[2][4];
#pragma unroll
        for (int ai = 0; ai < 2; ++ai)
#pragma unroll
            for (int m = 0; m < 4; ++m) { const int pos = pos0 + ai * HALF + m * 16; asg[ai][m] = pos < cnt ? slot[e * 16384 + pos] : -1; }
#pragma unroll
        for (int ai = 0; ai < 2; ++ai)
#pragma unroll
            for (int m = 0; m < 4; ++m) { const int as = asg[ai][m];
                if (as >= 0) { const float gw = gatew[as]; bf16_t* rowp = YA + (size_t)as * 1024 + col0;
#pragma unroll
                    for (int bj = 0; bj < 2; ++bj) { const f32x4 v0 = acc[ai][bj][m][0] * gw, v1 = acc[ai][bj][m][1] * gw;
                        u32x4 w; w.x = cvt_pk_bf16(v0[0], v0[1]); w.y = cvt_pk_bf16(v0[2], v0[3]); w.z = cvt_pk_bf16(v1[0], v1[1]); w.w = cvt_pk_bf16(v1[2], v1[3]);
                        *(u32x4*)(rowp + bj * HALF) = w; } } }
    }
};
struct OrderInProj {
    int G, c;
    __device__ __forceinline__ bool next(int i, Unit& u) const {
        const long L = (long)i * G + c; if (L >= 656) return false;
        if (L < 640) { int wgid = (int)L; const int xcd = wgid % NXCD, off = wgid / NXCD; wgid = xcd * 80 + off;
            const int nig = WGM * 10; const int fm = (wgid / nig) * WGM; u.pm = fm + ((wgid % nig) % WGM); u.pn = (wgid % nig) / WGM; }
        else { const int j = (int)L - 640; u.pm = 64 + (j >> 1); u.pn = j & 1; }
        return true;
    }
    __device__ __forceinline__ void a_ready(const Unit&) const {}
    __device__ __forceinline__ void done(const Unit&) const {}
};
struct OrderMoE {
    int G, c, NU; const PG8_LAS int* TE;
    __device__ __forceinline__ bool next(int i, Unit& u) const {
        const long L = (long)i * G + c; if (L >= NU) return false;
        const int q = NU / NXCD, r = NU % NXCD, xcd = (int)(L % NXCD), off = (int)(L / NXCD);
        const int id = (xcd < r ? xcd * (q + 1) : r * (q + 1) + (xcd - r) * q) + off;
        const int tile = id >> 2; u.pm = tile; u.pn = __builtin_amdgcn_readfirstlane(TE[tile]) * 4 + (id & 3); return true;
    }
    __device__ __forceinline__ void a_ready(const Unit&) const {}
    __device__ __forceinline__ void done(const Unit&) const {}
};
template <class Epi, class Sched, bool ALIGN_EPI = false, bool SP2 = false>
__device__ __forceinline__ void gemm_phase(PG8_LAS unsigned char* lds, const Gemm g, const Sched& S, const Epi& E) {
    const int tid = threadIdx.x, wid = __builtin_amdgcn_readfirstlane(tid >> 6), lane = tid & 63, wr = wid >> 2, wc = wid & 3, fr = lane & 15, fq = lane >> 4;
    const int K = g.K, nt = K / BK;
    unsigned voffA[2], voffB[2];
#pragma unroll
    for (int i = 0; i < 2; ++i) { int R, C; stage_rc(tid * 16 + i * 8192, R, C); const int Rb = Epi::PERM ? ((R & ~31) + perm32(R & 31)) : R;
        voffA[i] = (unsigned)(R * K + C) * 2u; voffB[i] = (unsigned)(Rb * K + C) * 2u; }
    const size_t kstep = (size_t)(BK * 2);
    const size_t hstep = (size_t)HALF * K * 2;
    const size_t tstep = 2 * hstep;
    const unsigned ldsw = (unsigned)wid * 1024u;
    const int aoff = lds_byte(wr * 64 + fr, fq * 8), boff = lds_byte(wc * 32 + fr, fq * 8);
#define PG8_SA(b, h) (((b) * 2 + (h)) * HTB)
#define PG8_SB(b, h) ((4 + (b) * 2 + (h)) * HTB)
#define PG8_STAGE(bufoff, gbase, voff) do { _Pragma("unroll") for (int _i = 0; _i < 2; ++_i) \
        __builtin_amdgcn_global_load_lds((const unsigned*)((const char*)(gbase) + (voff)[_i]), (PG8_LAS unsigned*)(lds + (bufoff) + ldsw + _i * 8192), 16, 0, 0); } while (0)
#define PG8_LDA(dst, b, h) do { _Pragma("unroll") for (int m = 0; m < 4; ++m) _Pragma("unroll") for (int k = 0; k < 2; ++k) dst[m][k] = *(const PG8_LAS bf16x8*)(lds + PG8_SA(b, h) + aoff + m * 2048 + k * 1024); } while (0)
#define PG8_LDB(dst, b, h) do { _Pragma("unroll") for (int n = 0; n < 2; ++n) _Pragma("unroll") for (int k = 0; k < 2; ++k) dst[n][k] = *(const PG8_LAS bf16x8*)(lds + PG8_SB(b, h) + boff + n * 2048 + k * 1024); } while (0)
#define PG8_MMA(ai, bj, At, Bt) do { __builtin_amdgcn_s_setprio(1); _Pragma("unroll") for (int m = 0; m < 4; ++m) _Pragma("unroll") for (int n = 0; n < 2; ++n) _Pragma("unroll") for (int k = 0; k < 2; ++k) \
        acc[ai][bj][m][n] = __builtin_amdgcn_mfma_f32_16x16x32_bf16(Bt[n][k], At[m][k], acc[ai][bj][m][n], 0, 0, 0); __builtin_amdgcn_s_setprio(0); } while (0)
#define PG8_WAIT_V(n) asm volatile("s_waitcnt vmcnt(" #n ")" ::: "memory")
#define PG8_WAIT_L(n) asm volatile("s_waitcnt lgkmcnt(" #n ")" ::: "memory")
#define PG8_BAR __builtin_amdgcn_s_barrier()
#define PG8_SCHED __builtin_amdgcn_sched_barrier(0)
    Unit cur, nxt; int ui = 0;
    if (!S.next(0, cur)) return;
    f32x4 acc[2][2][4][2];
#pragma unroll
    for (int a = 0; a < 2; ++a)
#pragma unroll
        for (int b = 0; b < 2; ++b)
#pragma unroll
            for (int m = 0; m < 4; ++m)
#pragma unroll
                for (int n = 0; n < 2; ++n) acc[a][b][m][n] = (f32x4){0.f, 0.f, 0.f, 0.f};
    bf16x8 At[4][2], B0[2][2], B1[2][2];
    const char* cA = (const char*)g.A + (size_t)cur.pm * tstep; const char* cB = (const char*)g.Bt + (size_t)cur.pn * tstep;
    S.a_ready(cur);
    if constexpr (SP2) {
        PG8_STAGE(PG8_SB(0, 0), cB, voffB); PG8_STAGE(PG8_SB(0, 1), cB + hstep, voffB); PG8_STAGE(PG8_SA(0, 0), cA, voffA); PG8_STAGE(PG8_SA(0, 1), cA + hstep, voffA);
        if (wr == 1) PG8_BAR;
        PG8_WAIT_V(2); PG8_BAR;
        PG8_STAGE(PG8_SB(1, 0), cB + kstep, voffB); PG8_STAGE(PG8_SA(1, 0), cA + kstep, voffA); PG8_STAGE(PG8_SB(1, 1), cB + hstep + kstep, voffB);
        PG8_WAIT_V(6); PG8_BAR;
    } else {
        PG8_STAGE(PG8_SB(0, 0), cB, voffB); PG8_STAGE(PG8_SA(0, 0), cA, voffA); PG8_STAGE(PG8_SB(0, 1), cB + hstep, voffB); PG8_STAGE(PG8_SA(0, 1), cA + hstep, voffA);
        if (wr == 1) PG8_BAR;
        PG8_WAIT_V(4); PG8_BAR;
        PG8_STAGE(PG8_SB(1, 0), cB + kstep, voffB); PG8_STAGE(PG8_SA(1, 0), cA + kstep, voffA); PG8_STAGE(PG8_SB(1, 1), cB + hstep + kstep, voffB);
        PG8_WAIT_V(6); PG8_BAR;
    }
    for (;;) {
        const bool has_next = S.next(ui + 1, nxt);
        const char* nA = has_next ? (const char*)g.A + (size_t)nxt.pm * tstep : cA; const char* nB = has_next ? (const char*)g.Bt + (size_t)nxt.pn * tstep : cB;
        for (int t = 0; t < nt; t += 2) {
            const bool last = (t == nt - 2);
            const char* a1 = cA + (size_t)(t + 1) * kstep;
            const char* a2 = last ? nA : cA + (size_t)(t + 2) * kstep; const char* b2 = last ? nB : cB + (size_t)(t + 2) * kstep;
            const char* a3 = a2 + kstep; const char* b3 = b2 + kstep;
            if (last && has_next) S.a_ready(nxt);
            if constexpr (SP2) {
            PG8_LDB(B0, 0, 0); PG8_LDB(B1, 0, 1); PG8_SCHED; PG8_LDA(At, 0, 0); PG8_STAGE(PG8_SA(1, 1), a1 + hstep, voffA);
            PG8_WAIT_V(8); PG8_WAIT_L(0); PG8_BAR; PG8_MMA(0, 0, At, B0); PG8_MMA(0, 1, At, B1); PG8_BAR; PG8_SCHED;
            PG8_LDA(At, 0, 1); PG8_STAGE(PG8_SB(0, 0), b2, voffB); PG8_STAGE(PG8_SB(0, 1), b2 + hstep, voffB); PG8_STAGE(PG8_SA(0, 0), a2, voffA);
            PG8_WAIT_V(8); PG8_WAIT_L(0); PG8_BAR; PG8_MMA(1, 0, At, B0); PG8_MMA(1, 1, At, B1); PG8_BAR; PG8_SCHED;
            PG8_LDB(B0, 1, 0); PG8_LDB(B1, 1, 1); PG8_SCHED; PG8_LDA(At, 1, 0); PG8_STAGE(PG8_SA(0, 1), a2 + hstep, voffA);
            PG8_WAIT_V(8); PG8_WAIT_L(0); PG8_BAR; PG8_MMA(0, 0, At, B0); PG8_MMA(0, 1, At, B1); PG8_BAR; PG8_SCHED;
            PG8_LDA(At, 1, 1); PG8_STAGE(PG8_SB(1, 0), b3, voffB); PG8_STAGE(PG8_SB(1, 1), b3 + hstep, voffB); PG8_STAGE(PG8_SA(1, 0), a3, voffA);
            PG8_WAIT_V(8); PG8_WAIT_L(0); PG8_BAR; PG8_MMA(1, 0, At, B0); PG8_MMA(1, 1, At, B1); PG8_BAR; PG8_SCHED;
            } else {
            PG8_LDB(B0, 0, 0); PG8_SCHED; PG8_LDA(At, 0, 0); PG8_STAGE(PG8_SA(1, 1), a1 + hstep, voffA);
            PG8_WAIT_L(8); PG8_BAR; PG8_WAIT_L(0); PG8_MMA(0, 0, At, B0); PG8_BAR; PG8_SCHED;
            PG8_LDB(B1, 0, 1); PG8_STAGE(PG8_SB(0, 0), b2, voffB);
            PG8_BAR; PG8_WAIT_L(0); PG8_MMA(0, 1, At, B1); PG8_BAR;
            PG8_LDA(At, 0, 1); PG8_STAGE(PG8_SA(0, 0), a2, voffA);
            PG8_BAR; PG8_WAIT_L(0); PG8_MMA(1, 0, At, B0); PG8_BAR; PG8_SCHED;
            PG8_STAGE(PG8_SB(0, 1), b2 + hstep, voffB);
            PG8_WAIT_V(6); PG8_BAR; PG8_MMA(1, 1, At, B1); PG8_BAR;
            PG8_LDB(B0, 1, 0); PG8_SCHED; PG8_LDA(At, 1, 0); PG8_STAGE(PG8_SA(0, 1), a2 + hstep, voffA);
            PG8_WAIT_L(8); PG8_BAR; PG8_WAIT_L(0); PG8_MMA(0, 0, At, B0); PG8_BAR; PG8_SCHED;
            PG8_LDB(B1, 1, 1); PG8_STAGE(PG8_SB(1, 0), b3, voffB);
            PG8_BAR; PG8_WAIT_L(0); PG8_MMA(0, 1, At, B1); PG8_BAR;
            PG8_LDA(At, 1, 1); PG8_STAGE(PG8_SA(1, 0), a3, voffA);
            PG8_BAR; PG8_WAIT_L(0); PG8_MMA(1, 0, At, B0); PG8_BAR; PG8_SCHED;
            PG8_STAGE(PG8_SB(1, 1), b3 + hstep, voffB);
            PG8_WAIT_V(6); PG8_BAR; PG8_MMA(1, 1, At, B1); PG8_BAR;
            }
        }
        if constexpr (ALIGN_EPI) { if (wr == 0) PG8_BAR; }
        if constexpr (!Epi::AFTER_DRAIN) { E(acc, cur, wr, wc, fr, fq); S.done(cur); }
        if (!has_next) break;
#pragma unroll
        for (int a = 0; a < 2; ++a)
#pragma unroll
            for (int b = 0; b < 2; ++b)
#pragma unroll
                for (int m = 0; m < 4; ++m)
#pragma unroll
                    for (int n = 0; n < 2; ++n) acc[a][b][m][n] = (f32x4){0.f, 0.f, 0.f, 0.f};
        cur = nxt; cA = nA; cB = nB; ++ui;
        if constexpr (ALIGN_EPI) { if (wr == 1) PG8_BAR; }
    }
    PG8_WAIT_V(0);
    if constexpr (!ALIGN_EPI) { if (wr == 0) PG8_BAR; }
    PG8_BAR;
    if constexpr (Epi::AFTER_DRAIN) { E.fused(acc, cur, wr, wc, fr, fq, lds, wid, lane); S.done(cur); }
#undef PG8_SA
#undef PG8_SB
#undef PG8_STAGE
#undef PG8_LDA
#undef PG8_LDB
#undef PG8_MMA
#undef PG8_WAIT_V
#undef PG8_WAIT_L
#undef PG8_BAR
#undef PG8_SCHED
}
template <class Epi, class Sched, bool ALIGN_EPI>
__device__ __forceinline__ void gemm_phase_g(PG8_LAS unsigned char* lds, const Gemm g, const Sched& S, const Epi& E, const PG8_LAS int* rowtab) {
    constexpr bool SP2 = true;
    const int tid = threadIdx.x, wid = __builtin_amdgcn_readfirstlane(tid >> 6), lane = tid & 63, wr = wid >> 2, wc = wid & 3, fr = lane & 15, fq = lane >> 4;
    const int K = g.K, nt = K / BK;
    unsigned voffB[2], vc0[2], vc1[2], vn0[2], vn1[2]; int RA[2]; unsigned CA2[2];
#pragma unroll
    for (int i = 0; i < 2; ++i) { int R, C; stage_rc(tid * 16 + i * 8192, R, C); const int Rb = Epi::PERM ? ((R & ~31) + perm32(R & 31)) : R;
        RA[i] = R; CA2[i] = (unsigned)C * 2u; voffB[i] = (unsigned)(Rb * K + C) * 2u; }
    const unsigned rowb = (unsigned)K * 2u;
#define PG8_ROWS(ui_, o0, o1) do { _Pragma("unroll") for (int _i = 0; _i < 2; ++_i) { (o0)[_i] = (unsigned)rowtab[(ui_) * 256 + RA[_i]] * rowb + CA2[_i]; (o1)[_i] = (unsigned)rowtab[(ui_) * 256 + 128 + RA[_i]] * rowb + CA2[_i]; } } while (0)
    const size_t kstep = (size_t)(BK * 2);
    const size_t hstep = (size_t)HALF * K * 2;
    const size_t tstep = 2 * hstep;
    const unsigned ldsw = (unsigned)wid * 1024u;
    const int aoff = lds_byte(wr * 64 + fr, fq * 8), boff = lds_byte(wc * 32 + fr, fq * 8);
#define PG8_SA(b, h) (((b) * 2 + (h)) * HTB)
#define PG8_SB(b, h) ((4 + (b) * 2 + (h)) * HTB)
#define PG8_STAGE(bufoff, gbase, voff) do { _Pragma("unroll") for (int _i = 0; _i < 2; ++_i) \
        __builtin_amdgcn_global_load_lds((const unsigned*)((const char*)(gbase) + (voff)[_i]), (PG8_LAS unsigned*)(lds + (bufoff) + ldsw + _i * 8192), 16, 0, 0); } while (0)
#define PG8_LDA(dst, b, h) do { _Pragma("unroll") for (int m = 0; m < 4; ++m) _Pragma("unroll") for (int k = 0; k < 2; ++k) dst[m][k] = *(const PG8_LAS bf16x8*)(lds + PG8_SA(b, h) + aoff + m * 2048 + k * 1024); } while (0)
#define PG8_LDB(dst, b, h) do { _Pragma("unroll") for (int n = 0; n < 2; ++n) _Pragma("unroll") for (int k = 0; k < 2; ++k) dst[n][k] = *(const PG8_LAS bf16x8*)(lds + PG8_SB(b, h) + boff + n * 2048 + k * 1024); } while (0)
#define PG8_MMA(ai, bj, At, Bt) do { __builtin_amdgcn_s_setprio(1); _Pragma("unroll") for (int m = 0; m < 4; ++m) _Pragma("unroll") for (int n = 0; n < 2; ++n) _Pragma("unroll") for (int k = 0; k < 2; ++k) \
        acc[ai][bj][m][n] = __builtin_amdgcn_mfma_f32_16x16x32_bf16(Bt[n][k], At[m][k], acc[ai][bj][m][n], 0, 0, 0); __builtin_amdgcn_s_setprio(0); } while (0)
#define PG8_WAIT_V(n) asm volatile("s_waitcnt vmcnt(" #n ")" ::: "memory")
#define PG8_WAIT_L(n) asm volatile("s_waitcnt lgkmcnt(" #n ")" ::: "memory")
#define PG8_BAR __builtin_amdgcn_s_barrier()
#define PG8_SCHED __builtin_amdgcn_sched_barrier(0)
    Unit cur, nxt; int ui = 0;
    if (!S.next(0, cur)) return;
    f32x4 acc[2][2][4][2];
#pragma unroll
    for (int a = 0; a < 2; ++a)
#pragma unroll
        for (int b = 0; b < 2; ++b)
#pragma unroll
            for (int m = 0; m < 4; ++m)
#pragma unroll
                for (int n = 0; n < 2; ++n) acc[a][b][m][n] = (f32x4){0.f, 0.f, 0.f, 0.f};
    bf16x8 At[4][2], B0[2][2], B1[2][2];
    const char* const cA = (const char*)g.A; PG8_ROWS(0, vc0, vc1); const char* cB = (const char*)g.Bt + (size_t)cur.pn * tstep;
    S.a_ready(cur);
    if constexpr (SP2) {
        PG8_STAGE(PG8_SB(0, 0), cB, voffB); PG8_STAGE(PG8_SB(0, 1), cB + hstep, voffB); PG8_STAGE(PG8_SA(0, 0), cA, vc0); PG8_STAGE(PG8_SA(0, 1), cA, vc1);
        if (wr == 1) PG8_BAR;
        PG8_WAIT_V(2); PG8_BAR;
        PG8_STAGE(PG8_SB(1, 0), cB + kstep, voffB); PG8_STAGE(PG8_SA(1, 0), cA + kstep, vc0); PG8_STAGE(PG8_SB(1, 1), cB + hstep + kstep, voffB);
        PG8_WAIT_V(6); PG8_BAR;
    }
    for (;;) {
        const bool has_next = S.next(ui + 1, nxt);
        const char* nB = has_next ? (const char*)g.Bt + (size_t)nxt.pn * tstep : cB;
        if (has_next) PG8_ROWS(ui + 1, vn0, vn1); else { vn0[0] = vc0[0]; vn0[1] = vc0[1]; vn1[0] = vc1[0]; vn1[1] = vc1[1]; }
        for (int t = 0; t < nt; t += 2) {
            const bool last = (t == nt - 2);
            const char* a1 = cA + (size_t)(t + 1) * kstep;
            const char* a2 = last ? cA : cA + (size_t)(t + 2) * kstep; const char* b2 = last ? nB : cB + (size_t)(t + 2) * kstep;
            const unsigned s0_[2] = {last ? vn0[0] : vc0[0], last ? vn0[1] : vc0[1]}, s1_[2] = {last ? vn1[0] : vc1[0], last ? vn1[1] : vc1[1]};
            const char* a3 = a2 + kstep; const char* b3 = b2 + kstep;
            if (last && has_next) S.a_ready(nxt);
            if constexpr (SP2) {
            PG8_LDB(B0, 0, 0); PG8_LDB(B1, 0, 1); PG8_SCHED; PG8_LDA(At, 0, 0); PG8_STAGE(PG8_SA(1, 1), a1, vc1);
            PG8_WAIT_V(8); PG8_WAIT_L(0); PG8_BAR; PG8_MMA(0, 0, At, B0); PG8_MMA(0, 1, At, B1); PG8_BAR; PG8_SCHED;
            PG8_LDA(At, 0, 1); PG8_STAGE(PG8_SB(0, 0), b2, voffB); PG8_STAGE(PG8_SB(0, 1), b2 + hstep, voffB); PG8_STAGE(PG8_SA(0, 0), a2, s0_);
            PG8_WAIT_V(8); PG8_WAIT_L(0); PG8_BAR; PG8_MMA(1, 0, At, B0); PG8_MMA(1, 1, At, B1); PG8_BAR; PG8_SCHED;
            PG8_LDB(B0, 1, 0); PG8_LDB(B1, 1, 1); PG8_SCHED; PG8_LDA(At, 1, 0); PG8_STAGE(PG8_SA(0, 1), a2, s1_);
            PG8_WAIT_V(8); PG8_WAIT_L(0); PG8_BAR; PG8_MMA(0, 0, At, B0); PG8_MMA(0, 1, At, B1); PG8_BAR; PG8_SCHED;
            PG8_LDA(At, 1, 1); PG8_STAGE(PG8_SB(1, 0), b3, voffB); PG8_STAGE(PG8_SB(1, 1), b3 + hstep, voffB); PG8_STAGE(PG8_SA(1, 0), a3, s0_);
            PG8_WAIT_V(8); PG8_WAIT_L(0); PG8_BAR; PG8_MMA(1, 0, At, B0); PG8_MMA(1, 1, At, B1); PG8_BAR; PG8_SCHED;
            }
        }
        if constexpr (ALIGN_EPI) { if (wr == 0) PG8_BAR; }
        if constexpr (!Epi::AFTER_DRAIN) { E(acc, cur, wr, wc, fr, fq); S.done(cur); }
        if (!has_next) break;
#pragma unroll
        for (int a = 0; a < 2; ++a)
#pragma unroll
            for (int b = 0; b < 2; ++b)
#pragma unroll
                for (int m = 0; m < 4; ++m)
#pragma unroll
                    for (int n = 0; n < 2; ++n) acc[a][b][m][n] = (f32x4){0.f, 0.f, 0.f, 0.f};
        cur = nxt; cB = nB; ++ui; vc0[0] = vn0[0]; vc0[1] = vn0[1]; vc1[0] = vn1[0]; vc1[1] = vn1[1];
        if constexpr (ALIGN_EPI) { if (wr == 1) PG8_BAR; }
    }
    PG8_WAIT_V(0);
    if constexpr (!ALIGN_EPI) { if (wr == 0) PG8_BAR; }
    PG8_BAR;
    if constexpr (Epi::AFTER_DRAIN) { E.fused(acc, cur, wr, wc, fr, fq, lds, wid, lane); S.done(cur); }
#undef PG8_ROWS
#undef PG8_SA
#undef PG8_SB
#undef PG8_STAGE
#undef PG8_LDA
#undef PG8_LDB
#undef PG8_MMA
#undef PG8_WAIT_V
#undef PG8_WAIT_L
#undef PG8_BAR
#undef PG8_SCHED
}
}

#ifndef MK_N_LAUNCHES
#define MK_N_LAUNCHES 1
#endif
constexpr int N_PHASES = 11;
constexpr int NWAVES = 8;
#define GAS __attribute__((address_space(1)))
#define LAS __attribute__((address_space(3)))
typedef unsigned short bf16;
typedef unsigned v4u __attribute__((ext_vector_type(4)));
typedef unsigned v2u __attribute__((ext_vector_type(2)));
typedef float f32x4 __attribute__((ext_vector_type(4)));
typedef float f32x16 __attribute__((ext_vector_type(16)));
typedef short bf16x8 __attribute__((ext_vector_type(8)));
#define LDS_WAIT() asm volatile("s_waitcnt lgkmcnt(0)" ::: "memory")
#define RLX_AGENT __ATOMIC_RELAXED, __HIP_MEMORY_SCOPE_AGENT

constexpr int NB = 8, SEQ = 2048, DM = 1024, CTXL = 256, NTOK = NB * SEQ, NCTX = NB * CTXL, DIN = 2560, NEXP = 32;
constexpr float NORM_EPS = 1e-6f;
enum { I_X = 0, I_C, I_CTX, I_CCTX, I_ADAW, I_ADAB, I_N1G, I_N2G, I_WIN, I_RCW, I_RCB, I_RGWA, I_RGBA, I_RGWX, I_RGBX, I_RGLAM, I_SCW, I_WOUT, I_RGRW, I_RGRB, I_REW, I_REB, I_EWG, I_EWU, I_EWD, I_FNG, N_IN };

constexpr size_t MiB = 1u << 20;
constexpr size_t WS_CTL = 0, CTL_ZERO_BYTES = 1 * MiB;
constexpr size_t WS_MODP = 1 * MiB;
constexpr size_t WS_MOD = 5 * MiB;
constexpr size_t WS_WRT = 5 * MiB + 512 * 1024;
constexpr size_t WS_WRG = 5 * MiB + 768 * 1024;
constexpr size_t WS_WIN = 6 * MiB;
constexpr size_t WS_WOUT = 11 * MiB;
constexpr size_t WS_WGU = 13 * MiB;
constexpr size_t WS_WD = 77 * MiB;
constexpr size_t WS_AGG = 109 * MiB;
constexpr size_t WS_SLOT = 112 * MiB;
constexpr size_t WS_GATEW = 114 * MiB;
constexpr size_t WS_SMAP = 114 * MiB + 256 * 1024;
constexpr size_t WS_RA = 115 * MiB;
constexpr size_t WS_ZC = WS_RA + 80 * MiB;
constexpr size_t WS_RB = 197 * MiB;
constexpr size_t WS_END = 237 * MiB;
constexpr size_t WS_YA = WS_WGU;
constexpr int CW_BAR = 4096;
constexpr int CW_CNT = 16384;
constexpr int RING_BYTES = 131072, LDSCTL_OFF = 133120, TBL_OFF = LDSCTL_OFF + 512, LDS_BYTES = 147456;

__device__ __forceinline__ float bflo(unsigned w) { return __uint_as_float(w << 16); }
__device__ __forceinline__ float bfhi(unsigned w) { return __uint_as_float(w & 0xffff0000u); }
__device__ __forceinline__ unsigned pk2(float lo, float hi) { return pg8::cvt_pk_bf16(lo, hi); }
__device__ __forceinline__ float wave_sum(float v) {
#pragma unroll
    for (int o = 1; o < 64; o <<= 1) v += __shfl_xor(v, o);
    return v;
}

#define XB_TMO      128
#define XB_XCNT(j)  (256  + 64 * (j))
#define XB_XSUB(j)  (1280 + 64 * (j))
#define XB_XGEN(j)  (2304 + 64 * (j))
#define XB_TOP      3328
#define XB_TOPGEN   3392
#define XCD_BAR_WORDS 3456
#define XB_SPIN_CAP (1u << 18)
__device__ __forceinline__ unsigned xb_ld(unsigned* p)              { return __hip_atomic_load(p, __ATOMIC_RELAXED, __HIP_MEMORY_SCOPE_AGENT); }
__device__ __forceinline__ unsigned xb_add(unsigned* p, unsigned v) { return __hip_atomic_fetch_add(p, v, __ATOMIC_RELAXED, __HIP_MEMORY_SCOPE_AGENT); }
__device__ __forceinline__ unsigned xb_xcc_id() { return (unsigned)__builtin_amdgcn_s_getreg((3 << 11) | 20) & 0xFu; }
#define XB_SPIN(cond, bar) do { unsigned _sp = 0; while (cond) { __builtin_amdgcn_s_sleep(1); \
    if ((++_sp & 255u) == 0u) { if (xb_ld(&(bar)[XB_TMO])) break; if (_sp > XB_SPIN_CAP) { atomicAdd(&(bar)[XB_TMO], 1u); break; } } } } while (0)
struct XcdBarrier { unsigned* bar; unsigned x; volatile LAS unsigned* st; };
__device__ __forceinline__ XcdBarrier xcd_barrier_post(unsigned* bar, volatile LAS unsigned* st) {
    XcdBarrier b; b.bar = bar; b.x = xb_xcc_id(); b.st = st;
    if (threadIdx.x == 0) (void)xb_add(&bar[XB_XCNT(b.x)], 1u);
    return b;
}
__device__ __forceinline__ void xcd_barrier_complete(unsigned* bar, unsigned x, unsigned& nloc, unsigned& nx) {
    const unsigned G = gridDim.x * gridDim.y * gridDim.z;
    unsigned sum, cnt, mine, sp = 0u;
    for (;;) {
        sum = 0u; cnt = 0u; mine = 0u;
#pragma unroll
        for (unsigned j = 0; j < 16; ++j) { const unsigned c = xb_ld(&bar[XB_XCNT(j)]); sum += c; cnt += (c > 0u) ? 1u : 0u; mine = (j == x) ? c : mine; }
        if (sum == G) break;
        __builtin_amdgcn_s_sleep(1);
        if ((++sp & 255u) == 0u) { if (xb_ld(&bar[XB_TMO])) break; if (sp > XB_SPIN_CAP) { atomicAdd(&bar[XB_TMO], 1u); break; } }
    }
    nloc = mine > 0u ? mine : 1u; nx = cnt > 0u ? cnt : 1u;
}
__device__ __forceinline__ void xcd_barrier(const XcdBarrier& b) {
    asm volatile("s_waitcnt vmcnt(0)" ::: "memory");
    __syncthreads();
    if (threadIdx.x == 0) {
        unsigned* bar = b.bar;
        __builtin_amdgcn_s_waitcnt(0);
        unsigned nloc = b.st[0], nx = b.st[1];
        if (nloc == 0u) { xcd_barrier_complete(bar, b.x, nloc, nx); b.st[0] = nloc; b.st[1] = nx; }
        const unsigned old = xb_add(&bar[XB_XSUB(b.x)], 1u);
        const unsigned gen = old / nloc;
        if (old + 1u == (gen + 1u) * nloc) {
            __builtin_amdgcn_fence(__ATOMIC_RELEASE, "agent");
            asm volatile("s_waitcnt vmcnt(0)" ::: "memory");
            const unsigned og = xb_add(&bar[XB_TOP], 1u);
            const unsigned tg = og / nx;
            if (og + 1u == (tg + 1u) * nx) xb_add(&bar[XB_TOPGEN], 1u);
            else XB_SPIN(xb_ld(&bar[XB_TOPGEN]) == tg, bar);
            __builtin_amdgcn_fence(__ATOMIC_ACQUIRE, "agent");
            xb_add(&bar[XB_XGEN(b.x)], 1u);
            asm volatile("s_waitcnt vmcnt(0)" ::: "memory");
        } else {
            XB_SPIN(xb_ld(&bar[XB_XGEN(b.x)]) == gen, bar);
            __builtin_amdgcn_fence(__ATOMIC_ACQUIRE, "agent");
            asm volatile("s_waitcnt vmcnt(0)" ::: "memory");
        }
    }
    __syncthreads();
}

struct Args { const float* in[N_IN]; float* out; unsigned char* ws; int ph_lo, ph_hi; };
struct Frame { LAS unsigned char* lds; int tid, lane, wave, G, bid; };

struct TrItem { const float* src; bf16* dst; int N, KP; };
__device__ __forceinline__ void tr_load(const TrItem& t, f32x4 (&v)[16]) {
#pragma unroll
    for (int i = 0; i < 16; ++i) v[i] = __builtin_nontemporal_load((const f32x4*)(t.src + (size_t)(4 * i) * t.N));
}
__device__ __forceinline__ void tr_finish(const TrItem& t, const f32x4 (&v)[16], LAS float* scr, int lane) {
    const int kq = lane >> 4, nb = 4 * (lane & 15);
#pragma unroll
    for (int i = 0; i < 16; ++i) { const int kk = 4 * i + kq;
        scr[(nb + 0) * 65 + kk] = v[i].x; scr[(nb + 1) * 65 + kk] = v[i].y; scr[(nb + 2) * 65 + kk] = v[i].z; scr[(nb + 3) * 65 + kk] = v[i].w; }
    LDS_WAIT(); asm volatile("" ::: "memory");
    const int c = lane & 7;
#pragma unroll
    for (int j = 0; j < 8; ++j) { const int n = (lane >> 3) + 8 * j; const LAS float* sp = scr + n * 65 + 8 * c;
        v4u o; o.x = pk2(sp[0], sp[1]); o.y = pk2(sp[2], sp[3]); o.z = pk2(sp[4], sp[5]); o.w = pk2(sp[6], sp[7]);
        *(v4u*)(t.dst + (size_t)(8 * j) * t.KP) = o; }
    LDS_WAIT(); asm volatile("" ::: "memory");
}
__device__ __forceinline__ void gemv_item(const Args& a, int item, LAS float* scr, int lane) {
    const int ks = item / 24, nb = item % 24, k0 = ks * 64, n0 = nb * 256 + 4 * lane;
    const float* cc = a.in[I_C]; const float* cx = a.in[I_CCTX]; const float* W = a.in[I_ADAW];
#pragma unroll
    for (int r = 0; r < 9; ++r) { const float v = r < 8 ? cc[r * 1024 + k0 + lane] : cx[k0 + lane]; scr[r * 64 + lane] = v / (1.0f + __expf(-v)); }
    LDS_WAIT(); asm volatile("" ::: "memory");
    f32x4 acc[9];
#pragma unroll
    for (int r = 0; r < 9; ++r) acc[r] = (f32x4){0.f, 0.f, 0.f, 0.f};
#pragma unroll 16
    for (int kk = 0; kk < 64; ++kk) { const f32x4 w = *(const f32x4*)(W + (size_t)(k0 + kk) * 6144 + n0);
#pragma unroll
        for (int r = 0; r < 9; ++r) acc[r] += scr[r * 64 + kk] * w; }
    float* MODP = (float*)(a.ws + WS_MODP);
#pragma unroll
    for (int r = 0; r < 9; ++r) *(f32x4*)(MODP + ((size_t)ks * 9 + r) * 6144 + n0) = acc[r];
    LDS_WAIT(); asm volatile("" ::: "memory");
}
constexpr int IT_GEMV = 384, IT_WRT = 72;
constexpr int TT_WIN = 16 * 40, TT_WOUT = 16 * 16, TT_RG = 32, TT_GU = 8192, TT_DOWN = 4096, TT_TOTAL = TT_WIN + TT_WOUT + TT_RG + TT_GU + TT_DOWN;
__device__ __forceinline__ TrItem tr_decode(const Args& a, int r, int lane) {
    const float* W; bf16* WT; int N, KP, drow0, k0, n0;
    if (r < TT_WIN) { const int kb = r / 40, nb = r % 40; W = a.in[I_WIN]; WT = (bf16*)(a.ws + WS_WIN); N = 2560; KP = 1024; drow0 = 64 * nb; k0 = 64 * kb; n0 = 64 * nb; }
    else if (r < TT_WIN + TT_WOUT) { const int q = r - TT_WIN, kb = q >> 4, nb = q & 15; W = a.in[I_WOUT]; WT = (bf16*)(a.ws + WS_WOUT); N = 1024; KP = 1024; drow0 = 64 * nb; k0 = 64 * kb; n0 = 64 * nb; }
    else if (r < TT_WIN + TT_WOUT + TT_RG) { const int mat = r - TT_WIN - TT_WOUT, g = mat >> 4, d = (mat >> 3) & 1, h = mat & 7;
        W = (g ? a.in[I_RGWX] : a.in[I_RGWA]) + (size_t)(d * 8 + h) * 4096; WT = (bf16*)(a.ws + WS_WRG); N = 64; KP = 64; drow0 = h * 256 + d * 128 + g * 64; k0 = 0; n0 = 0; }
    else if (r < TT_WIN + TT_WOUT + TT_RG + TT_GU) { int q = r - TT_WIN - TT_WOUT - TT_RG; const int up = q >> 12; q &= 4095; const int e = q >> 7, it2 = q & 127, kb = it2 >> 3, nb = it2 & 7;
        n0 = 64 * nb; k0 = 64 * kb; W = (up ? a.in[I_EWU] : a.in[I_EWG]) + (size_t)e * 524288; WT = (bf16*)(a.ws + WS_WGU); N = 512; KP = 1024; drow0 = e * 1024 + (n0 >> 7) * 256 + up * 128 + (n0 & 127); }
    else { const int q = r - TT_WIN - TT_WOUT - TT_RG - TT_GU, e = q >> 7, it2 = q & 127, kb = it2 >> 4, nb = it2 & 15;
        n0 = 64 * nb; k0 = 64 * kb; W = a.in[I_EWD] + (size_t)e * 524288; WT = (bf16*)(a.ws + WS_WD); N = 1024; KP = 512; drow0 = e * 1024 + n0; }
    TrItem t; t.N = N; t.KP = KP;
    t.src = W + (size_t)(k0 + (lane >> 4)) * N + n0 + 4 * (lane & 15);
    t.dst = WT + (size_t)(drow0 + (lane >> 3)) * KP + k0 + 8 * (lane & 7);
    return t;
}
__device__ __forceinline__ void p0_prep(const Args& a, Frame& F) {
    LAS float* scr = (LAS float*)(F.lds + F.wave * 16640);
    const int gw = F.wave * F.G + F.bid, NGW = F.G * NWAVES, lane = F.lane;
    float* WrT = (float*)(a.ws + WS_WRT);
    for (int it = gw; it < IT_GEMV + IT_WRT; it += NGW) {
        if (it < IT_GEMV) { gemv_item(a, it, scr, lane); continue; }
        const int r = it - IT_GEMV; const float* rgw = a.in[I_RGRW]; const float* rew = a.in[I_REW];
#pragma unroll
        for (int i = 0; i < 8; ++i) { const int idx = r * 512 + lane + 64 * i, j = idx >> 10, k = idx & 1023; WrT[idx] = j < 4 ? rgw[k * 4 + j] : rew[k * 32 + (j - 4)]; }
    }
    f32x4 vA[16], vB[16]; TrItem tA, tB;
    int it = gw;
    if (it < TT_TOTAL) { tA = tr_decode(a, TT_TOTAL - 1 - it, lane); tr_load(tA, vA); }
    while (it < TT_TOTAL) {
        int it2 = it + NGW;
        if (it2 < TT_TOTAL) { tB = tr_decode(a, TT_TOTAL - 1 - it2, lane); tr_load(tB, vB); }
        tr_finish(tA, vA, scr, lane);
        it = it2; if (it >= TT_TOTAL) break;
        it2 = it + NGW;
        if (it2 < TT_TOTAL) { tA = tr_decode(a, TT_TOTAL - 1 - it2, lane); tr_load(tA, vA); }
        tr_finish(tB, vB, scr, lane);
        it = it2;
    }
}

__device__ __forceinline__ void norm_row_mod(const float* src, bf16* dst, const LAS float* GS, const LAS float* SH, int lane) {
    const f32x4* xr = (const f32x4*)src + lane; f32x4 v[4]; float ss = 0.f;
#pragma unroll
    for (int j = 0; j < 4; ++j) { v[j] = xr[64 * j]; ss += (v[j].x * v[j].x + v[j].y * v[j].y) + (v[j].z * v[j].z + v[j].w * v[j].w); }
    const float rstd = 1.0f / sqrtf(wave_sum(ss) * (1.0f / 1024.0f) + NORM_EPS);
#pragma unroll
    for (int j = 0; j < 4; ++j) { const f32x4 g = *(const LAS f32x4*)(GS + 4 * lane + 256 * j), s = *(const LAS f32x4*)(SH + 4 * lane + 256 * j);
        const f32x4 y = (v[j] * rstd) * g + s; v2u o; o.x = pk2(y.x, y.y); o.y = pk2(y.z, y.w);
        *(v2u*)(dst + 4 * lane + 256 * j) = o; }
}
__device__ __forceinline__ void p1_norm(const Args& a, Frame& F) {
    const float* MODP = (const float*)(a.ws + WS_MODP); float* MOD = (float*)(a.ws + WS_MOD); bf16* XN = (bf16*)(a.ws + WS_RB);
    const float* adab = a.in[I_ADAB]; const float* n1g = a.in[I_N1G];
    LAS float* GS = (LAS float*)F.lds; LAS float* SH = GS + 1024; LAS float* GSC = GS + 2048; LAS float* SHC = GS + 3072;
    for (int blk = F.bid; blk < 256; blk += F.G) {
        const int b = blk >> 5;
        for (int k = F.tid; k < 1024; k += NWAVES * 64) {
            float s_sh = adab[k], s_sc = adab[1024 + k], c_sh = s_sh, c_sc = s_sc;
#pragma unroll 4
            for (int ks = 0; ks < 16; ++ks) { const float* base = MODP + (size_t)ks * 9 * 6144;
                s_sh += base[b * 6144 + k]; s_sc += base[b * 6144 + 1024 + k]; c_sh += base[8 * 6144 + k]; c_sc += base[8 * 6144 + 1024 + k]; }
            const float g = n1g[k]; GS[k] = g * (1.0f + s_sc); SH[k] = s_sh; GSC[k] = g * (1.0f + c_sc); SHC[k] = c_sh;
        }
        if (F.tid < 216) { const int r = F.tid / 24, n = blk * 24 + F.tid % 24; float s = adab[n];
#pragma unroll 4
            for (int ks = 0; ks < 16; ++ks) s += MODP[((size_t)ks * 9 + r) * 6144 + n];
            MOD[r * 6144 + n] = s; }
        __syncthreads();
#pragma unroll 1
        for (int j = 0; j < 9; ++j) { const bool isctx = j == 8;
            const int row = isctx ? NTOK + blk * 8 + F.wave : blk * 64 + F.wave * 8 + j;
            const float* src = isctx ? a.in[I_CTX] + (size_t)(blk * 8 + F.wave) * 1024 : a.in[I_X] + (size_t)row * 1024;
            norm_row_mod(src, XN + (size_t)row * 1024, isctx ? GSC : GS, isctx ? SHC : SH, F.lane); }
        __syncthreads();
    }
}

__device__ __forceinline__ void ld8(const bf16* p, float (&f)[8]) { const v4u w = *(const v4u*)p;
    f[0] = bflo(w.x); f[1] = bfhi(w.x); f[2] = bflo(w.y); f[3] = bfhi(w.y); f[4] = bflo(w.z); f[5] = bfhi(w.z); f[6] = bflo(w.w); f[7] = bfhi(w.w); }
__device__ __forceinline__ v4u pack8(const float (&f)[8]) { v4u w; w.x = pk2(f[0], f[1]); w.y = pk2(f[2], f[3]); w.z = pk2(f[4], f[5]); w.w = pk2(f[6], f[7]); return w; }

__device__ __forceinline__ void yconv_item(const Args& a, Frame& F, int b, int r) {
    const bf16* Z = (const bf16*)(a.ws + WS_RA); bf16* Y = (bf16*)(a.ws + WS_RB); const float* scw = a.in[I_SCW];
    const int cg = F.tid & 63, c0 = cg * 8; const bool vert = cg >= 32; const int stride = vert ? 64 : 1;
    float wk[3][8];
#pragma unroll
    for (int k = 0; k < 3; ++k)
#pragma unroll
        for (int i = 0; i < 8; ++i) wk[k][i] = scw[k * 512 + c0 + i];
#pragma unroll 2
    for (int j = 0; j < 8; ++j) { const int w = (F.tid >> 6) + 8 * j, t = r * 64 + w;
        float acc[8];
#pragma unroll
        for (int i = 0; i < 8; ++i) acc[i] = 0.f;
#pragma unroll
        for (int k = 0; k < 3; ++k) { const int p = (vert ? r : w) + k - 1; const bool valid = p >= 0 && p < (vert ? 32 : 64);
            const int tn = valid ? t + (k - 1) * stride : t; const bf16* zr = Z + (size_t)(b * SEQ + tn) * DIN;
            float cv[8], vv[8]; ld8(zr + 2048 + c0, cv); ld8(zr + 1024 + c0, vv);
            const float m = valid ? 1.0f : 0.0f;
#pragma unroll
            for (int i = 0; i < 8; ++i) acc[i] += (wk[k][i] * m) * (cv[i] * vv[i]); }
        float bg[8]; ld8(Z + (size_t)(b * SEQ + t) * DIN + 1536 + c0, bg);
#pragma unroll
        for (int i = 0; i < 8; ++i) acc[i] *= bg[i];
        *(v4u*)(Y + (size_t)(b * SEQ + t) * 1024 + 512 + c0) = pack8(acc); }
}

constexpr int SC_XC = 0, SC_AB = 9216, SC_BB = 9216 + 32768, SC_SEG = 9216 + 65536, SC_HALL = SC_SEG + 4096;
template <bool PASS2>
__device__ __forceinline__ void scan_range(const Args& a, Frame& F, int b, int h, int vc0, int nvc) {
    const int tid = F.tid, lane = F.lane, wave = F.wave;
    LAS bf16* XC = (LAS bf16*)(F.lds + SC_XC);
    LAS float* AB = (LAS float*)(F.lds + SC_AB);
    LAS float* BB = (LAS float*)(F.lds + SC_BB);
    LAS float* SEG = (LAS float*)(F.lds + SC_SEG);
    LAS float* HALL = (LAS float*)(F.lds + SC_HALL);
    const bf16* Z = (const bf16*)(a.ws + WS_RA); const bf16* Zc = (const bf16*)(a.ws + WS_ZC);
    const bf16* WrgT = (const bf16*)(a.ws + WS_WRG); float* AGG = (float*)(a.ws + WS_AGG); bf16* Y = (bf16*)(a.ws + WS_RB);
    const int d = wave >> 2, chh = (wave >> 1) & 1, shf = wave & 1, r = lane & 31, hh = lane >> 5;
    bf16x8 br[4], bi[4];
    { const bf16* wr_ = WrgT + (size_t)(h * 256 + d * 128 + chh * 32 + r) * 64 + hh * 8;
#pragma unroll
      for (int ks = 0; ks < 4; ++ks) { br[ks] = *(const bf16x8*)(wr_ + ks * 16); bi[ks] = *(const bf16x8*)(wr_ + 64 * 64 + ks * 16); } }
    const int ch = chh * 32 + r, gch = d * 512 + h * 64 + ch;
    const float ba = a.in[I_RGBA][gch] * -1.4426950408889634f, bx = a.in[I_RGBX][gch] * -1.4426950408889634f;
    const float Kc = -8.0f * 1.4426950408889634f * log1pf(expf(-a.in[I_RGLAM][gch]));
    const int cs = tid >> 3, ig = tid & 7, col = h * 64 + ig * 8;
    float cwv[4][8], cbv[8];
#pragma unroll
    for (int i = 0; i < 8; ++i) { cbv[i] = a.in[I_RCB][col + i];
#pragma unroll
        for (int k = 0; k < 4; ++k) cwv[k][i] = a.in[I_RCW][k * 512 + col + i]; }
    const int d2 = tid >> 8, seg = (tid >> 6) & 3, c = tid & 63;
    if (PASS2 && tid < 128) {
        const int dd = tid >> 6, cc = tid & 63; const float* ag = AGG + ((size_t)b * 36 * 2 + dd) * 1024 + (h * 64 + cc) * 2;
        float pv[36], sv[36];
#pragma unroll
        for (int k = 0; k < 36; ++k) { pv[k] = ag[(size_t)k * 2048]; sv[k] = ag[(size_t)k * 2048 + 1]; }
        float hc = 0.0f;
        if (dd == 0) {
#pragma unroll
            for (int k = 0; k < 36; ++k) { const int t = k - vc0; if (t >= 0 && t < nvc) HALL[(t * 2 + 0) * 64 + cc] = hc; hc = pv[k] * hc + sv[k]; }
        } else {
#pragma unroll
            for (int k = 3; k >= 0; --k) hc = pv[k] * hc + sv[k];
#pragma unroll
            for (int k = 35; k >= 4; --k) { const int t = k - vc0; if (t >= 0 && t < nvc) HALL[(t * 2 + 1) * 64 + cc] = hc; hc = pv[k] * hc + sv[k]; }
        }
    }
    v4u xq[4]; v4u gq = (v4u){0u, 0u, 0u, 0u}, gqn = gq;
    { const int vc = vc0; const bool isctx = vc < 4; const int s0 = isctx ? vc * 64 : (vc - 4) * 64, Ls = isctx ? CTXL : SEQ, pitch = isctx ? 512 : DIN;
      const bf16* src = isctx ? Zc + (size_t)b * CTXL * 512 : Z + (size_t)b * SEQ * DIN;
#pragma unroll
      for (int k = 0; k < 4; ++k) { const int sp = s0 + cs + k - 2; const int spc = (sp >= 0 && sp < Ls) ? sp : s0 + cs; xq[k] = *(const v4u*)(src + (size_t)spc * pitch + col); }
      if (PASS2) gq = *(const v4u*)(Z + ((size_t)b * SEQ + s0 + cs) * DIN + 512 + col); }
#pragma unroll 1
    for (int t = 0; t < nvc; ++t) {
        const int vc = vc0 + t; const bool isctx = vc < 4; const int s0 = isctx ? vc * 64 : (vc - 4) * 64, Ls = isctx ? CTXL : SEQ;
        { float acc[8];
#pragma unroll
          for (int i = 0; i < 8; ++i) acc[i] = cbv[i];
#pragma unroll
          for (int k = 0; k < 4; ++k) { const int sp = s0 + cs + k - 2; const float m = (sp >= 0 && sp < Ls) ? 1.0f : 0.0f;
              const v4u w = xq[k]; const float xv[8] = {bflo(w.x), bfhi(w.x), bflo(w.y), bfhi(w.y), bflo(w.z), bfhi(w.z), bflo(w.w), bfhi(w.w)};
#pragma unroll
              for (int i = 0; i < 8; ++i) acc[i] += (cwv[k][i] * m) * xv[i]; }
          *(LAS v4u*)(XC + cs * 72 + ig * 8) = pack8(acc); }
        if (t + 1 < nvc) { const int vn = vc + 1; const bool cx = vn < 4; const int s0n = cx ? vn * 64 : (vn - 4) * 64, Lsn = cx ? CTXL : SEQ, pitch = cx ? 512 : DIN;
            const bf16* src = cx ? Zc + (size_t)b * CTXL * 512 : Z + (size_t)b * SEQ * DIN;
#pragma unroll
            for (int k = 0; k < 4; ++k) { const int sp = s0n + cs + k - 2; const int spc = (sp >= 0 && sp < Lsn) ? sp : s0n + cs; xq[k] = *(const v4u*)(src + (size_t)spc * pitch + col); }
            if (PASS2) gqn = *(const v4u*)(Z + ((size_t)b * SEQ + s0n + cs) * DIN + 512 + col); }
        __syncthreads();
        { f32x16 accr, acci;
#pragma unroll
          for (int i = 0; i < 16; ++i) { accr[i] = 0.f; acci[i] = 0.f; }
#pragma unroll
          for (int ks = 0; ks < 4; ++ks) {
              const bf16x8 af = *(const LAS bf16x8*)(XC + (shf * 32 + r) * 72 + ks * 16 + hh * 8);
              accr = __builtin_amdgcn_mfma_f32_32x32x16_bf16(af, br[ks], accr, 0, 0, 0);
              acci = __builtin_amdgcn_mfma_f32_32x32x16_bf16(af, bi[ks], acci, 0, 0, 0); }
#pragma unroll
          for (int reg = 0; reg < 16; ++reg) { const int s = shf * 32 + (reg & 3) + 8 * (reg >> 2) + 4 * hh;
              const float rr = __builtin_amdgcn_rcpf(1.0f + __builtin_amdgcn_exp2f(fmaf(accr[reg], -1.4426950408889634f, ba)));
              const float ii = __builtin_amdgcn_rcpf(1.0f + __builtin_amdgcn_exp2f(fmaf(acci[reg], -1.4426950408889634f, bx)));
              const float av = __builtin_amdgcn_exp2f(Kc * rr);
              const float xcv = __uint_as_float((unsigned)XC[s * 72 + ch] << 16);
              const float bv = __builtin_amdgcn_sqrtf(fmaxf(fmaf(-av, av, 1.0f), 0.0f)) * (ii * xcv);
              AB[(d * 64 + s) * 64 + ch] = av; BB[(d * 64 + s) * 64 + ch] = bv; } }
        __syncthreads();
        float av16[16], bv16[16];
        { float P = 1.0f, Sv = 0.0f;
#pragma unroll
          for (int j = 0; j < 16; ++j) { const int vs = seg * 16 + j, s = d2 ? 63 - vs : vs; av16[j] = AB[(d2 * 64 + s) * 64 + c]; bv16[j] = BB[(d2 * 64 + s) * 64 + c]; }
#pragma unroll
          for (int j = 0; j < 16; ++j) { Sv = av16[j] * Sv + bv16[j]; P *= av16[j]; }
          SEG[((d2 * 4 + seg) * 64 + c) * 2 + 0] = P; SEG[((d2 * 4 + seg) * 64 + c) * 2 + 1] = Sv; }
        __syncthreads();
        if (!PASS2) {
            if (seg == 0) { float Pt = 1.0f, St = 0.0f;
#pragma unroll
                for (int k = 0; k < 4; ++k) { const float p = SEG[((d2 * 4 + k) * 64 + c) * 2], sg = SEG[((d2 * 4 + k) * 64 + c) * 2 + 1]; St = p * St + sg; Pt *= p; }
                float* ag = AGG + (((size_t)b * 36 + vc) * 2 + d2) * 1024 + (h * 64 + c) * 2; ag[0] = Pt; ag[1] = St; }
        } else {
            float hv = HALL[(t * 2 + d2) * 64 + c];
            for (int k = 0; k < seg; ++k) { const float p = SEG[((d2 * 4 + k) * 64 + c) * 2], sg = SEG[((d2 * 4 + k) * 64 + c) * 2 + 1]; hv = p * hv + sg; }
#pragma unroll
            for (int j = 0; j < 16; ++j) { const int vs = seg * 16 + j, s = d2 ? 63 - vs : vs; hv = av16[j] * hv + bv16[j]; BB[(d2 * 64 + s) * 64 + c] = hv; }
            __syncthreads();
            { const size_t trow = (size_t)b * SEQ + s0 + cs;
              const float g[8] = {bflo(gq.x), bfhi(gq.x), bflo(gq.y), bfhi(gq.y), bflo(gq.z), bfhi(gq.z), bflo(gq.w), bfhi(gq.w)}; float o[8];
              const f32x4 h0a = *(const LAS f32x4*)(BB + (0 * 64 + cs) * 64 + ig * 8), h0b = *(const LAS f32x4*)(BB + (0 * 64 + cs) * 64 + ig * 8 + 4);
              const f32x4 h1a = *(const LAS f32x4*)(BB + (1 * 64 + cs) * 64 + ig * 8), h1b = *(const LAS f32x4*)(BB + (1 * 64 + cs) * 64 + ig * 8 + 4);
              const float hs[8] = {h0a.x + h1a.x, h0a.y + h1a.y, h0a.z + h1a.z, h0a.w + h1a.w, h0b.x + h1b.x, h0b.y + h1b.y, h0b.z + h1b.z, h0b.w + h1b.w};
#pragma unroll
              for (int i = 0; i < 8; ++i) { const float z = g[i] + 0.044715f * g[i] * g[i] * g[i];
                  const float ge = g[i] * __builtin_amdgcn_rcpf(1.0f + __builtin_amdgcn_exp2f(-1.5957691216057308f * 1.4426950408889634f * z));
                  o[i] = ge * hs[i]; }
              *(v4u*)(Y + trow * 1024 + col) = pack8(o); }
            gq = gqn;
        }
    }
    __syncthreads();
}

__device__ __forceinline__ float red8(const float (&p)[8], int lane) {
    const bool b0 = lane & 1, b1 = lane & 2, b2 = lane & 4;
    float q[4], r2[2];
#pragma unroll
    for (int i = 0; i < 4; ++i) { const float keep = b0 ? p[i + 4] : p[i], send = b0 ? p[i] : p[i + 4]; q[i] = keep + __shfl_xor(send, 1); }
#pragma unroll
    for (int i = 0; i < 2; ++i) { const float keep = b1 ? q[i + 2] : q[i], send = b1 ? q[i] : q[i + 2]; r2[i] = keep + __shfl_xor(send, 2); }
    float s; { const float keep = b2 ? r2[1] : r2[0], send = b2 ? r2[0] : r2[1]; s = keep + __shfl_xor(send, 4); }
    s += __shfl_xor(s, 8); s += __shfl_xor(s, 16); s += __shfl_xor(s, 32);
    return s;
}
__device__ __forceinline__ void p6_route(const Args& a, Frame& F, bool commit) {
    const float* X1 = a.out; const float* MOD = (const float*)(a.ws + WS_MOD); const float* WrT = (const float*)(a.ws + WS_WRT);
    bf16* ML = (bf16*)(a.ws + WS_RB); int* SLOT = (int*)(a.ws + WS_SLOT); float* GATEW = (float*)(a.ws + WS_GATEW); unsigned* CNT = (unsigned*)(a.ws + WS_CTL) + CW_CNT;
    const float* n2g = a.in[I_N2G]; const float* rgb = a.in[I_RGRB]; const float* reb = a.in[I_REB];
    const int lane = F.lane;
    LAS float* LG = (LAS float*)(F.lds + F.wave * 2048);
    LAS float* WL = (LAS float*)(F.lds + 16384);
    if (F.bid == 0 && F.tid < 128) *(v4u*)(ML + (size_t)NTOK * 1024 + F.tid * 8) = (v4u){0u, 0u, 0u, 0u};
    for (int base = F.bid; base < NTOK / 64; base += F.G) {
        const int row0 = (base * NWAVES + F.wave) * 8, b = row0 >> 11;
        f32x4 v[8][4]; float ss[8];
#pragma unroll
        for (int r = 0; r < 8; ++r) { ss[r] = 0.f;
#pragma unroll
            for (int j = 0; j < 4; ++j) { v[r][j] = *(const f32x4*)(X1 + (size_t)(row0 + r) * 1024 + 4 * lane + 256 * j);
                ss[r] += (v[r][j].x * v[r][j].x + v[r][j].y * v[r][j].y) + (v[r][j].z * v[r][j].z + v[r][j].w * v[r][j].w); } }
#pragma unroll
        for (int r = 0; r < 8; ++r) ss[r] = 1.0f / sqrtf(wave_sum(ss[r]) * (1.0f / 1024.0f) + NORM_EPS);
#pragma unroll
        for (int j = 0; j < 4; ++j) { const int col = 4 * lane + 256 * j;
            const f32x4 gn = *(const f32x4*)(n2g + col), sc = *(const f32x4*)(MOD + (size_t)b * 6144 + 4096 + col), sh = *(const f32x4*)(MOD + (size_t)b * 6144 + 3072 + col);
            const f32x4 gs = gn * (sc + 1.0f);
#pragma unroll
            for (int r = 0; r < 8; ++r) { v[r][j] = (v[r][j] * ss[r]) * gs + sh; v2u o; o.x = pk2(v[r][j].x, v[r][j].y); o.y = pk2(v[r][j].z, v[r][j].w);
                *(v2u*)(ML + (size_t)(row0 + r) * 1024 + col) = o; } }
        const int rid = 4 * (lane & 1) + 2 * ((lane >> 1) & 1) + ((lane >> 2) & 1);
#pragma unroll 1
        for (int half = 0; half < 2; ++half) {
            __syncthreads();
#pragma unroll
            for (int i = 0; i < 9; ++i) *(LAS f32x4*)(WL + 4 * (F.tid + 512 * i)) = *(const f32x4*)(WrT + half * 18432 + 4 * (F.tid + 512 * i));
            __syncthreads();
#pragma unroll 2
            for (int jj = 0; jj < 18; ++jj) { f32x4 w[4];
#pragma unroll
                for (int j = 0; j < 4; ++j) w[j] = *(const LAS f32x4*)(WL + jj * 1024 + 4 * lane + 256 * j);
                float p[8];
#pragma unroll
                for (int r = 0; r < 8; ++r) { f32x4 q = v[r][0] * w[0]; q = v[r][1] * w[1] + q; q = v[r][2] * w[2] + q; q = v[r][3] * w[3] + q; p[r] = (q.x + q.y) + (q.z + q.w); }
                const int jo = half * 18 + jj;
                const float tot = red8(p, lane) + (jo < 4 ? rgb[jo] : reb[jo - 4]);
                if (lane < 8) LG[rid * 36 + jo] = tot; }
        }
        LDS_WAIT(); asm volatile("" ::: "memory");
        float lg[36];
#pragma unroll
        for (int jj = 0; jj < 36; ++jj) lg[jj] = LG[(lane < 8 ? rid : 0) * 36 + jj];
        int grp = 0; float gm = lg[0];
#pragma unroll
        for (int j = 1; j < 4; ++j) if (lg[j] > gm) { gm = lg[j]; grp = j; }
        float gz = 0.f;
#pragma unroll
        for (int j = 0; j < 4; ++j) gz += __expf(lg[j] - gm);
        const float pg = 1.0f / gz;
        float el[8];
#pragma unroll
        for (int i = 0; i < 8; ++i) el[i] = grp == 0 ? lg[4 + i] : grp == 1 ? lg[12 + i] : grp == 2 ? lg[20 + i] : lg[28 + i];
        int i1 = 0; float m1 = el[0];
#pragma unroll
        for (int i = 1; i < 8; ++i) if (el[i] > m1) { m1 = el[i]; i1 = i; }
        int i2 = -1; float m2 = -3.0e38f;
#pragma unroll
        for (int i = 0; i < 8; ++i) if (i != i1 && el[i] > m2) { m2 = el[i]; i2 = i; }
        const float e2 = __expf(m2 - m1), den = 1.0f / (1.0f + e2);
        if (lane < 8 && commit) { const int tok = row0 + rid;
            const int ea = grp * 8 + i1, eb = grp * 8 + i2;
            const unsigned pa = __hip_atomic_fetch_add(CNT + 64 * ea, 1u, RLX_AGENT); SLOT[ea * 16384 + pa] = tok * 2;     GATEW[tok * 2] = pg * den;
            const unsigned pb = __hip_atomic_fetch_add(CNT + 64 * eb, 1u, RLX_AGENT); SLOT[eb * 16384 + pb] = tok * 2 + 1; GATEW[tok * 2 + 1] = pg * e2 * den; }
    }
    __syncthreads();
}

__device__ __forceinline__ void build_tiles(const Args& a, Frame& F) {
    LAS int* T = (LAS int*)(F.lds + TBL_OFF); unsigned* CNT = (unsigned*)(a.ws + WS_CTL) + CW_CNT;
    if (F.tid < 32) T[F.tid] = (int)__hip_atomic_load(CNT + 64 * F.tid, RLX_AGENT);
    __syncthreads();
    if (F.tid == 0) { int acc = 0;
        for (int e = 0; e < 32; ++e) { const int n = (T[e] + 255) >> 8; T[32 + e] = acc; for (int t = 0; t < n; ++t) T[96 + acc + t] = e; acc += n; }
        T[64] = acc; }
    __syncthreads();
}
constexpr int ROWTAB_OFF = TBL_OFF + 1024;
template <class Sched>
__device__ __forceinline__ void build_rowtab(const Args& a, Frame& F, const Sched& S) {
    const LAS int* T = (const LAS int*)(F.lds + TBL_OFF); LAS int* RT = (LAS int*)(F.lds + ROWTAB_OFF); const int* SLOT = (const int*)(a.ws + WS_SLOT);
    pg8::Unit u;
    for (int i = 0; i < 4 && S.next(i, u); ++i)
        if (F.tid < 256) { const int e = u.pn >> 2, pos = (u.pm - T[32 + e]) * 256 + F.tid; RT[i * 256 + F.tid] = pos < T[e] ? (SLOT[e * 16384 + pos] >> 1) : NTOK; }
    __syncthreads();
}
__device__ __forceinline__ void p10_final(const Args& a, Frame& F, bool commit) {
    float* X1 = a.out; float* OUT = commit ? a.out : (float*)(a.ws + WS_RA); const float* MOD = (const float*)(a.ws + WS_MOD); const bf16* YA = (const bf16*)(a.ws + WS_YA); const float* fng = a.in[I_FNG];
    const int lane = F.lane;
    for (int t = F.bid * NWAVES + F.wave; t < NTOK; t += F.G * NWAVES) {
        const int b = t >> 11; f32x4 v[4]; float ss = 0.f;
#pragma unroll
        for (int j = 0; j < 4; ++j) { const int col = 4 * lane + 256 * j;
            const f32x4 x = *(const f32x4*)(X1 + (size_t)t * 1024 + col), g2 = *(const f32x4*)(MOD + (size_t)b * 6144 + 5120 + col);
            const v2u ya = *(const v2u*)(YA + (size_t)(2 * t) * 1024 + col), yb = *(const v2u*)(YA + (size_t)(2 * t + 1) * 1024 + col);
            f32x4 y; y.x = bflo(ya.x) + bflo(yb.x); y.y = bfhi(ya.x) + bfhi(yb.x); y.z = bflo(ya.y) + bflo(yb.y); y.w = bfhi(ya.y) + bfhi(yb.y);
            v[j] = x + g2 * y; ss += (v[j].x * v[j].x + v[j].y * v[j].y) + (v[j].z * v[j].z + v[j].w * v[j].w); }
        const float rstd = 1.0f / sqrtf(wave_sum(ss) * (1.0f / 1024.0f) + NORM_EPS);
#pragma unroll
        for (int j = 0; j < 4; ++j) { const int col = 4 * lane + 256 * j; const f32x4 g = *(const f32x4*)(fng + col);
            *(f32x4*)(OUT + (size_t)t * 1024 + col) = (v[j] * rstd) * g; }
    }
}

__global__ void __launch_bounds__(NWAVES * 64, 2) mk_fwd(Args a) {
    extern __shared__ __attribute__((aligned(16))) unsigned char lds_raw[];
    Frame F; F.lds = (LAS unsigned char*)lds_raw; F.tid = threadIdx.x; F.lane = F.tid & 63; F.wave = __builtin_amdgcn_readfirstlane(F.tid >> 6); F.G = gridDim.x; F.bid = blockIdx.x;
    for (int u = F.tid; u < (LDS_BYTES - LDSCTL_OFF) / 4; u += NWAVES * 64) ((LAS unsigned*)(F.lds + LDSCTL_OFF))[u] = 0u;
    __syncthreads();
    const int lo = a.ph_lo, hi = a.ph_hi;
    XcdBarrier bar; bar.bar = (unsigned*)(a.ws + WS_CTL) + CW_BAR; bar.x = 0; bar.st = nullptr;
    if (hi - lo > 1) bar = xcd_barrier_post((unsigned*)(a.ws + WS_CTL) + CW_BAR, (volatile LAS unsigned*)(F.lds + LDSCTL_OFF) + 8);
#ifndef PHMASK
#define PHMASK 0x7ff
#endif
#define IN(k) (((PHMASK >> (k)) & 1) && lo <= (k) && (k) < hi)
#define SEAM(k) do { if (IN(k) && IN((k) + 1)) xcd_barrier(bar); } while (0)
#ifndef PROBE_REP
#define PROBE_REP (-1)
#endif
#ifndef PROBE_N
#define PROBE_N 3
#endif
#ifndef PROBE_T
#define PROBE_T (-1)
#endif
#define TBEG(k) unsigned long long tb_ = 0; if (PROBE_T == (k) || PROBE_T == 99) tb_ = __builtin_amdgcn_s_memrealtime();
#define TEND(k) if (PROBE_T == (k) || PROBE_T == 99) { const unsigned long long te_ = __builtin_amdgcn_s_memrealtime(); while (__builtin_amdgcn_s_memrealtime() - te_ < te_ - tb_) __builtin_amdgcn_s_sleep(8); }
#define REPS(k) for (int rep_ = 0; rep_ < ((PROBE_REP == (k)) ? PROBE_N : 1); ++rep_)

    if (IN(0)) { TBEG(0) REPS(0) { p0_prep(a, F); } TEND(0) } SEAM(0);
    if (IN(1)) { TBEG(1) REPS(1) { p1_norm(a, F); } TEND(1) } SEAM(1);
    if (IN(2)) { TBEG(2) { {
        pg8::Gemm g{(const bf16*)(a.ws + WS_RB), (const bf16*)(a.ws + WS_WIN), NTOK + NCTX, DIN, DM}; pg8::OrderInProj S{F.G, F.bid};
        pg8::EpiInProj E{(bf16*)(a.ws + WS_RA), (bf16*)(a.ws + WS_ZC)};
        pg8::gemm_phase<pg8::EpiInProj, pg8::OrderInProj, true, true>(F.lds, g, S, E); }
    if (PROBE_REP == 2) {
        pg8::Gemm g{(const bf16*)(a.ws + WS_RB), (const bf16*)(a.ws + WS_WIN), NTOK + NCTX, DIN, DM}; pg8::OrderInProj S{F.G, F.bid};
        pg8::EpiInProj E{(bf16*)(a.ws + WS_RA), (bf16*)(a.ws + WS_ZC)};
        pg8::gemm_phase<pg8::EpiInProj, pg8::OrderInProj, true, true>(F.lds, g, S, E); } }
    TEND(2) } SEAM(2);
    if (IN(3)) { TBEG(3) REPS(3) {
        for (int it = F.bid; it < 256; it += F.G) yconv_item(a, F, it >> 5, it & 31);
        for (int w = F.bid; w < 256; w += F.G) { const int bh = w >> 2; scan_range<false>(a, F, bh >> 3, bh & 7, 9 * (w & 3), 9); } }
    TEND(3) } SEAM(3);
    if (IN(4)) { TBEG(4) REPS(4) {
        for (int w = F.bid; w < 256; w += F.G) { const int bh = w >> 2; scan_range<true>(a, F, bh >> 3, bh & 7, 4 + 8 * (w & 3), 8); } }
    TEND(4) } SEAM(4);
    if (IN(5)) { TBEG(5) REPS(5) {
        pg8::Gemm g{(const bf16*)(a.ws + WS_RB), (const bf16*)(a.ws + WS_WOUT), NTOK, DM, DM}; pg8::StaticOrder S; S.init(NTOK, DM, F.G, F.bid);
        pg8::EpiOutProj E{a.in[I_X], a.out, (const float*)(a.ws + WS_MOD)};
        pg8::gemm_phase<pg8::EpiOutProj, pg8::StaticOrder, true, true>(F.lds, g, S, E); }
    TEND(5) } SEAM(5);
    if (IN(6)) { TBEG(6) REPS(6) { p6_route(a, F, rep_ == ((PROBE_REP == 6) ? PROBE_N : 1) - 1); } TEND(6) } if (IN(6) && IN(8)) xcd_barrier(bar);
    if (IN(8)) { TBEG(8) {
        build_tiles(a, F); const LAS int* T = (const LAS int*)(F.lds + TBL_OFF);
        pg8::Gemm g{(const bf16*)(a.ws + WS_RB), (const bf16*)(a.ws + WS_WGU), 0, 0, DM}; pg8::OrderMoE S{F.G, F.bid, T[64] * 4, T + 96};
        build_rowtab(a, F, S);
        pg8::EpiGateUp E{(bf16*)(a.ws + WS_RA)};
        pg8::gemm_phase_g<pg8::EpiGateUp, pg8::OrderMoE, true>(F.lds, g, S, E, (const LAS int*)(F.lds + ROWTAB_OFF));
        if (PROBE_REP == 8) pg8::gemm_phase_g<pg8::EpiGateUp, pg8::OrderMoE, true>(F.lds, g, S, E, (const LAS int*)(F.lds + ROWTAB_OFF)); }
    TEND(8) } SEAM(8);
    if (IN(9)) { TBEG(9) {
        build_tiles(a, F); const LAS int* T = (const LAS int*)(F.lds + TBL_OFF);
        pg8::Gemm g{(const bf16*)(a.ws + WS_RA), (const bf16*)(a.ws + WS_WD), 0, 0, 512}; pg8::OrderMoE S{F.G, F.bid, T[64] * 4, T + 96};
        pg8::EpiDown E{(bf16*)(a.ws + WS_YA), (const int*)(a.ws + WS_SLOT), (const float*)(a.ws + WS_GATEW), T};
        pg8::gemm_phase<pg8::EpiDown, pg8::OrderMoE, true, true>(F.lds, g, S, E);
        if (PROBE_REP == 9) pg8::gemm_phase<pg8::EpiDown, pg8::OrderMoE, true, true>(F.lds, g, S, E); }
    TEND(9) } SEAM(9);
    if (IN(10)) { TBEG(10) REPS(10) { p10_final(a, F, rep_ == ((PROBE_REP == 10) ? PROBE_N : 1) - 1); }
    TEND(10) }
#undef IN
#undef SEAM
}

extern "C" void kernel_launch(void* const* d_in, const int* in_sizes, int n_in, void* d_out, int out_size, void* d_ws, size_t ws_size, hipStream_t stream) {
    static int grid = 0;
    if (grid == 0) {
        if (n_in != N_IN || out_size != NTOK * DM || ws_size < WS_END) { fprintf(stderr, "kernel_launch: unexpected shapes: n_in %d out %d ws %zu (need %zu)\n", n_in, out_size, ws_size, (size_t)WS_END); grid = -1; return; }
        int dev = 0, cus = 0, per_cu = 0;
        if (hipGetDevice(&dev) != hipSuccess || hipDeviceGetAttribute(&cus, hipDeviceAttributeMultiprocessorCount, dev) != hipSuccess) { grid = -1; return; }
        if (hipFuncSetAttribute((const void*)mk_fwd, hipFuncAttributeMaxDynamicSharedMemorySize, LDS_BYTES) != hipSuccess) { fprintf(stderr, "kernel_launch: hipFuncSetAttribute failed\n"); grid = -1; return; }
        if (hipOccupancyMaxActiveBlocksPerMultiprocessor(&per_cu, (const void*)mk_fwd, NWAVES * 64, LDS_BYTES) != hipSuccess || per_cu < 1) { fprintf(stderr, "kernel_launch: occupancy query says %d blocks per CU\n", per_cu); (void)hipGetLastError(); grid = -1; return; }
        grid = cus;
        if (grid > 256) grid = 256;
    }
    if (grid < 0) return;
    (void)hipMemsetAsync((char*)d_ws + WS_CTL, 0, CTL_ZERO_BYTES, stream);
    Args a{};
    for (int i = 0; i < N_IN; ++i) a.in[i] = (const float*)d_in[i];
    a.out = (float*)d_out; a.ws = (unsigned char*)d_ws;
    if (MK_N_LAUNCHES == 1) {
        a.ph_lo = 0; a.ph_hi = N_PHASES;
        void* args[] = {&a};
        hipError_t e = hipLaunchCooperativeKernel((const void*)mk_fwd, dim3(grid), dim3(NWAVES * 64), args, LDS_BYTES, stream);
        if (e != hipSuccess) fprintf(stderr, "kernel_launch: cooperative launch failed: %s (grid %d)\n", hipGetErrorString(e), grid);
    } else {
        for (int p = 0; p < N_PHASES; ++p) { a.ph_lo = p; a.ph_hi = p + 1; hipLaunchKernelGGL(mk_fwd, dim3(grid), dim3(NWAVES * 64), LDS_BYTES, stream, a); }
    }
}
```

```cpp
#define MK_N_LAUNCHES 1
#include <hip/hip_runtime.h>
#include <cstdio>
#include <cstdint>
namespace pg8 {
#define PG8_LAS __attribute__((address_space(3)))
typedef unsigned short bf16_t;
typedef short bf16x8 __attribute__((ext_vector_type(8)));
typedef float f32x4 __attribute__((ext_vector_type(4)));
typedef unsigned u32x4 __attribute__((ext_vector_type(4)));
constexpr int BM = 256, BK = 64, HALF = 128, HTB = HALF * BK * 2  , STAGE_BYTES = 8 * HTB, NXCD = 8, WGM = 8;

__host__ __device__ __forceinline__ int lds_byte(int r, int c) { const int st = (r >> 4) * 2 + (c >> 5), rr = r & 15, cc = c & 31, ob = rr * 64 + cc * 2; return st * 1024 + (ob ^ (((ob >> 9) & 1) << 5)); }
__host__ __device__ __forceinline__ void stage_rc(int b, int& R, int& C) { const int st = b / 1024, sb = b % 1024, swz = sb ^ (((sb >> 9) & 1) << 5); R = (st >> 1) * 16 + swz / 64; C = (st & 1) * 32 + (swz % 64) / 2; }
__host__ __device__ __forceinline__ int perm32(int rho) { const int n = rho >> 4, i = rho & 15; return 8 * (i >> 2) + 4 * n + (i & 3); }

struct Unit { int pm, pn; };
struct Gemm { const bf16_t* A; const bf16_t* Bt; int M, N, K; };

struct StaticOrder {
    int nM, nN, nwg, G, c;
    __host__ __device__ void init(int M, int N, int G_, int c_) { nM = M / BM; nN = N / BM; nwg = nM * nN; G = G_; c = c_; }
    __host__ __device__ bool next(int i, Unit& u) const {
        const long L = (long)i * G + c; if (L >= nwg) return false;
        int wgid = (int)L; { const int q = nwg / NXCD, r = nwg % NXCD, xcd = wgid % NXCD, off = wgid / NXCD; wgid = (xcd < r ? xcd * (q + 1) : r * (q + 1) + (xcd - r) * q) + off; }
        const int nig = WGM * nN, gid = wgid / nig, fm = gid * WGM, gsz = (nM - fm) < WGM ? (nM - fm) : WGM;
        u.pm = fm + ((wgid % nig) % gsz); u.pn = (wgid % nig) / gsz; return true;
    }
    __device__ __forceinline__ void a_ready(const Unit&) const {}
    __device__ __forceinline__ void done(const Unit&) const {}
};
__device__ __forceinline__ unsigned cvt_pk_bf16(float lo, float hi) { unsigned r; asm volatile("v_cvt_pk_bf16_f32 %0, %1, %2" : "=v"(r) : "v"(lo), "v"(hi)); return r; }
struct EpiInProj {
    static constexpr bool PERM = true, AFTER_DRAIN = false;
    bf16_t* Z; bf16_t* Zc;
    __device__ __forceinline__ void operator()(const f32x4 (&acc)[2][2][4][2], const Unit& u, int wr, int wc, int fr, int fq) const {
        const bool isctx = u.pm >= 64;
        bf16_t* base = isctx ? Zc : Z; const int ldc = isctx ? 512 : 2560; const int prow = isctx ? u.pm - 64 : u.pm;
        const int row0 = prow * BM + wr * 64 + fr, col0 = u.pn * BM + wc * 32 + 8 * fq;
#pragma unroll
        for (int ai = 0; ai < 2; ++ai)
#pragma unroll
            for (int m = 0; m < 4; ++m) { bf16_t* rowp = base + (size_t)(row0 + ai * HALF + m * 16) * ldc + col0;
#pragma unroll
                for (int bj = 0; bj < 2; ++bj) { const f32x4 v0 = acc[ai][bj][m][0], v1 = acc[ai][bj][m][1];
                    u32x4 w; w.x = cvt_pk_bf16(v0[0], v0[1]); w.y = cvt_pk_bf16(v0[2], v0[3]); w.z = cvt_pk_bf16(v1[0], v1[1]); w.w = cvt_pk_bf16(v1[2], v1[3]);
                    *(u32x4*)(rowp + bj * HALF) = w; } }
    }
};
struct EpiOutProj {
    static constexpr bool PERM = false, AFTER_DRAIN = false;
    const float* x; float* X1; const float* mod;
    __device__ __forceinline__ void operator()(const f32x4 (&acc)[2][2][4][2], const Unit& u, int wr, int wc, int fr, int fq) const {
        const int b = u.pm >> 3;
        const int row0 = u.pm * BM + wr * 64 + fr, col0 = u.pn * BM + wc * 32 + 4 * fq;
        f32x4 gv[2][2];
#pragma unroll
        for (int bj = 0; bj < 2; ++bj)
#pragma unroll
            for (int n = 0; n < 2; ++n) gv[bj][n] = *(const f32x4*)(mod + (size_t)b * 6144 + 2048 + col0 + bj * HALF + n * 16);
#pragma unroll
        for (int ai = 0; ai < 2; ++ai)
#pragma unroll
            for (int m = 0; m < 4; ++m) { const size_t off = (size_t)(row0 + ai * HALF + m * 16) * 1024 + col0;
#pragma unroll
                for (int bj = 0; bj < 2; ++bj)
#pragma unroll
                    for (int n = 0; n < 2; ++n) { const f32x4 xv = *(const f32x4*)(x + off + bj * HALF + n * 16);
                        *(f32x4*)(X1 + off + bj * HALF + n * 16) = xv + gv[bj][n] * acc[ai][bj][m][n]; } }
    }
};
__device__ __forceinline__ float silu_f(float g) { return g * __builtin_amdgcn_rcpf(1.0f + __builtin_amdgcn_exp2f(-1.4426950408889634f * g)); }
struct EpiGateUp {
    static constexpr bool PERM = true, AFTER_DRAIN = false;
    unsigned char* H;
    __device__ __forceinline__ void operator()(const f32x4 (&acc)[2][2][4][2], const Unit& u, int wr, int wc, int fr, int fq) const {
        const int row0 = u.pm * BM + wr * 64 + fr, col0 = (u.pn & 3) * 128 + wc * 32 + 8 * fq;
#pragma unroll
        for (int ai = 0; ai < 2; ++ai)
#pragma unroll
            for (int m = 0; m < 4; ++m) { unsigned char* rowp = H + (size_t)(row0 + ai * HALF + m * 16) * 512 + col0;
                const f32x4 g0 = acc[ai][0][m][0], g1 = acc[ai][0][m][1], u0 = acc[ai][1][m][0], u1 = acc[ai][1][m][1];
#define H8_(g, u) __builtin_amdgcn_fmed3f(4.0f * silu_f(g) * (u), -448.0f, 448.0f)
                int w0 = __builtin_amdgcn_cvt_pk_fp8_f32(H8_(g0[0], u0[0]), H8_(g0[1], u0[1]), 0, false);
                w0 = __builtin_amdgcn_cvt_pk_fp8_f32(H8_(g0[2], u0[2]), H8_(g0[3], u0[3]), w0, true);
                int w1 = __builtin_amdgcn_cvt_pk_fp8_f32(H8_(g1[0], u1[0]), H8_(g1[1], u1[1]), 0, false);
                w1 = __builtin_amdgcn_cvt_pk_fp8_f32(H8_(g1[2], u1[2]), H8_(g1[3], u1[3]), w1, true);
#undef H8_
                typedef int i32x2 __attribute__((ext_vector_type(2)));
                *(i32x2*)rowp = (i32x2){w0, w1}; }
    }
};
struct EpiDown {
    static constexpr bool PERM = true, AFTER_DRAIN = false;
    bf16_t* YA; const int* slot; const float* gatew; const PG8_LAS int* T;
    __device__ __forceinline__ void operator()(const f32x4 (&acc)[2][2][4][2], const Unit& u, int wr, int wc, int fr, int fq) const {
        const int e = u.pn >> 2, cnt = T[e], pos0 = (u.pm - T[32 + e]) * BM + wr * 64 + fr, col0 = (u.pn & 3) * BM + wc * 32 + 8 * fq;
        int asg[2][4];
#pragma unroll
        for (int ai = 0; ai < 2; ++ai)
#pragma unroll
            for (int m = 0; m < 4; ++m) { const int pos = pos0 + ai * HALF + m * 16; asg[ai][m] = pos < cnt ? slot[e * 16384 + pos] : -1; }
#pragma unroll
        for (int ai = 0; ai < 2; ++ai)
#pragma unroll
            for (int m = 0; m < 4; ++m) { const int as = asg[ai][m];
                if (as >= 0) { const float gw = gatew[as]; bf16_t* rowp = YA + (size_t)as * 1024 + col0;
#pragma unroll
                    for (int bj = 0; bj < 2; ++bj) { const f32x4 v0 = acc[ai][bj][m][0] * gw, v1 = acc[ai][bj][m][1] * gw;
                        u32x4 w; w.x = cvt_pk_bf16(v0[0], v0[1]); w.y = cvt_pk_bf16(v0[2], v0[3]); w.z = cvt_pk_bf16(v1[0], v1[1]); w.w = cvt_pk_bf16(v1[2], v1[3]);
                        *(u32x4*)(rowp + bj * HALF) = w; } } }
    }
};
struct OrderInProj {
    int G, c;
    __device__ __forceinline__ bool next(int i, Unit& u) const {
        const long L = (long)i * G + c; if (L >= 656) return false;
        if (L < 640) { int wgid = (int)L; const int xcd = wgid % NXCD, off = wgid / NXCD; wgid = xcd * 80 + off;
            const int nig = WGM * 10; const int fm = (wgid / nig) * WGM; u.pm = fm + ((wgid % nig) % WGM); u.pn = (wgid % nig) / WGM; }
        else { const int j = (int)L - 640; u.pm = 64 + (j >> 1); u.pn = j & 1; }
        return true;
    }
    __device__ __forceinline__ void a_ready(const Unit&) const {}
    __device__ __forceinline__ void done(const Unit&) const {}
};
struct OrderMoE {
    int G, c, NU; const PG8_LAS int* TE;
    __device__ __forceinline__ bool next(int i, Unit& u) const {
        const long L = (long)i * G + c; if (L >= NU) return false;
        const int q = NU / NXCD, r = NU % NXCD, xcd = (int)(L % NXCD), off = (int)(L / NXCD);
        const int id = (xcd < r ? xcd * (q + 1) : r * (q + 1) + (xcd - r) * q) + off;
        const int tile = id >> 2; u.pm = tile; u.pn = __builtin_amdgcn_readfirstlane(TE[tile]) * 4 + (id & 3); return true;
    }
    __device__ __forceinline__ void a_ready(const Unit&) const {}
    __device__ __forceinline__ void done(const Unit&) const {}
};
template <class Epi, class Sched, bool ALIGN_EPI = false, bool SP2 = false>
__device__ __forceinline__ void gemm_phase(PG8_LAS unsigned char* lds, const Gemm g, const Sched& S, const Epi& E) {
    const int tid = threadIdx.x, wid = __builtin_amdgcn_readfirstlane(tid >> 6), lane = tid & 63, wr = wid >> 2, wc = wid & 3, fr = lane & 15, fq = lane >> 4;
    const int K = g.K, nt = K / BK;
    unsigned voffA[2], voffB[2];
#pragma unroll
    for (int i = 0; i < 2; ++i) { int R, C; stage_rc(tid * 16 + i * 8192, R, C); const int Rb = Epi::PERM ? ((R & ~31) + perm32(R & 31)) : R;
        voffA[i] = (unsigned)(R * K + C) * 2u; voffB[i] = (unsigned)(Rb * K + C) * 2u; }
    const size_t kstep = (size_t)(BK * 2);
    const size_t hstep = (size_t)HALF * K * 2;
    const size_t tstep = 2 * hstep;
    const unsigned ldsw = (unsigned)wid * 1024u;
    const int aoff = lds_byte(wr * 64 + fr, fq * 8), boff = lds_byte(wc * 32 + fr, fq * 8);
#define PG8_SA(b, h) (((b) * 2 + (h)) * HTB)
#define PG8_SB(b, h) ((4 + (b) * 2 + (h)) * HTB)
#define PG8_STAGE(bufoff, gbase, voff) do { _Pragma("unroll") for (int _i = 0; _i < 2; ++_i) \
        __builtin_amdgcn_global_load_lds((const unsigned*)((const char*)(gbase) + (voff)[_i]), (PG8_LAS unsigned*)(lds + (bufoff) + ldsw + _i * 8192), 16, 0, 0); } while (0)
#define PG8_LDA(dst, b, h) do { _Pragma("unroll") for (int m = 0; m < 4; ++m) _Pragma("unroll") for (int k = 0; k < 2; ++k) dst[m][k] = *(const PG8_LAS bf16x8*)(lds + PG8_SA(b, h) + aoff + m * 2048 + k * 1024); } while (0)
#define PG8_LDB(dst, b, h) do { _Pragma("unroll") for (int n = 0; n < 2; ++n) _Pragma("unroll") for (int k = 0; k < 2; ++k) dst[n][k] = *(const PG8_LAS bf16x8*)(lds + PG8_SB(b, h) + boff + n * 2048 + k * 1024); } while (0)
#define PG8_MMA(ai, bj, At, Bt) do { __builtin_amdgcn_s_setprio(1); _Pragma("unroll") for (int m = 0; m < 4; ++m) _Pragma("unroll") for (int n = 0; n < 2; ++n) _Pragma("unroll") for (int k = 0; k < 2; ++k) \
        acc[ai][bj][m][n] = __builtin_amdgcn_mfma_f32_16x16x32_bf16(Bt[n][k], At[m][k], acc[ai][bj][m][n], 0, 0, 0); __builtin_amdgcn_s_setprio(0); } while (0)
#define PG8_WAIT_V(n) asm volatile("s_waitcnt vmcnt(" #n ")" ::: "memory")
#define PG8_WAIT_L(n) asm volatile("s_waitcnt lgkmcnt(" #n ")" ::: "memory")
#define PG8_BAR __builtin_amdgcn_s_barrier()
#define PG8_SCHED __builtin_amdgcn_sched_barrier(0)
    Unit cur, nxt; int ui = 0;
    if (!S.next(0, cur)) return;
    f32x4 acc[2][2][4][2];
#pragma unroll
    for (int a = 0; a < 2; ++a)
#pragma unroll
        for (int b = 0; b < 2; ++b)
#pragma unroll
            for (int m = 0; m < 4; ++m)
#pragma unroll
                for (int n = 0; n < 2; ++n) acc[a][b][m][n] = (f32x4){0.f, 0.f, 0.f, 0.f};
    bf16x8 At[4][2], B0[2][2], B1[2][2];
    const char* cA = (const char*)g.A + (size_t)cur.pm * tstep; const char* cB = (const char*)g.Bt + (size_t)cur.pn * tstep;
    S.a_ready(cur);
    if constexpr (SP2) {
        PG8_STAGE(PG8_SB(0, 0), cB, voffB); PG8_STAGE(PG8_SB(0, 1), cB + hstep, voffB); PG8_STAGE(PG8_SA(0, 0), cA, voffA); PG8_STAGE(PG8_SA(0, 1), cA + hstep, voffA);
        if (wr == 1) PG8_BAR;
        PG8_WAIT_V(2); PG8_BAR;
        PG8_STAGE(PG8_SB(1, 0), cB + kstep, voffB); PG8_STAGE(PG8_SA(1, 0), cA + kstep, voffA); PG8_STAGE(PG8_SB(1, 1), cB + hstep + kstep, voffB);
        PG8_WAIT_V(6); PG8_BAR;
    } else {
        PG8_STAGE(PG8_SB(0, 0), cB, voffB); PG8_STAGE(PG8_SA(0, 0), cA, voffA); PG8_STAGE(PG8_SB(0, 1), cB + hstep, voffB); PG8_STAGE(PG8_SA(0, 1), cA + hstep, voffA);
        if (wr == 1) PG8_BAR;
        PG8_WAIT_V(4); PG8_BAR;
        PG8_STAGE(PG8_SB(1, 0), cB + kstep, voffB); PG8_STAGE(PG8_SA(1, 0), cA + kstep, voffA); PG8_STAGE(PG8_SB(1, 1), cB + hstep + kstep, voffB);
        PG8_WAIT_V(6); PG8_BAR;
    }
    for (;;) {
        const bool has_next = S.next(ui + 1, nxt);
        const char* nA = has_next ? (const char*)g.A + (size_t)nxt.pm * tstep : cA; const char* nB = has_next ? (const char*)g.Bt + (size_t)nxt.pn * tstep : cB;
        for (int t = 0; t < nt; t += 2) {
            const bool last = (t == nt - 2);
            const char* a1 = cA + (size_t)(t + 1) * kstep;
            const char* a2 = last ? nA : cA + (size_t)(t + 2) * kstep; const char* b2 = last ? nB : cB + (size_t)(t + 2) * kstep;
            const char* a3 = a2 + kstep; const char* b3 = b2 + kstep;
            if (last && has_next) S.a_ready(nxt);
            if constexpr (SP2) {
            PG8_LDB(B0, 0, 0); PG8_LDB(B1, 0, 1); PG8_SCHED; PG8_LDA(At, 0, 0); PG8_STAGE(PG8_SA(1, 1), a1 + hstep, voffA);
            PG8_WAIT_V(8); PG8_WAIT_L(0); PG8_BAR; PG8_MMA(0, 0, At, B0); PG8_MMA(0, 1, At, B1); PG8_BAR; PG8_SCHED;
            PG8_LDA(At, 0, 1); PG8_STAGE(PG8_SB(0, 0), b2, voffB); PG8_STAGE(PG8_SB(0, 1), b2 + hstep, voffB); PG8_STAGE(PG8_SA(0, 0), a2, voffA);
            PG8_WAIT_V(8); PG8_WAIT_L(0); PG8_BAR; PG8_MMA(1, 0, At, B0); PG8_MMA(1, 1, At, B1); PG8_BAR; PG8_SCHED;
            PG8_LDB(B0, 1, 0); PG8_LDB(B1, 1, 1); PG8_SCHED; PG8_LDA(At, 1, 0); PG8_STAGE(PG8_SA(0, 1), a2 + hstep, voffA);
            PG8_WAIT_V(8); PG8_WAIT_L(0); PG8_BAR; PG8_MMA(0, 0, At, B0); PG8_MMA(0, 1, At, B1); PG8_BAR; PG8_SCHED;
            PG8_LDA(At, 1, 1); PG8_STAGE(PG8_SB(1, 0), b3, voffB); PG8_STAGE(PG8_SB(1, 1), b3 + hstep, voffB); PG8_STAGE(PG8_SA(1, 0), a3, voffA);
            PG8_WAIT_V(8); PG8_WAIT_L(0); PG8_BAR; PG8_MMA(1, 0, At, B0); PG8_MMA(1, 1, At, B1); PG8_BAR; PG8_SCHED;
            } else {
            PG8_LDB(B0, 0, 0); PG8_SCHED; PG8_LDA(At, 0, 0); PG8_STAGE(PG8_SA(1, 1), a1 + hstep, voffA);
            PG8_WAIT_L(8); PG8_BAR; PG8_WAIT_L(0); PG8_MMA(0, 0, At, B0); PG8_BAR; PG8_SCHED;
            PG8_LDB(B1, 0, 1); PG8_STAGE(PG8_SB(0, 0), b2, voffB);
            PG8_BAR; PG8_WAIT_L(0); PG8_MMA(0, 1, At, B1); PG8_BAR;
            PG8_LDA(At, 0, 1); PG8_STAGE(PG8_SA(0, 0), a2, voffA);
            PG8_BAR; PG8_WAIT_L(0); PG8_MMA(1, 0, At, B0); PG8_BAR; PG8_SCHED;
            PG8_STAGE(PG8_SB(0, 1), b2 + hstep, voffB);
            PG8_WAIT_V(6); PG8_BAR; PG8_MMA(1, 1, At, B1); PG8_BAR;
            PG8_LDB(B0, 1, 0); PG8_SCHED; PG8_LDA(At, 1, 0); PG8_STAGE(PG8_SA(0, 1), a2 + hstep, voffA);
            PG8_WAIT_L(8); PG8_BAR; PG8_WAIT_L(0); PG8_MMA(0, 0, At, B0); PG8_BAR; PG8_SCHED;
            PG8_LDB(B1, 1, 1); PG8_STAGE(PG8_SB(1, 0), b3, voffB);
            PG8_BAR; PG8_WAIT_L(0); PG8_MMA(0, 1, At, B1); PG8_BAR;
            PG8_LDA(At, 1, 1); PG8_STAGE(PG8_SA(1, 0), a3, voffA);
            PG8_BAR; PG8_WAIT_L(0); PG8_MMA(1, 0, At, B0); PG8_BAR; PG8_SCHED;
            PG8_STAGE(PG8_SB(1, 1), b3 + hstep, voffB);
            PG8_WAIT_V(6); PG8_BAR; PG8_MMA(1, 1, At, B1); PG8_BAR;
            }
        }
        if constexpr (ALIGN_EPI) { if (wr == 0) PG8_BAR; }
        if constexpr (!Epi::AFTER_DRAIN) { E(acc, cur, wr, wc, fr, fq); S.done(cur); }
        if (!has_next) break;
#pragma unroll
        for (int a = 0; a < 2; ++a)
#pragma unroll
            for (int b = 0; b < 2; ++b)
#pragma unroll
                for (int m = 0; m < 4; ++m)
#pragma unroll
                    for (int n = 0; n < 2; ++n) acc[a][b][m][n] = (f32x4){0.f, 0.f, 0.f, 0.f};
        cur = nxt; cA = nA; cB = nB; ++ui;
        if constexpr (ALIGN_EPI) { if (wr == 1) PG8_BAR; }
    }
    PG8_WAIT_V(0);
    if constexpr (!ALIGN_EPI) { if (wr == 0) PG8_BAR; }
    PG8_BAR;
    if constexpr (Epi::AFTER_DRAIN) { E.fused(acc, cur, wr, wc, fr, fq, lds, wid, lane); S.done(cur); }
#undef PG8_SA
#undef PG8_SB
#undef PG8_STAGE
#undef PG8_LDA
#undef PG8_LDB
#undef PG8_MMA
#undef PG8_WAIT_V
#undef PG8_WAIT_L
#undef PG8_BAR
#undef PG8_SCHED
}
typedef int i32x8 __attribute__((ext_vector_type(8)));
typedef int i32x4 __attribute__((ext_vector_type(4)));
__device__ __forceinline__ bf16x8 lo8(i32x8 v) { return __builtin_bit_cast(bf16x8, (i32x4){v[0], v[1], v[2], v[3]}); }
__device__ __forceinline__ bf16x8 hi8(i32x8 v) { return __builtin_bit_cast(bf16x8, (i32x4){v[4], v[5], v[6], v[7]}); }
constexpr int SCALE_A = 0x7D7D7D7D, SCALE_B = 0x7A7A7A7A;
template <class Epi, class Sched, bool ALIGN_EPI, bool F8 = false>
__device__ __forceinline__ void gemm_phase_g(PG8_LAS unsigned char* lds, const Gemm g, const Sched& S, const Epi& E, const PG8_LAS int* rowtab) {
    constexpr bool SP2 = true;
    const int tid = threadIdx.x, wid = __builtin_amdgcn_readfirstlane(tid >> 6), lane = tid & 63, wr = wid >> 2, wc = wid & 3, fr = lane & 15, fq = lane >> 4;
    const int K = g.K, nt = F8 ? K / 128 : K / BK;
    unsigned voffB[2], vc0[2], vc1[2], vn0[2], vn1[2]; int RA[2]; unsigned CA2[2];
#pragma unroll
    for (int i = 0; i < 2; ++i) { int R, C; stage_rc(tid * 16 + i * 8192, R, C); const int Rb = Epi::PERM ? ((R & ~31) + perm32(R & 31)) : R;
        RA[i] = R; CA2[i] = (unsigned)C * 2u; voffB[i] = F8 ? (unsigned)(Rb * K + 2 * C) : (unsigned)(Rb * K + C) * 2u; }
    const unsigned rowb = F8 ? (unsigned)K : (unsigned)K * 2u;
#define PG8_ROWS(ui_, o0, o1) do { _Pragma("unroll") for (int _i = 0; _i < 2; ++_i) { (o0)[_i] = (unsigned)rowtab[(ui_) * 256 + RA[_i]] * rowb + CA2[_i]; (o1)[_i] = (unsigned)rowtab[(ui_) * 256 + 128 + RA[_i]] * rowb + CA2[_i]; } } while (0)
    const size_t kstep = (size_t)(BK * 2);
    const size_t hstep = F8 ? (size_t)HALF * K : (size_t)HALF * K * 2;
    const size_t tstep = 2 * hstep;
    const unsigned ldsw = (unsigned)wid * 1024u;
    const int aoff = lds_byte(wr * 64 + fr, fq * 8), boff = lds_byte(wc * 32 + fr, fq * 8);
#define PG8_SA(b, h) (((b) * 2 + (h)) * HTB)
#define PG8_SB(b, h) ((4 + (b) * 2 + (h)) * HTB)
#define PG8_STAGE(bufoff, gbase, voff) do { _Pragma("unroll") for (int _i = 0; _i < 2; ++_i) \
        __builtin_amdgcn_global_load_lds((const unsigned*)((const char*)(gbase) + (voff)[_i]), (PG8_LAS unsigned*)(lds + (bufoff) + ldsw + _i * 8192), 16, 0, 0); } while (0)
#define PG8_LD16(off) (*(const PG8_LAS i32x4*)(lds + (off)))
#define PG8_LDA(dst, b, h) do { _Pragma("unroll") for (int m = 0; m < 4; ++m) { const i32x4 lo_ = PG8_LD16(PG8_SA(b, h) + aoff + m * 2048), hi_ = PG8_LD16(PG8_SA(b, h) + aoff + m * 2048 + 1024); \
        dst[m] = (i32x8){lo_[0], lo_[1], lo_[2], lo_[3], hi_[0], hi_[1], hi_[2], hi_[3]}; } } while (0)
#define PG8_LDB(dst, b, h) do { _Pragma("unroll") for (int n = 0; n < 2; ++n) { const i32x4 lo_ = PG8_LD16(PG8_SB(b, h) + boff + n * 2048), hi_ = PG8_LD16(PG8_SB(b, h) + boff + n * 2048 + 1024); \
        dst[n] = (i32x8){lo_[0], lo_[1], lo_[2], lo_[3], hi_[0], hi_[1], hi_[2], hi_[3]}; } } while (0)
#define PG8_MMA(ai, bj, At, Bt) do { __builtin_amdgcn_s_setprio(1); if constexpr (F8) { _Pragma("unroll") for (int m = 0; m < 4; ++m) _Pragma("unroll") for (int n = 0; n < 2; ++n) \
        asm volatile("v_mfma_scale_f32_16x16x128_f8f6f4 %0, %1, %2, %0, %3, %4 op_sel_hi:[0,0,0]" : "+v"(acc[ai][bj][m][n]) : "v"(Bt[n]), "v"(At[m]), "v"(scb_), "v"(sca_)); } else { \
        _Pragma("unroll") for (int m = 0; m < 4; ++m) _Pragma("unroll") for (int n = 0; n < 2; ++n) { \
        acc[ai][bj][m][n] = __builtin_amdgcn_mfma_f32_16x16x32_bf16(lo8(Bt[n]), lo8(At[m]), acc[ai][bj][m][n], 0, 0, 0); \
        acc[ai][bj][m][n] = __builtin_amdgcn_mfma_f32_16x16x32_bf16(hi8(Bt[n]), hi8(At[m]), acc[ai][bj][m][n], 0, 0, 0); } } __builtin_amdgcn_s_setprio(0); } while (0)
#define PG8_WAIT_V(n) asm volatile("s_waitcnt vmcnt(" #n ")" ::: "memory")
#define PG8_WAIT_L(n) asm volatile("s_waitcnt lgkmcnt(" #n ")" ::: "memory")
#define PG8_BAR __builtin_amdgcn_s_barrier()
#define PG8_SCHED __builtin_amdgcn_sched_barrier(0)
    Unit cur, nxt; int ui = 0;
    if (!S.next(0, cur)) return;
    f32x4 acc[2][2][4][2];
#pragma unroll
    for (int a = 0; a < 2; ++a)
#pragma unroll
        for (int b = 0; b < 2; ++b)
#pragma unroll
            for (int m = 0; m < 4; ++m)
#pragma unroll
                for (int n = 0; n < 2; ++n) acc[a][b][m][n] = (f32x4){0.f, 0.f, 0.f, 0.f};
    i32x8 At[4], B0[2], B1[2]; const int sca_ = SCALE_A, scb_ = SCALE_B;
    const char* const cA = (const char*)g.A; PG8_ROWS(0, vc0, vc1); const char* cB = (const char*)g.Bt + (size_t)cur.pn * tstep;
    S.a_ready(cur);
    if constexpr (SP2) {
        PG8_STAGE(PG8_SB(0, 0), cB, voffB); PG8_STAGE(PG8_SB(0, 1), cB + hstep, voffB); PG8_STAGE(PG8_SA(0, 0), cA, vc0); PG8_STAGE(PG8_SA(0, 1), cA, vc1);
        if (wr == 1) PG8_BAR;
        PG8_WAIT_V(2); PG8_BAR;
        PG8_STAGE(PG8_SB(1, 0), cB + kstep, voffB); PG8_STAGE(PG8_SA(1, 0), cA + kstep, vc0); PG8_STAGE(PG8_SB(1, 1), cB + hstep + kstep, voffB);
        PG8_WAIT_V(6); PG8_BAR;
    }
#pragma unroll 1
    for (;;) {
        const bool has_next = S.next(ui + 1, nxt);
        const char* nB = has_next ? (const char*)g.Bt + (size_t)nxt.pn * tstep : cB;
        if (has_next) PG8_ROWS(ui + 1, vn0, vn1); else { vn0[0] = vc0[0]; vn0[1] = vc0[1]; vn1[0] = vc1[0]; vn1[1] = vc1[1]; }
#pragma unroll 1
        for (int t = 0; t < nt; t += 2) {
            const bool last = (t == nt - 2);
            const char* a1 = cA + (size_t)(t + 1) * kstep;
            const char* a2 = last ? cA : cA + (size_t)(t + 2) * kstep; const char* b2 = last ? nB : cB + (size_t)(t + 2) * kstep;
            const unsigned s0_[2] = {last ? vn0[0] : vc0[0], last ? vn0[1] : vc0[1]}, s1_[2] = {last ? vn1[0] : vc1[0], last ? vn1[1] : vc1[1]};
            const char* a3 = a2 + kstep; const char* b3 = b2 + kstep;
            if (last && has_next) S.a_ready(nxt);
            if constexpr (SP2) {
            PG8_LDB(B0, 0, 0); PG8_LDB(B1, 0, 1); PG8_SCHED; PG8_LDA(At, 0, 0); PG8_STAGE(PG8_SA(1, 1), a1, vc1);
            PG8_WAIT_V(8); PG8_WAIT_L(0); PG8_BAR; PG8_MMA(0, 0, At, B0); PG8_MMA(0, 1, At, B1); PG8_BAR; PG8_SCHED;
            PG8_LDA(At, 0, 1); PG8_STAGE(PG8_SB(0, 0), b2, voffB); PG8_STAGE(PG8_SB(0, 1), b2 + hstep, voffB); PG8_STAGE(PG8_SA(0, 0), a2, s0_);
            PG8_WAIT_V(8); PG8_WAIT_L(0); PG8_BAR; PG8_MMA(1, 0, At, B0); PG8_MMA(1, 1, At, B1); PG8_BAR; PG8_SCHED;
            PG8_LDB(B0, 1, 0); PG8_LDB(B1, 1, 1); PG8_SCHED; PG8_LDA(At, 1, 0); PG8_STAGE(PG8_SA(0, 1), a2, s1_);
            PG8_WAIT_V(8); PG8_WAIT_L(0); PG8_BAR; PG8_MMA(0, 0, At, B0); PG8_MMA(0, 1, At, B1); PG8_BAR; PG8_SCHED;
            PG8_LDA(At, 1, 1); PG8_STAGE(PG8_SB(1, 0), b3, voffB); PG8_STAGE(PG8_SB(1, 1), b3 + hstep, voffB); PG8_STAGE(PG8_SA(1, 0), a3, s0_);
            PG8_WAIT_V(8); PG8_WAIT_L(0); PG8_BAR; PG8_MMA(1, 0, At, B0); PG8_MMA(1, 1, At, B1); PG8_BAR; PG8_SCHED;
            }
        }
        if constexpr (F8) asm volatile("s_nop 15\n\ts_nop 7" ::: "memory");
        if constexpr (ALIGN_EPI) { if (wr == 0) PG8_BAR; }
        if constexpr (!Epi::AFTER_DRAIN) { E(acc, cur, wr, wc, fr, fq); S.done(cur); }
        if (!has_next) break;
#pragma unroll
        for (int a = 0; a < 2; ++a)
#pragma unroll
            for (int b = 0; b < 2; ++b)
#pragma unroll
                for (int m = 0; m < 4; ++m)
#pragma unroll
                    for (int n = 0; n < 2; ++n) acc[a][b][m][n] = (f32x4){0.f, 0.f, 0.f, 0.f};
        cur = nxt; cB = nB; ++ui; vc0[0] = vn0[0]; vc0[1] = vn0[1]; vc1[0] = vn1[0]; vc1[1] = vn1[1];
        if constexpr (ALIGN_EPI) { if (wr == 1) PG8_BAR; }
    }
    PG8_WAIT_V(0);
    if constexpr (!ALIGN_EPI) { if (wr == 0) PG8_BAR; }
    PG8_BAR;
    if constexpr (Epi::AFTER_DRAIN) { E.fused(acc, cur, wr, wc, fr, fq, lds, wid, lane); S.done(cur); }
#undef PG8_ROWS
#undef PG8_LD16
#undef PG8_SA
#undef PG8_SB
#undef PG8_STAGE
#undef PG8_LDA
#undef PG8_LDB
#undef PG8_MMA
#undef PG8_WAIT_V
#undef PG8_WAIT_L
#undef PG8_BAR
#undef PG8_SCHED
}
}

#ifndef MK_N_LAUNCHES
#define MK_N_LAUNCHES 1
#endif
constexpr int N_PHASES = 11;
constexpr int NWAVES = 8;
#define GAS __attribute__((address_space(1)))
#define LAS __attribute__((address_space(3)))
typedef unsigned short bf16;
typedef unsigned v4u __attribute__((ext_vector_type(4)));
typedef unsigned v2u __attribute__((ext_vector_type(2)));
typedef float f32x4 __attribute__((ext_vector_type(4)));
typedef float f32x16 __attribute__((ext_vector_type(16)));
typedef short bf16x8 __attribute__((ext_vector_type(8)));
#define LDS_WAIT() asm volatile("s_waitcnt lgkmcnt(0)" ::: "memory")
#define RLX_AGENT __ATOMIC_RELAXED, __HIP_MEMORY_SCOPE_AGENT

constexpr int NB = 8, SEQ = 2048, DM = 1024, CTXL = 256, NTOK = NB * SEQ, NCTX = NB * CTXL, DIN = 2560, NEXP = 32;
constexpr float NORM_EPS = 1e-6f;
enum { I_X = 0, I_C, I_CTX, I_CCTX, I_ADAW, I_ADAB, I_N1G, I_N2G, I_WIN, I_RCW, I_RCB, I_RGWA, I_RGBA, I_RGWX, I_RGBX, I_RGLAM, I_SCW, I_WOUT, I_RGRW, I_RGRB, I_REW, I_REB, I_EWG, I_EWU, I_EWD, I_FNG, N_IN };

constexpr size_t MiB = 1u << 20;
constexpr size_t WS_CTL = 0, CTL_ZERO_BYTES = 1 * MiB;
constexpr size_t WS_MODP = 1 * MiB;
constexpr size_t WS_MOD = 5 * MiB;
constexpr size_t WS_WRT = 5 * MiB + 512 * 1024;
constexpr size_t WS_WRG = 5 * MiB + 768 * 1024;
constexpr size_t WS_WIN = 6 * MiB;
constexpr size_t WS_WOUT = 11 * MiB;
constexpr size_t WS_WGU = 13 * MiB;
constexpr size_t WS_WD = 77 * MiB;
constexpr size_t WS_AGG = 109 * MiB;
constexpr size_t WS_SLOT = 112 * MiB;
constexpr size_t WS_GATEW = 114 * MiB;
constexpr size_t WS_SMAP = 114 * MiB + 256 * 1024;
constexpr size_t WS_RA = 115 * MiB;
constexpr size_t WS_ZC = WS_RA + 80 * MiB;
constexpr size_t WS_RB = 197 * MiB;
constexpr size_t WS_END = 237 * MiB;
constexpr size_t WS_YA = WS_WGU;
constexpr int CW_BAR = 4096;
constexpr int CW_CNT = 16384;
constexpr int RING_BYTES = 131072, LDSCTL_OFF = 133120, TBL_OFF = LDSCTL_OFF + 512, LDS_BYTES = 147456;

__device__ __forceinline__ float bflo(unsigned w) { return __uint_as_float(w << 16); }
__device__ __forceinline__ float bfhi(unsigned w) { return __uint_as_float(w & 0xffff0000u); }
__device__ __forceinline__ unsigned pk2(float lo, float hi) { return pg8::cvt_pk_bf16(lo, hi); }
__device__ __forceinline__ float wave_sum(float v) {
#pragma unroll
    for (int o = 1; o < 64; o <<= 1) v += __shfl_xor(v, o);
    return v;
}

#define XB_TMO      128
#define XB_XCNT(j)  (256  + 64 * (j))
#define XB_XSUB(j)  (1280 + 64 * (j))
#define XB_XGEN(j)  (2304 + 64 * (j))
#define XB_TOP      3328
#define XB_TOPGEN   3392
#define XCD_BAR_WORDS 3456
#define XB_SPIN_CAP (1u << 18)
__device__ __forceinline__ unsigned xb_ld(unsigned* p)              { return __hip_atomic_load(p, __ATOMIC_RELAXED, __HIP_MEMORY_SCOPE_AGENT); }
__device__ __forceinline__ unsigned xb_add(unsigned* p, unsigned v) { return __hip_atomic_fetch_add(p, v, __ATOMIC_RELAXED, __HIP_MEMORY_SCOPE_AGENT); }
__device__ __forceinline__ unsigned xb_xcc_id() { return (unsigned)__builtin_amdgcn_s_getreg((3 << 11) | 20) & 0xFu; }
#define XB_SPIN(cond, bar) do { unsigned _sp = 0; while (cond) { __builtin_amdgcn_s_sleep(1); \
    if ((++_sp & 255u) == 0u) { if (xb_ld(&(bar)[XB_TMO])) break; if (_sp > XB_SPIN_CAP) { atomicAdd(&(bar)[XB_TMO], 1u); break; } } } } while (0)
struct XcdBarrier { unsigned* bar; unsigned x; volatile LAS unsigned* st; };
__device__ __forceinline__ XcdBarrier xcd_barrier_post(unsigned* bar, volatile LAS unsigned* st) {
    XcdBarrier b; b.bar = bar; b.x = xb_xcc_id(); b.st = st;
    if (threadIdx.x == 0) (void)xb_add(&bar[XB_XCNT(b.x)], 1u);
    return b;
}
__device__ __forceinline__ void xcd_barrier_complete(unsigned* bar, unsigned x, unsigned& nloc, unsigned& nx) {
    const unsigned G = gridDim.x * gridDim.y * gridDim.z;
    unsigned sum, cnt, mine, sp = 0u;
    for (;;) {
        sum = 0u; cnt = 0u; mine = 0u;
#pragma unroll
        for (unsigned j = 0; j < 16; ++j) { const unsigned c = xb_ld(&bar[XB_XCNT(j)]); sum += c; cnt += (c > 0u) ? 1u : 0u; mine = (j == x) ? c : mine; }
        if (sum == G) break;
        __builtin_amdgcn_s_sleep(1);
        if ((++sp & 255u) == 0u) { if (xb_ld(&bar[XB_TMO])) break; if (sp > XB_SPIN_CAP) { atomicAdd(&bar[XB_TMO], 1u); break; } }
    }
    nloc = mine > 0u ? mine : 1u; nx = cnt > 0u ? cnt : 1u;
}
__device__ __forceinline__ void xcd_barrier(const XcdBarrier& b) {
    asm volatile("s_waitcnt vmcnt(0)" ::: "memory");
    __syncthreads();
    if (threadIdx.x == 0) {
        unsigned* bar = b.bar;
        __builtin_amdgcn_s_waitcnt(0);
        unsigned nloc = b.st[0], nx = b.st[1];
        if (nloc == 0u) { xcd_barrier_complete(bar, b.x, nloc, nx); b.st[0] = nloc; b.st[1] = nx; }
        const unsigned old = xb_add(&bar[XB_XSUB(b.x)], 1u);
        const unsigned gen = old / nloc;
        if (old + 1u == (gen + 1u) * nloc) {
            __builtin_amdgcn_fence(__ATOMIC_RELEASE, "agent");
            asm volatile("s_waitcnt vmcnt(0)" ::: "memory");
            const unsigned og = xb_add(&bar[XB_TOP], 1u);
            const unsigned tg = og / nx;
            if (og + 1u == (tg + 1u) * nx) xb_add(&bar[XB_TOPGEN], 1u);
            else XB_SPIN(xb_ld(&bar[XB_TOPGEN]) == tg, bar);
            __builtin_amdgcn_fence(__ATOMIC_ACQUIRE, "agent");
            xb_add(&bar[XB_XGEN(b.x)], 1u);
            asm volatile("s_waitcnt vmcnt(0)" ::: "memory");
        } else {
            XB_SPIN(xb_ld(&bar[XB_XGEN(b.x)]) == gen, bar);
            __builtin_amdgcn_fence(__ATOMIC_ACQUIRE, "agent");
            asm volatile("s_waitcnt vmcnt(0)" ::: "memory");
        }
    }
    __syncthreads();
}

struct Args { const float* in[N_IN]; float* out; unsigned char* ws; int ph_lo, ph_hi; };
struct Frame { LAS unsigned char* lds; int tid, lane, wave, G, bid; };

struct TrItem { const float* src; bf16* dst; unsigned char* dst8; int N, KP, f8; };
__device__ __forceinline__ void tr_load(const TrItem& t, f32x4 (&v)[16]) {
#pragma unroll
    for (int i = 0; i < 16; ++i) v[i] = __builtin_nontemporal_load((const f32x4*)(t.src + (size_t)(4 * i) * t.N));
}
__device__ __forceinline__ void tr_finish(const TrItem& t, const f32x4 (&v)[16], LAS float* scr, int lane) {
    const int kq = lane >> 4, nb = 4 * (lane & 15);
#pragma unroll
    for (int i = 0; i < 16; ++i) { const int kk = 4 * i + kq;
        scr[(nb + 0) * 65 + kk] = v[i].x; scr[(nb + 1) * 65 + kk] = v[i].y; scr[(nb + 2) * 65 + kk] = v[i].z; scr[(nb + 3) * 65 + kk] = v[i].w; }
    LDS_WAIT(); asm volatile("" ::: "memory");
    if (t.f8) {
        const int c = lane & 3;
#pragma unroll
        for (int j = 0; j < 4; ++j) { const int n = (lane >> 2) + 16 * j; const LAS float* sp = scr + n * 65 + 16 * c; int o[4];
#pragma unroll
            for (int q = 0; q < 4; ++q) { o[q] = __builtin_amdgcn_cvt_pk_fp8_f32(32.0f * sp[4 * q], 32.0f * sp[4 * q + 1], 0, false); o[q] = __builtin_amdgcn_cvt_pk_fp8_f32(32.0f * sp[4 * q + 2], 32.0f * sp[4 * q + 3], o[q], true); }
            *(v4u*)(t.dst8 + (size_t)(16 * j) * t.KP) = (v4u){(unsigned)o[0], (unsigned)o[1], (unsigned)o[2], (unsigned)o[3]}; }
    } else {
    const int c = lane & 7;
#pragma unroll
    for (int j = 0; j < 8; ++j) { const int n = (lane >> 3) + 8 * j; const LAS float* sp = scr + n * 65 + 8 * c;
        v4u o; o.x = pk2(sp[0], sp[1]); o.y = pk2(sp[2], sp[3]); o.z = pk2(sp[4], sp[5]); o.w = pk2(sp[6], sp[7]);
        *(v4u*)(t.dst + (size_t)(8 * j) * t.KP) = o; }
    }
    LDS_WAIT(); asm volatile("" ::: "memory");
}
__device__ __forceinline__ void gemv_item(const Args& a, int item, LAS float* scr, int lane) {
    const int ks = item / 24, nb = item % 24, k0 = ks * 64, n0 = nb * 256 + 4 * lane;
    const float* cc = a.in[I_C]; const float* cx = a.in[I_CCTX]; const float* W = a.in[I_ADAW];
#pragma unroll
    for (int r = 0; r < 9; ++r) { const float v = r < 8 ? cc[r * 1024 + k0 + lane] : cx[k0 + lane]; scr[r * 64 + lane] = v / (1.0f + __expf(-v)); }
    LDS_WAIT(); asm volatile("" ::: "memory");
    f32x4 acc[9];
#pragma unroll
    for (int r = 0; r < 9; ++r) acc[r] = (f32x4){0.f, 0.f, 0.f, 0.f};
#pragma unroll 16
    for (int kk = 0; kk < 64; ++kk) { const f32x4 w = *(const f32x4*)(W + (size_t)(k0 + kk) * 6144 + n0);
#pragma unroll
        for (int r = 0; r < 9; ++r) acc[r] += scr[r * 64 + kk] * w; }
    float* MODP = (float*)(a.ws + WS_MODP);
#pragma unroll
    for (int r = 0; r < 9; ++r) *(f32x4*)(MODP + ((size_t)ks * 9 + r) * 6144 + n0) = acc[r];
    LDS_WAIT(); asm volatile("" ::: "memory");
}
constexpr int IT_GEMV = 384, IT_WRT = 72;
constexpr int TT_WIN = 16 * 40, TT_WOUT = 16 * 16, TT_RG = 32, TT_GU = 8192, TT_DOWN = 4096, TT_TOTAL = TT_WIN + TT_WOUT + TT_RG + TT_GU + TT_DOWN;
__device__ __forceinline__ TrItem tr_decode(const Args& a, int r, int lane) {
    const float* W; bf16* WT; int N, KP, drow0, k0, n0;
    if (r < TT_WIN) { const int kb = r / 40, nb = r % 40; W = a.in[I_WIN]; WT = (bf16*)(a.ws + WS_WIN); N = 2560; KP = 1024; drow0 = 64 * nb; k0 = 64 * kb; n0 = 64 * nb; }
    else if (r < TT_WIN + TT_WOUT) { const int q = r - TT_WIN, kb = q >> 4, nb = q & 15; W = a.in[I_WOUT]; WT = (bf16*)(a.ws + WS_WOUT); N = 1024; KP = 1024; drow0 = 64 * nb; k0 = 64 * kb; n0 = 64 * nb; }
    else if (r < TT_WIN + TT_WOUT + TT_RG) { const int mat = r - TT_WIN - TT_WOUT, g = mat >> 4, d = (mat >> 3) & 1, h = mat & 7;
        W = (g ? a.in[I_RGWX] : a.in[I_RGWA]) + (size_t)(d * 8 + h) * 4096; WT = (bf16*)(a.ws + WS_WRG); N = 64; KP = 64; drow0 = h * 256 + d * 128 + g * 64; k0 = 0; n0 = 0; }
    else if (r < TT_WIN + TT_WOUT + TT_RG + TT_GU) { int q = r - TT_WIN - TT_WOUT - TT_RG; const int up = q >> 12; q &= 4095; const int e = q >> 7, it2 = q & 127, kb = it2 >> 3, nb = it2 & 7;
        n0 = 64 * nb; k0 = 64 * kb; W = (up ? a.in[I_EWU] : a.in[I_EWG]) + (size_t)e * 524288; WT = (bf16*)(a.ws + WS_WGU); N = 512; KP = 1024; drow0 = e * 1024 + (n0 >> 7) * 256 + up * 128 + (n0 & 127); }
    else { const int q = r - TT_WIN - TT_WOUT - TT_RG - TT_GU, e = q >> 7, it2 = q & 127, kb = it2 >> 4, nb = it2 & 15;
        n0 = 64 * nb; k0 = 64 * kb; W = a.in[I_EWD] + (size_t)e * 524288; WT = (bf16*)(a.ws + WS_WD); N = 1024; KP = 512; drow0 = e * 1024 + n0; }
    TrItem t; t.N = N; t.KP = KP; t.f8 = r >= TT_WIN + TT_WOUT + TT_RG;
    t.src = W + (size_t)(k0 + (lane >> 4)) * N + n0 + 4 * (lane & 15);
    t.dst = WT + (size_t)(drow0 + (lane >> 3)) * KP + k0 + 8 * (lane & 7);
    t.dst8 = (unsigned char*)WT + (size_t)(drow0 + (lane >> 2)) * KP + k0 + 16 * (lane & 3);
    return t;
}
__device__ __forceinline__ void p0_prep(const Args& a, Frame& F) {
    LAS float* scr = (LAS float*)(F.lds + F.wave * 16640);
    const int gw = F.wave * F.G + F.bid, NGW = F.G * NWAVES, lane = F.lane;
    float* WrT = (float*)(a.ws + WS_WRT);
    for (int it = gw; it < IT_GEMV + IT_WRT; it += NGW) {
        if (it < IT_GEMV) { gemv_item(a, it, scr, lane); continue; }
        const int r = it - IT_GEMV; const float* rgw = a.in[I_RGRW]; const float* rew = a.in[I_REW];
#pragma unroll
        for (int i = 0; i < 8; ++i) { const int idx = r * 512 + lane + 64 * i, j = idx >> 10, k = idx & 1023; WrT[idx] = j < 4 ? rgw[k * 4 + j] : rew[k * 32 + (j - 4)]; }
    }
    f32x4 vA[16], vB[16]; TrItem tA, tB;
    int it = gw;
    if (it < TT_TOTAL) { tA = tr_decode(a, TT_TOTAL - 1 - it, lane); tr_load(tA, vA); }
    while (it < TT_TOTAL) {
        int it2 = it + NGW;
        if (it2 < TT_TOTAL) { tB = tr_decode(a, TT_TOTAL - 1 - it2, lane); tr_load(tB, vB); }
        tr_finish(tA, vA, scr, lane);
        it = it2; if (it >= TT_TOTAL) break;
        it2 = it + NGW;
        if (it2 < TT_TOTAL) { tA = tr_decode(a, TT_TOTAL - 1 - it2, lane); tr_load(tA, vA); }
        tr_finish(tB, vB, scr, lane);
        it = it2;
    }
}

__device__ __forceinline__ void norm_row_mod(const float* src, bf16* dst, const LAS float* GS, const LAS float* SH, int lane) {
    const f32x4* xr = (const f32x4*)src + lane; f32x4 v[4]; float ss = 0.f;
#pragma unroll
    for (int j = 0; j < 4; ++j) { v[j] = xr[64 * j]; ss += (v[j].x * v[j].x + v[j].y * v[j].y) + (v[j].z * v[j].z + v[j].w * v[j].w); }
    const float rstd = 1.0f / sqrtf(wave_sum(ss) * (1.0f / 1024.0f) + NORM_EPS);
#pragma unroll
    for (int j = 0; j < 4; ++j) { const f32x4 g = *(const LAS f32x4*)(GS + 4 * lane + 256 * j), s = *(const LAS f32x4*)(SH + 4 * lane + 256 * j);
        const f32x4 y = (v[j] * rstd) * g + s; v2u o; o.x = pk2(y.x, y.y); o.y = pk2(y.z, y.w);
        *(v2u*)(dst + 4 * lane + 256 * j) = o; }
}
__device__ __forceinline__ void p1_norm(const Args& a, Frame& F) {
    const float* MODP = (const float*)(a.ws + WS_MODP); float* MOD = (float*)(a.ws + WS_MOD); bf16* XN = (bf16*)(a.ws + WS_RB);
    const float* adab = a.in[I_ADAB]; const float* n1g = a.in[I_N1G];
    LAS float* GS = (LAS float*)F.lds; LAS float* SH = GS + 1024; LAS float* GSC = GS + 2048; LAS float* SHC = GS + 3072;
    for (int blk = F.bid; blk < 256; blk += F.G) {
        const int b = blk >> 5;
        for (int k = F.tid; k < 1024; k += NWAVES * 64) {
            float s_sh = adab[k], s_sc = adab[1024 + k], c_sh = s_sh, c_sc = s_sc;
#pragma unroll 4
            for (int ks = 0; ks < 16; ++ks) { const float* base = MODP + (size_t)ks * 9 * 6144;
                s_sh += base[b * 6144 + k]; s_sc += base[b * 6144 + 1024 + k]; c_sh += base[8 * 6144 + k]; c_sc += base[8 * 6144 + 1024 + k]; }
            const float g = n1g[k]; GS[k] = g * (1.0f + s_sc); SH[k] = s_sh; GSC[k] = g * (1.0f + c_sc); SHC[k] = c_sh;
        }
        if (F.tid < 216) { const int r = F.tid / 24, n = blk * 24 + F.tid % 24; float s = adab[n];
#pragma unroll 4
            for (int ks = 0; ks < 16; ++ks) s += MODP[((size_t)ks * 9 + r) * 6144 + n];
            MOD[r * 6144 + n] = s; }
        __syncthreads();
#pragma unroll 1
        for (int j = 0; j < 9; ++j) { const bool isctx = j == 8;
            const int row = isctx ? NTOK + blk * 8 + F.wave : blk * 64 + F.wave * 8 + j;
            const float* src = isctx ? a.in[I_CTX] + (size_t)(blk * 8 + F.wave) * 1024 : a.in[I_X] + (size_t)row * 1024;
            norm_row_mod(src, XN + (size_t)row * 1024, isctx ? GSC : GS, isctx ? SHC : SH, F.lane); }
        __syncthreads();
    }
}

__device__ __forceinline__ void ld8(const bf16* p, float (&f)[8]) { const v4u w = *(const v4u*)p;
    f[0] = bflo(w.x); f[1] = bfhi(w.x); f[2] = bflo(w.y); f[3] = bfhi(w.y); f[4] = bflo(w.z); f[5] = bfhi(w.z); f[6] = bflo(w.w); f[7] = bfhi(w.w); }
__device__ __forceinline__ v4u pack8(const float (&f)[8]) { v4u w; w.x = pk2(f[0], f[1]); w.y = pk2(f[2], f[3]); w.z = pk2(f[4], f[5]); w.w = pk2(f[6], f[7]); return w; }

__device__ __forceinline__ void yconv_item(const Args& a, Frame& F, int b, int r) {
    const bf16* Z = (const bf16*)(a.ws + WS_RA); bf16* Y = (bf16*)(a.ws + WS_RB); const float* scw = a.in[I_SCW];
    const int cg = F.tid & 63, c0 = cg * 8; const bool vert = cg >= 32; const int stride = vert ? 64 : 1;
    float wk[3][8];
#pragma unroll
    for (int k = 0; k < 3; ++k)
#pragma unroll
        for (int i = 0; i < 8; ++i) wk[k][i] = scw[k * 512 + c0 + i];
#pragma unroll 2
    for (int j = 0; j < 8; ++j) { const int w = (F.tid >> 6) + 8 * j, t = r * 64 + w;
        float acc[8];
#pragma unroll
        for (int i = 0; i < 8; ++i) acc[i] = 0.f;
#pragma unroll
        for (int k = 0; k < 3; ++k) { const int p = (vert ? r : w) + k - 1; const bool valid = p >= 0 && p < (vert ? 32 : 64);
            const int tn = valid ? t + (k - 1) * stride : t; const bf16* zr = Z + (size_t)(b * SEQ + tn) * DIN;
            float cv[8], vv[8]; ld8(zr + 2048 + c0, cv); ld8(zr + 1024 + c0, vv);
            const float m = valid ? 1.0f : 0.0f;
#pragma unroll
            for (int i = 0; i < 8; ++i) acc[i] += (wk[k][i] * m) * (cv[i] * vv[i]); }
        float bg[8]; ld8(Z + (size_t)(b * SEQ + t) * DIN + 1536 + c0, bg);
#pragma unroll
        for (int i = 0; i < 8; ++i) acc[i] *= bg[i];
        *(v4u*)(Y + (size_t)(b * SEQ + t) * 1024 + 512 + c0) = pack8(acc); }
}

constexpr int SC_XC = 0, SC_AB = 9216, SC_BB = 9216 + 32768, SC_SEG = 9216 + 65536, SC_HALL = SC_SEG + 4096;
template <bool PASS2>
__device__ __forceinline__ void scan_range(const Args& a, Frame& F, int b, int h, int vc0, int nvc) {
    const int tid = F.tid, lane = F.lane, wave = F.wave;
    LAS bf16* XC = (LAS bf16*)(F.lds + SC_XC);
    LAS float* AB = (LAS float*)(F.lds + SC_AB);
    LAS float* BB = (LAS float*)(F.lds + SC_BB);
    LAS float* SEG = (LAS float*)(F.lds + SC_SEG);
    LAS float* HALL = (LAS float*)(F.lds + SC_HALL);
    const bf16* Z = (const bf16*)(a.ws + WS_RA); const bf16* Zc = (const bf16*)(a.ws + WS_ZC);
    const bf16* WrgT = (const bf16*)(a.ws + WS_WRG); float* AGG = (float*)(a.ws + WS_AGG); bf16* Y = (bf16*)(a.ws + WS_RB);
    const int d = wave >> 2, chh = (wave >> 1) & 1, shf = wave & 1, r = lane & 31, hh = lane >> 5;
    bf16x8 br[4], bi[4];
    { const bf16* wr_ = WrgT + (size_t)(h * 256 + d * 128 + chh * 32 + r) * 64 + hh * 8;
#pragma unroll
      for (int ks = 0; ks < 4; ++ks) { br[ks] = *(const bf16x8*)(wr_ + ks * 16); bi[ks] = *(const bf16x8*)(wr_ + 64 * 64 + ks * 16); } }
    const int ch = chh * 32 + r, gch = d * 512 + h * 64 + ch;
    const float ba = a.in[I_RGBA][gch] * -1.4426950408889634f, bx = a.in[I_RGBX][gch] * -1.4426950408889634f;
    const float Kc = -8.0f * 1.4426950408889634f * log1pf(expf(-a.in[I_RGLAM][gch]));
    const int cs = tid >> 3, ig = tid & 7, col = h * 64 + ig * 8;
    float cwv[4][8], cbv[8];
#pragma unroll
    for (int i = 0; i < 8; ++i) { cbv[i] = a.in[I_RCB][col + i];
#pragma unroll
        for (int k = 0; k < 4; ++k) cwv[k][i] = a.in[I_RCW][k * 512 + col + i]; }
    const int d2 = tid >> 8, seg = (tid >> 6) & 3, c = tid & 63;
    if (PASS2 && tid < 128) {
        const int dd = tid >> 6, cc = tid & 63; const float* ag = AGG + ((size_t)b * 36 * 2 + dd) * 1024 + (h * 64 + cc) * 2;
        float pv[36], sv[36];
#pragma unroll
        for (int k = 0; k < 36; ++k) { pv[k] = ag[(size_t)k * 2048]; sv[k] = ag[(size_t)k * 2048 + 1]; }
        float hc = 0.0f;
        if (dd == 0) {
#pragma unroll
            for (int k = 0; k < 36; ++k) { const int t = k - vc0; if (t >= 0 && t < nvc) HALL[(t * 2 + 0) * 64 + cc] = hc; hc = pv[k] * hc + sv[k]; }
        } else {
#pragma unroll
            for (int k = 3; k >= 0; --k) hc = pv[k] * hc + sv[k];
#pragma unroll
            for (int k = 35; k >= 4; --k) { const int t = k - vc0; if (t >= 0 && t < nvc) HALL[(t * 2 + 1) * 64 + cc] = hc; hc = pv[k] * hc + sv[k]; }
        }
    }
    v4u xq[4]; v4u gq = (v4u){0u, 0u, 0u, 0u}, gqn = gq;
    { const int vc = vc0; const bool isctx = vc < 4; const int s0 = isctx ? vc * 64 : (vc - 4) * 64, Ls = isctx ? CTXL : SEQ, pitch = isctx ? 512 : DIN;
      const bf16* src = isctx ? Zc + (size_t)b * CTXL * 512 : Z + (size_t)b * SEQ * DIN;
#pragma unroll
      for (int k = 0; k < 4; ++k) { const int sp = s0 + cs + k - 2; const int spc = (sp >= 0 && sp < Ls) ? sp : s0 + cs; xq[k] = *(const v4u*)(src + (size_t)spc * pitch + col); }
      if (PASS2) gq = *(const v4u*)(Z + ((size_t)b * SEQ + s0 + cs) * DIN + 512 + col); }
#pragma unroll 1
    for (int t = 0; t < nvc; ++t) {
        const int vc = vc0 + t; const bool isctx = vc < 4; const int s0 = isctx ? vc * 64 : (vc - 4) * 64, Ls = isctx ? CTXL : SEQ;
        { float acc[8];
#pragma unroll
          for (int i = 0; i < 8; ++i) acc[i] = cbv[i];
#pragma unroll
          for (int k = 0; k < 4; ++k) { const int sp = s0 + cs + k - 2; const float m = (sp >= 0 && sp < Ls) ? 1.0f : 0.0f;
              const v4u w = xq[k]; const float xv[8] = {bflo(w.x), bfhi(w.x), bflo(w.y), bfhi(w.y), bflo(w.z), bfhi(w.z), bflo(w.w), bfhi(w.w)};
#pragma unroll
              for (int i = 0; i < 8; ++i) acc[i] += (cwv[k][i] * m) * xv[i]; }
          *(LAS v4u*)(XC + cs * 72 + ig * 8) = pack8(acc); }
        if (t + 1 < nvc) { const int vn = vc + 1; const bool cx = vn < 4; const int s0n = cx ? vn * 64 : (vn - 4) * 64, Lsn = cx ? CTXL : SEQ, pitch = cx ? 512 : DIN;
            const bf16* src = cx ? Zc + (size_t)b * CTXL * 512 : Z + (size_t)b * SEQ * DIN;
#pragma unroll
            for (int k = 0; k < 4; ++k) { const int sp = s0n + cs + k - 2; const int spc = (sp >= 0 && sp < Lsn) ? sp : s0n + cs; xq[k] = *(const v4u*)(src + (size_t)spc * pitch + col); }
            if (PASS2) gqn = *(const v4u*)(Z + ((size_t)b * SEQ + s0n + cs) * DIN + 512 + col); }
        __syncthreads();
        { f32x16 accr, acci;
#pragma unroll
          for (int i = 0; i < 16; ++i) { accr[i] = 0.f; acci[i] = 0.f; }
#pragma unroll
          for (int ks = 0; ks < 4; ++ks) {
              const bf16x8 af = *(const LAS bf16x8*)(XC + (shf * 32 + r) * 72 + ks * 16 + hh * 8);
              accr = __builtin_amdgcn_mfma_f32_32x32x16_bf16(af, br[ks], accr, 0, 0, 0);
              acci = __builtin_amdgcn_mfma_f32_32x32x16_bf16(af, bi[ks], acci, 0, 0, 0); }
#pragma unroll
          for (int reg = 0; reg < 16; ++reg) { const int s = shf * 32 + (reg & 3) + 8 * (reg >> 2) + 4 * hh;
              const float rr = __builtin_amdgcn_rcpf(1.0f + __builtin_amdgcn_exp2f(fmaf(accr[reg], -1.4426950408889634f, ba)));
              const float ii = __builtin_amdgcn_rcpf(1.0f + __builtin_amdgcn_exp2f(fmaf(acci[reg], -1.4426950408889634f, bx)));
              const float av = __builtin_amdgcn_exp2f(Kc * rr);
              const float xcv = __uint_as_float((unsigned)XC[s * 72 + ch] << 16);
              const float bv = __builtin_amdgcn_sqrtf(fmaxf(fmaf(-av, av, 1.0f), 0.0f)) * (ii * xcv);
              AB[(d * 64 + s) * 64 + ch] = av; BB[(d * 64 + s) * 64 + ch] = bv; } }
        __syncthreads();
        float av16[16], bv16[16];
        { float P = 1.0f, Sv = 0.0f;
#pragma unroll
          for (int j = 0; j < 16; ++j) { const int vs = seg * 16 + j, s = d2 ? 63 - vs : vs; av16[j] = AB[(d2 * 64 + s) * 64 + c]; bv16[j] = BB[(d2 * 64 + s) * 64 + c]; }
#pragma unroll
          for (int j = 0; j < 16; ++j) { Sv = av16[j] * Sv + bv16[j]; P *= av16[j]; }
          SEG[((d2 * 4 + seg) * 64 + c) * 2 + 0] = P; SEG[((d2 * 4 + seg) * 64 + c) * 2 + 1] = Sv; }
        __syncthreads();
        if (!PASS2) {
            if (seg == 0) { float Pt = 1.0f, St = 0.0f;
#pragma unroll
                for (int k = 0; k < 4; ++k) { const float p = SEG[((d2 * 4 + k) * 64 + c) * 2], sg = SEG[((d2 * 4 + k) * 64 + c) * 2 + 1]; St = p * St + sg; Pt *= p; }
                float* ag = AGG + (((size_t)b * 36 + vc) * 2 + d2) * 1024 + (h * 64 + c) * 2; ag[0] = Pt; ag[1] = St; }
        } else {
            float hv = HALL[(t * 2 + d2) * 64 + c];
            for (int k = 0; k < seg; ++k) { const float p = SEG[((d2 * 4 + k) * 64 + c) * 2], sg = SEG[((d2 * 4 + k) * 64 + c) * 2 + 1]; hv = p * hv + sg; }
#pragma unroll
            for (int j = 0; j < 16; ++j) { const int vs = seg * 16 + j, s = d2 ? 63 - vs : vs; hv = av16[j] * hv + bv16[j]; BB[(d2 * 64 + s) * 64 + c] = hv; }
            __syncthreads();
            { const size_t trow = (size_t)b * SEQ + s0 + cs;
              const float g[8] = {bflo(gq.x), bfhi(gq.x), bflo(gq.y), bfhi(gq.y), bflo(gq.z), bfhi(gq.z), bflo(gq.w), bfhi(gq.w)}; float o[8];
              const f32x4 h0a = *(const LAS f32x4*)(BB + (0 * 64 + cs) * 64 + ig * 8), h0b = *(const LAS f32x4*)(BB + (0 * 64 + cs) * 64 + ig * 8 + 4);
              const f32x4 h1a = *(const LAS f32x4*)(BB + (1 * 64 + cs) * 64 + ig * 8), h1b = *(const LAS f32x4*)(BB + (1 * 64 + cs) * 64 + ig * 8 + 4);
              const float hs[8] = {h0a.x + h1a.x, h0a.y + h1a.y, h0a.z + h1a.z, h0a.w + h1a.w, h0b.x + h1b.x, h0b.y + h1b.y, h0b.z + h1b.z, h0b.w + h1b.w};
#pragma unroll
              for (int i = 0; i < 8; ++i) { const float z = g[i] + 0.044715f * g[i] * g[i] * g[i];
                  const float ge = g[i] * __builtin_amdgcn_rcpf(1.0f + __builtin_amdgcn_exp2f(-1.5957691216057308f * 1.4426950408889634f * z));
                  o[i] = ge * hs[i]; }
              *(v4u*)(Y + trow * 1024 + col) = pack8(o); }
            gq = gqn;
        }
    }
    __syncthreads();
}

template <int CTRL> __device__ __forceinline__ float dppf(float x) { return __builtin_bit_cast(float, __builtin_amdgcn_update_dpp(0, __builtin_bit_cast(int, x), CTRL, 0xF, 0xF, true)); }
__device__ __forceinline__ float xrow_sum(float s) {
    { unsigned a = __builtin_bit_cast(unsigned, s), b = a; asm volatile("v_nop\n\tv_nop\n\tv_permlane16_swap_b32 %0, %1" : "+v"(a), "+v"(b)); s = __builtin_bit_cast(float, a) + __builtin_bit_cast(float, b); }
    { unsigned a = __builtin_bit_cast(unsigned, s), b = a; asm volatile("v_nop\n\tv_nop\n\tv_permlane32_swap_b32 %0, %1" : "+v"(a), "+v"(b)); s = __builtin_bit_cast(float, a) + __builtin_bit_cast(float, b); }
    return s;
}
__device__ __forceinline__ float wave_sum_dpp(float s) {
    s += dppf<0xB1>(s); s += dppf<0x4E>(s); s += dppf<0x141>(s); s += dppf<0x128>(s); return xrow_sum(s);
}
__device__ __forceinline__ float red8(const float (&p)[8], int lane) {
    const bool b2 = lane & 4, e0 = ((lane ^ (lane >> 2)) & 1) != 0, e1 = (((lane >> 1) ^ (lane >> 2)) & 1) != 0;
    float q[4], r2[2];
#pragma unroll
    for (int i = 0; i < 4; ++i) { const float keep = e0 ? p[i + 4] : p[i], send = e0 ? p[i] : p[i + 4]; q[i] = keep + dppf<0xB1>(send); }
#pragma unroll
    for (int i = 0; i < 2; ++i) { const float keep = e1 ? q[i + 2] : q[i], send = e1 ? q[i] : q[i + 2]; r2[i] = keep + dppf<0x4E>(send); }
    float s; { const float keep = b2 ? r2[1] : r2[0], send = b2 ? r2[0] : r2[1]; s = keep + dppf<0x141>(send); }
    s += dppf<0x128>(s);
    return xrow_sum(s);
}
__device__ __forceinline__ void p6_route(const Args& a, Frame& F, bool commit) {
    const float* X1 = a.out; const float* MOD = (const float*)(a.ws + WS_MOD); const float* WrT = (const float*)(a.ws + WS_WRT);
    unsigned char* ML = a.ws + WS_RB; int* SLOT = (int*)(a.ws + WS_SLOT); float* GATEW = (float*)(a.ws + WS_GATEW); unsigned* CNT = (unsigned*)(a.ws + WS_CTL) + CW_CNT;
    const float* n2g = a.in[I_N2G]; const float* rgb = a.in[I_RGRB]; const float* reb = a.in[I_REB];
    const int lane = F.lane;
    LAS float* LG = (LAS float*)(F.lds + F.wave * 2048);
    LAS float* WL = (LAS float*)(F.lds + 16384);
    if (F.bid == 0 && F.tid < 64) *(v4u*)(ML + (size_t)NTOK * 1024 + F.tid * 16) = (v4u){0u, 0u, 0u, 0u};
    for (int base = F.bid; base < NTOK / 64; base += F.G) {
        const int row0 = (base * NWAVES + F.wave) * 8, b = row0 >> 11;
        f32x4 v[8][4]; float ss[8];
#pragma unroll
        for (int r = 0; r < 8; ++r) { ss[r] = 0.f;
#pragma unroll
            for (int j = 0; j < 4; ++j) { v[r][j] = *(const f32x4*)(X1 + (size_t)(row0 + r) * 1024 + 4 * lane + 256 * j);
                ss[r] += (v[r][j].x * v[r][j].x + v[r][j].y * v[r][j].y) + (v[r][j].z * v[r][j].z + v[r][j].w * v[r][j].w); } }
#pragma unroll
        for (int r = 0; r < 8; ++r) ss[r] = 1.0f / sqrtf(wave_sum_dpp(ss[r]) * (1.0f / 1024.0f) + NORM_EPS);
#pragma unroll
        for (int j = 0; j < 4; ++j) { const int col = 4 * lane + 256 * j;
            const f32x4 gn = *(const f32x4*)(n2g + col), sc = *(const f32x4*)(MOD + (size_t)b * 6144 + 4096 + col), sh = *(const f32x4*)(MOD + (size_t)b * 6144 + 3072 + col);
            const f32x4 gs = gn * (sc + 1.0f);
#pragma unroll
            for (int r = 0; r < 8; ++r) { v[r][j] = (v[r][j] * ss[r]) * gs + sh; int o = __builtin_amdgcn_cvt_pk_fp8_f32(4.0f * v[r][j].x, 4.0f * v[r][j].y, 0, false); o = __builtin_amdgcn_cvt_pk_fp8_f32(4.0f * v[r][j].z, 4.0f * v[r][j].w, o, true);
                *(int*)(ML + (size_t)(row0 + r) * 1024 + col) = o; } }
        const int rid = 4 * ((lane ^ (lane >> 2)) & 1) + 2 * (((lane >> 1) ^ (lane >> 2)) & 1) + ((lane >> 2) & 1);
#pragma unroll 1
        for (int half = 0; half < 2; ++half) {
            __syncthreads();
#pragma unroll
            for (int i = 0; i < 9; ++i) *(LAS f32x4*)(WL + 4 * (F.tid + 512 * i)) = *(const f32x4*)(WrT + half * 18432 + 4 * (F.tid + 512 * i));
            __syncthreads();
#pragma unroll 2
            for (int jj = 0; jj < 18; ++jj) { f32x4 w[4];
#pragma unroll
                for (int j = 0; j < 4; ++j) w[j] = *(const LAS f32x4*)(WL + jj * 1024 + 4 * lane + 256 * j);
                float p[8];
#pragma unroll
                for (int r = 0; r < 8; ++r) { f32x4 q = v[r][0] * w[0]; q = v[r][1] * w[1] + q; q = v[r][2] * w[2] + q; q = v[r][3] * w[3] + q; p[r] = (q.x + q.y) + (q.z + q.w); }
                const int jo = half * 18 + jj;
                const float tot = red8(p, lane) + (jo < 4 ? rgb[jo] : reb[jo - 4]);
                if (lane < 8) LG[rid * 36 + jo] = tot; }
        }
        LDS_WAIT(); asm volatile("" ::: "memory");
        float lg[36];
#pragma unroll
        for (int jj = 0; jj < 36; ++jj) lg[jj] = LG[(lane < 8 ? rid : 0) * 36 + jj];
        int grp = 0; float gm = lg[0];
#pragma unroll
        for (int j = 1; j < 4; ++j) if (lg[j] > gm) { gm = lg[j]; grp = j; }
        float gz = 0.f;
#pragma unroll
        for (int j = 0; j < 4; ++j) gz += __expf(lg[j] - gm);
        const float pg = 1.0f / gz;
        float el[8];
#pragma unroll
        for (int i = 0; i < 8; ++i) el[i] = grp == 0 ? lg[4 + i] : grp == 1 ? lg[12 + i] : grp == 2 ? lg[20 + i] : lg[28 + i];
        int i1 = 0; float m1 = el[0];
#pragma unroll
        for (int i = 1; i < 8; ++i) if (el[i] > m1) { m1 = el[i]; i1 = i; }
        int i2 = -1; float m2 = -3.0e38f;
#pragma unroll
        for (int i = 0; i < 8; ++i) if (i != i1 && el[i] > m2) { m2 = el[i]; i2 = i; }
        const float e2 = __expf(m2 - m1), den = 1.0f / (1.0f + e2);
        if (lane < 8 && commit) { const int tok = row0 + rid;
            const int ea = grp * 8 + i1, eb = grp * 8 + i2;
            const unsigned pa = __hip_atomic_fetch_add(CNT + 64 * ea, 1u, RLX_AGENT); SLOT[ea * 16384 + pa] = tok * 2;     GATEW[tok * 2] = pg * den;
            const unsigned pb = __hip_atomic_fetch_add(CNT + 64 * eb, 1u, RLX_AGENT); SLOT[eb * 16384 + pb] = tok * 2 + 1; GATEW[tok * 2 + 1] = pg * e2 * den; }
    }
    __syncthreads();
}

__device__ __forceinline__ void build_tiles(const Args& a, Frame& F) {
    LAS int* T = (LAS int*)(F.lds + TBL_OFF); unsigned* CNT = (unsigned*)(a.ws + WS_CTL) + CW_CNT;
    if (F.tid < 32) T[F.tid] = (int)__hip_atomic_load(CNT + 64 * F.tid, RLX_AGENT);
    __syncthreads();
    if (F.tid == 0) { int acc = 0;
        for (int e = 0; e < 32; ++e) { const int n = (T[e] + 255) >> 8; T[32 + e] = acc; for (int t = 0; t < n; ++t) T[96 + acc + t] = e; acc += n; }
        T[64] = acc; }
    __syncthreads();
}
constexpr int ROWTAB_OFF = TBL_OFF + 1024;
template <bool GATHER, class Sched>
__device__ __forceinline__ void build_rowtab(const Args& a, Frame& F, const Sched& S) {
    const LAS int* T = (const LAS int*)(F.lds + TBL_OFF); LAS int* RT = (LAS int*)(F.lds + ROWTAB_OFF); const int* SLOT = (const int*)(a.ws + WS_SLOT);
    pg8::Unit u;
    for (int i = 0; i < 4 && S.next(i, u); ++i)
        if (F.tid < 256) { const int e = u.pn >> 2, pos = (u.pm - T[32 + e]) * 256 + F.tid;
            RT[i * 256 + F.tid] = GATHER ? (pos < T[e] ? (SLOT[e * 16384 + pos] >> 1) : NTOK) : u.pm * 256 + F.tid; }
    __syncthreads();
}
__device__ __forceinline__ void p10_final(const Args& a, Frame& F, bool commit) {
    float* X1 = a.out; float* OUT = commit ? a.out : (float*)(a.ws + WS_RA); const float* MOD = (const float*)(a.ws + WS_MOD); const bf16* YA = (const bf16*)(a.ws + WS_YA); const float* fng = a.in[I_FNG];
    const int lane = F.lane;
    for (int t = F.bid * NWAVES + F.wave; t < NTOK; t += F.G * NWAVES) {
        const int b = t >> 11; f32x4 v[4]; float ss = 0.f;
#pragma unroll
        for (int j = 0; j < 4; ++j) { const int col = 4 * lane + 256 * j;
            const f32x4 x = *(const f32x4*)(X1 + (size_t)t * 1024 + col), g2 = *(const f32x4*)(MOD + (size_t)b * 6144 + 5120 + col);
            const v2u ya = *(const v2u*)(YA + (size_t)(2 * t) * 1024 + col), yb = *(const v2u*)(YA + (size_t)(2 * t + 1) * 1024 + col);
            f32x4 y; y.x = bflo(ya.x) + bflo(yb.x); y.y = bfhi(ya.x) + bfhi(yb.x); y.z = bflo(ya.y) + bflo(yb.y); y.w = bfhi(ya.y) + bfhi(yb.y);
            v[j] = x + g2 * y; ss += (v[j].x * v[j].x + v[j].y * v[j].y) + (v[j].z * v[j].z + v[j].w * v[j].w); }
        const float rstd = 1.0f / sqrtf(wave_sum(ss) * (1.0f / 1024.0f) + NORM_EPS);
#pragma unroll
        for (int j = 0; j < 4; ++j) { const int col = 4 * lane + 256 * j; const f32x4 g = *(const f32x4*)(fng + col);
            *(f32x4*)(OUT + (size_t)t * 1024 + col) = (v[j] * rstd) * g; }
    }
}

__global__ void __launch_bounds__(NWAVES * 64, 2) mk_fwd(Args a) {
    extern __shared__ __attribute__((aligned(16))) unsigned char lds_raw[];
    Frame F; F.lds = (LAS unsigned char*)lds_raw; F.tid = threadIdx.x; F.lane = F.tid & 63; F.wave = __builtin_amdgcn_readfirstlane(F.tid >> 6); F.G = gridDim.x; F.bid = blockIdx.x;
    for (int u = F.tid; u < (LDS_BYTES - LDSCTL_OFF) / 4; u += NWAVES * 64) ((LAS unsigned*)(F.lds + LDSCTL_OFF))[u] = 0u;
    __syncthreads();
    const int lo = a.ph_lo, hi = a.ph_hi;
    XcdBarrier bar; bar.bar = (unsigned*)(a.ws + WS_CTL) + CW_BAR; bar.x = 0; bar.st = nullptr;
    if (hi - lo > 1) bar = xcd_barrier_post((unsigned*)(a.ws + WS_CTL) + CW_BAR, (volatile LAS unsigned*)(F.lds + LDSCTL_OFF) + 8);
#ifndef PHMASK
#define PHMASK 0x7ff
#endif
#define IN(k) (((PHMASK >> (k)) & 1) && lo <= (k) && (k) < hi)
#define SEAM(k) do { if (IN(k) && IN((k) + 1)) xcd_barrier(bar); } while (0)
#ifndef PROBE_REP
#define PROBE_REP (-1)
#endif
#ifndef PROBE_N
#define PROBE_N 3
#endif
#ifndef PROBE_T
#define PROBE_T (-1)
#endif
#define TBEG(k) unsigned long long tb_ = 0; if (PROBE_T == (k) || PROBE_T == 99) tb_ = __builtin_amdgcn_s_memrealtime();
#define TEND(k) if (PROBE_T == (k) || PROBE_T == 99) { const unsigned long long te_ = __builtin_amdgcn_s_memrealtime(); while (__builtin_amdgcn_s_memrealtime() - te_ < te_ - tb_) __builtin_amdgcn_s_sleep(8); }
#define REPS(k) for (int rep_ = 0; rep_ < ((PROBE_REP == (k)) ? PROBE_N : 1); ++rep_)

    if (IN(0)) { TBEG(0) REPS(0) { p0_prep(a, F); } TEND(0) } SEAM(0);
    if (IN(1)) { TBEG(1) REPS(1) { p1_norm(a, F); } TEND(1) } SEAM(1);
    if (IN(2)) { TBEG(2) { {
        pg8::Gemm g{(const bf16*)(a.ws + WS_RB), (const bf16*)(a.ws + WS_WIN), NTOK + NCTX, DIN, DM}; pg8::OrderInProj S{F.G, F.bid};
        pg8::EpiInProj E{(bf16*)(a.ws + WS_RA), (bf16*)(a.ws + WS_ZC)};
        pg8::gemm_phase<pg8::EpiInProj, pg8::OrderInProj, true, true>(F.lds, g, S, E); }
    if (PROBE_REP == 2) {
        pg8::Gemm g{(const bf16*)(a.ws + WS_RB), (const bf16*)(a.ws + WS_WIN), NTOK + NCTX, DIN, DM}; pg8::OrderInProj S{F.G, F.bid};
        pg8::EpiInProj E{(bf16*)(a.ws + WS_RA), (bf16*)(a.ws + WS_ZC)};
        pg8::gemm_phase<pg8::EpiInProj, pg8::OrderInProj, true, true>(F.lds, g, S, E); } }
    TEND(2) } SEAM(2);
    if (IN(3)) { TBEG(3) REPS(3) {
        for (int it = F.bid; it < 256; it += F.G) yconv_item(a, F, it >> 5, it & 31);
        for (int w = F.bid; w < 256; w += F.G) { const int bh = w >> 2; scan_range<false>(a, F, bh >> 3, bh & 7, 9 * (w & 3), 9); } }
    TEND(3) } SEAM(3);
    if (IN(4)) { TBEG(4) REPS(4) {
        for (int w = F.bid; w < 256; w += F.G) { const int bh = w >> 2; scan_range<true>(a, F, bh >> 3, bh & 7, 4 + 8 * (w & 3), 8); } }
    TEND(4) } SEAM(4);
    if (IN(5)) { TBEG(5) REPS(5) {
        pg8::Gemm g{(const bf16*)(a.ws + WS_RB), (const bf16*)(a.ws + WS_WOUT), NTOK, DM, DM}; pg8::StaticOrder S; S.init(NTOK, DM, F.G, F.bid);
        pg8::EpiOutProj E{a.in[I_X], a.out, (const float*)(a.ws + WS_MOD)};
        pg8::gemm_phase<pg8::EpiOutProj, pg8::StaticOrder, true, true>(F.lds, g, S, E); }
    TEND(5) } SEAM(5);
    if (IN(6)) { TBEG(6) REPS(6) { p6_route(a, F, rep_ == ((PROBE_REP == 6) ? PROBE_N : 1) - 1); } TEND(6) } if (IN(6) && IN(8)) xcd_barrier(bar);
    if (IN(8)) { TBEG(8) {
        build_tiles(a, F); const LAS int* T = (const LAS int*)(F.lds + TBL_OFF);
        pg8::Gemm g{(const bf16*)(a.ws + WS_RB), (const bf16*)(a.ws + WS_WGU), 0, 0, DM}; pg8::OrderMoE S{F.G, F.bid, T[64] * 4, T + 96};
        build_rowtab<true>(a, F, S);
        pg8::EpiGateUp E{a.ws + WS_RA};
        pg8::gemm_phase_g<pg8::EpiGateUp, pg8::OrderMoE, true, true>(F.lds, g, S, E, (const LAS int*)(F.lds + ROWTAB_OFF));
        if (PROBE_REP == 8) pg8::gemm_phase_g<pg8::EpiGateUp, pg8::OrderMoE, true, true>(F.lds, g, S, E, (const LAS int*)(F.lds + ROWTAB_OFF)); }
    TEND(8) } SEAM(8);
    if (IN(9)) { TBEG(9) {
        build_tiles(a, F); const LAS int* T = (const LAS int*)(F.lds + TBL_OFF);
        pg8::Gemm g{(const bf16*)(a.ws + WS_RA), (const bf16*)(a.ws + WS_WD), 0, 0, 512}; pg8::OrderMoE S{F.G, F.bid, T[64] * 4, T + 96};
        build_rowtab<false>(a, F, S);
        pg8::EpiDown E{(bf16*)(a.ws + WS_YA), (const int*)(a.ws + WS_SLOT), (const float*)(a.ws + WS_GATEW), T};
        pg8::gemm_phase_g<pg8::EpiDown, pg8::OrderMoE, true, true>(F.lds, g, S, E, (const LAS int*)(F.lds + ROWTAB_OFF));
        if (PROBE_REP == 9) pg8::gemm_phase_g<pg8::EpiDown, pg8::OrderMoE, true, true>(F.lds, g, S, E, (const LAS int*)(F.lds + ROWTAB_OFF)); }
    TEND(9) } SEAM(9);
    if (IN(10)) { TBEG(10) REPS(10) { p10_final(a, F, rep_ == ((PROBE_REP == 10) ? PROBE_N : 1) - 1); }
    TEND(10) }
#undef IN
#undef SEAM
}

extern "C" void kernel_launch(void* const* d_in, const int* in_sizes, int n_in, void* d_out, int out_size, void* d_ws, size_t ws_size, hipStream_t stream) {
    static int grid = 0;
    if (grid == 0) {
        if (n_in != N_IN || out_size != NTOK * DM || ws_size < WS_END) { fprintf(stderr, "kernel_launch: unexpected shapes: n_in %d out %d ws %zu (need %zu)\n", n_in, out_size, ws_size, (size_t)WS_END); grid = -1; return; }
        int dev = 0, cus = 0, per_cu = 0;
        if (hipGetDevice(&dev) != hipSuccess || hipDeviceGetAttribute(&cus, hipDeviceAttributeMultiprocessorCount, dev) != hipSuccess) { grid = -1; return; }
        if (hipFuncSetAttribute((const void*)mk_fwd, hipFuncAttributeMaxDynamicSharedMemorySize, LDS_BYTES) != hipSuccess) { fprintf(stderr, "kernel_launch: hipFuncSetAttribute failed\n"); grid = -1; return; }
        if (hipOccupancyMaxActiveBlocksPerMultiprocessor(&per_cu, (const void*)mk_fwd, NWAVES * 64, LDS_BYTES) != hipSuccess || per_cu < 1) { fprintf(stderr, "kernel_launch: occupancy query says %d blocks per CU\n", per_cu); (void)hipGetLastError(); grid = -1; return; }
        grid = cus;
        if (grid > 256) grid = 256;
    }
    if (grid < 0) return;
    (void)hipMemsetAsync((char*)d_ws + WS_CTL, 0, CTL_ZERO_BYTES, stream);
    Args a{};
    for (int i = 0; i < N_IN; ++i) a.in[i] = (const float*)d_in[i];
    a.out = (float*)d_out; a.ws = (unsigned char*)d_ws;
    if (MK_N_LAUNCHES == 1) {
        a.ph_lo = 0; a.ph_hi = N_PHASES;
        void* args[] = {&a};
        hipError_t e = hipLaunchCooperativeKernel((const void*)mk_fwd, dim3(grid), dim3(NWAVES * 64), args, LDS_BYTES, stream);
        if (e != hipSuccess) fprintf(stderr, "kernel_launch: cooperative launch failed: %s (grid %d)\n", hipGetErrorString(e), grid);
    } else {
        for (int p = 0; p < N_PHASES; ++p) { a.ph_lo = p; a.ph_hi = p + 1; hipLaunchKernelGGL(mk_fwd, dim3(grid), dim3(NWAVES * 64), LDS_BYTES, stream, a); }
    }
}
```

```cpp
#define MK_N_LAUNCHES 1
#include <hip/hip_runtime.h>
#include <cstdio>
#include <cstdint>
namespace pg8 {
#define PG8_LAS __attribute__((address_space(3)))
typedef unsigned short bf16_t;
typedef short bf16x8 __attribute__((ext_vector_type(8)));
typedef float f32x4 __attribute__((ext_vector_type(4)));
typedef unsigned u32x4 __attribute__((ext_vector_type(4)));
constexpr int BM = 256, BK = 64, HALF = 128, HTB = HALF * BK * 2  , STAGE_BYTES = 8 * HTB, NXCD = 8, WGM = 8;

__host__ __device__ __forceinline__ int lds_byte(int r, int c) { const int st = (r >> 4) * 2 + (c >> 5), rr = r & 15, cc = c & 31, ob = rr * 64 + cc * 2; return st * 1024 + (ob ^ (((ob >> 9) & 1) << 5)); }
__host__ __device__ __forceinline__ void stage_rc(int b, int& R, int& C) { const int st = b / 1024, sb = b % 1024, swz = sb ^ (((sb >> 9) & 1) << 5); R = (st >> 1) * 16 + swz / 64; C = (st & 1) * 32 + (swz % 64) / 2; }
__host__ __device__ __forceinline__ int perm32(int rho) { const int n = rho >> 4, i = rho & 15; return 8 * (i >> 2) + 4 * n + (i & 3); }

struct Unit { int pm, pn; };
struct Gemm { const bf16_t* A; const bf16_t* Bt; int M, N, K; };

struct StaticOrder {
    int nM, nN, nwg, G, c;
    __host__ __device__ void init(int M, int N, int G_, int c_) { nM = M / BM; nN = N / BM; nwg = nM * nN; G = G_; c = c_; }
    __host__ __device__ bool next(int i, Unit& u) const {
        const long L = (long)i * G + c; if (L >= nwg) return false;
        int wgid = (int)L; { const int q = nwg / NXCD, r = nwg % NXCD, xcd = wgid % NXCD, off = wgid / NXCD; wgid = (xcd < r ? xcd * (q + 1) : r * (q + 1) + (xcd - r) * q) + off; }
        const int nig = WGM * nN, gid = wgid / nig, fm = gid * WGM, gsz = (nM - fm) < WGM ? (nM - fm) : WGM;
        u.pm = fm + ((wgid % nig) % gsz); u.pn = (wgid % nig) / gsz; return true;
    }
    __device__ __forceinline__ void a_ready(const Unit&) const {}
    __device__ __forceinline__ void done(const Unit&) const {}
};
__device__ __forceinline__ unsigned cvt_pk_bf16(float lo, float hi) { unsigned r; asm volatile("v_cvt_pk_bf16_f32 %0, %1, %2" : "=v"(r) : "v"(lo), "v"(hi)); return r; }
struct EpiInProj {
    static constexpr bool PERM = true, AFTER_DRAIN = false;
    bf16_t* Z; bf16_t* Zc;
    __device__ __forceinline__ void operator()(const f32x4 (&acc)[2][2][4][2], const Unit& u, int wr, int wc, int fr, int fq) const {
        const bool isctx = u.pm >= 64;
        bf16_t* base = isctx ? Zc : Z; const int ldc = isctx ? 512 : 2560; const int prow = isctx ? u.pm - 64 : u.pm;
        const int row0 = prow * BM + wr * 64 + fr, col0 = u.pn * BM + wc * 32 + 8 * fq;
#pragma unroll
        for (int ai = 0; ai < 2; ++ai)
#pragma unroll
            for (int m = 0; m < 4; ++m) { bf16_t* rowp = base + (size_t)(row0 + ai * HALF + m * 16) * ldc + col0;
#pragma unroll
                for (int bj = 0; bj < 2; ++bj) { const f32x4 v0 = acc[ai][bj][m][0], v1 = acc[ai][bj][m][1];
                    u32x4 w; w.x = cvt_pk_bf16(v0[0], v0[1]); w.y = cvt_pk_bf16(v0[2], v0[3]); w.z = cvt_pk_bf16(v1[0], v1[1]); w.w = cvt_pk_bf16(v1[2], v1[3]);
                    *(u32x4*)(rowp + bj * HALF) = w; } }
    }
};
struct EpiOutProj {
    static constexpr bool PERM = false, AFTER_DRAIN = false;
    const float* x; float* X1; const float* mod;
    __device__ __forceinline__ void operator()(const f32x4 (&acc)[2][2][4][2], const Unit& u, int wr, int wc, int fr, int fq) const {
        const int b = u.pm >> 3;
        const int row0 = u.pm * BM + wr * 64 + fr, col0 = u.pn * BM + wc * 32 + 4 * fq;
        f32x4 gv[2][2];
#pragma unroll
        for (int bj = 0; bj < 2; ++bj)
#pragma unroll
            for (int n = 0; n < 2; ++n) gv[bj][n] = *(const f32x4*)(mod + (size_t)b * 6144 + 2048 + col0 + bj * HALF + n * 16);
#pragma unroll
        for (int ai = 0; ai < 2; ++ai)
#pragma unroll
            for (int m = 0; m < 4; ++m) { const size_t off = (size_t)(row0 + ai * HALF + m * 16) * 1024 + col0;
#pragma unroll
                for (int bj = 0; bj < 2; ++bj)
#pragma unroll
                    for (int n = 0; n < 2; ++n) { const f32x4 xv = *(const f32x4*)(x + off + bj * HALF + n * 16);
                        *(f32x4*)(X1 + off + bj * HALF + n * 16) = xv + gv[bj][n] * acc[ai][bj][m][n]; } }
    }
};
__device__ __forceinline__ float silu_f(float g) { return g * __builtin_amdgcn_rcpf(1.0f + __builtin_amdgcn_exp2f(-1.4426950408889634f * g)); }
struct EpiGateUp {
    static constexpr bool PERM = true, AFTER_DRAIN = false;
    unsigned char* H;
    __device__ __forceinline__ void operator()(const f32x4 (&acc)[2][2][4][2], const Unit& u, int wr, int wc, int fr, int fq) const {
        const int row0 = u.pm * BM + wr * 64 + fr, col0 = (u.pn & 3) * 128 + wc * 32 + 8 * fq;
#pragma unroll
        for (int ai = 0; ai < 2; ++ai)
#pragma unroll
            for (int m = 0; m < 4; ++m) { unsigned char* rowp = H + (size_t)(row0 + ai * HALF + m * 16) * 512 + col0;
                const f32x4 g0 = acc[ai][0][m][0], g1 = acc[ai][0][m][1], u0 = acc[ai][1][m][0], u1 = acc[ai][1][m][1];
#define H8_(g, u) __builtin_amdgcn_fmed3f(4.0f * silu_f(g) * (u), -448.0f, 448.0f)
                int w0 = __builtin_amdgcn_cvt_pk_fp8_f32(H8_(g0[0], u0[0]), H8_(g0[1], u0[1]), 0, false);
                w0 = __builtin_amdgcn_cvt_pk_fp8_f32(H8_(g0[2], u0[2]), H8_(g0[3], u0[3]), w0, true);
                int w1 = __builtin_amdgcn_cvt_pk_fp8_f32(H8_(g1[0], u1[0]), H8_(g1[1], u1[1]), 0, false);
                w1 = __builtin_amdgcn_cvt_pk_fp8_f32(H8_(g1[2], u1[2]), H8_(g1[3], u1[3]), w1, true);
#undef H8_
                typedef int i32x2 __attribute__((ext_vector_type(2)));
                *(i32x2*)rowp = (i32x2){w0, w1}; }
    }
};
struct EpiDown {
    static constexpr bool PERM = true, AFTER_DRAIN = false;
    bf16_t* YA; const int* slot; const float* gatew; const PG8_LAS int* T;
    __device__ __forceinline__ void operator()(const f32x4 (&acc)[2][2][4][2], const Unit& u, int wr, int wc, int fr, int fq) const {
        const int e = u.pn >> 2, cnt = T[e], pos0 = (u.pm - T[32 + e]) * BM + wr * 64 + fr, col0 = (u.pn & 3) * BM + wc * 32 + 8 * fq;
        int asg[2][4];
#pragma unroll
        for (int ai = 0; ai < 2; ++ai)
#pragma unroll
            for (int m = 0; m < 4; ++m) { const int pos = pos0 + ai * HALF + m * 16; asg[ai][m] = pos < cnt ? slot[e * 16384 + pos] : -1; }
#pragma unroll
        for (int ai = 0; ai < 2; ++ai)
#pragma unroll
            for (int m = 0; m < 4; ++m) { const int as = asg[ai][m];
                if (as >= 0) { const float gw = gatew[as]; bf16_t* rowp = YA + (size_t)as * 1024 + col0;
#pragma unroll
                    for (int bj = 0; bj < 2; ++bj) { const f32x4 v0 = acc[ai][bj][m][0] * gw, v1 = acc[ai][bj][m][1] * gw;
                        u32x4 w; w.x = cvt_pk_bf16(v0[0], v0[1]); w.y = cvt_pk_bf16(v0[2], v0[3]); w.z = cvt_pk_bf16(v1[0], v1[1]); w.w = cvt_pk_bf16(v1[2], v1[3]);
                        *(u32x4*)(rowp + bj * HALF) = w; } } }
    }
};
struct OrderInProj {
    int G, c;
    __device__ __forceinline__ bool next(int i, Unit& u) const {
        const long L = (long)i * G + c; if (L >= 656) return false;
        if (L < 640) { int wgid = (int)L; const int xcd = wgid % NXCD, off = wgid / NXCD; wgid = xcd * 80 + off;
            const int nig = WGM * 10; const int fm = (wgid / nig) * WGM; u.pm = fm + ((wgid % nig) % WGM); u.pn = (wgid % nig) / WGM; }
        else { const int j = (int)L - 640; u.pm = 64 + (j >> 1); u.pn = j & 1; }
        return true;
    }
    __device__ __forceinline__ void a_ready(const Unit&) const {}
    __device__ __forceinline__ void done(const Unit&) const {}
};
struct OrderMoE {
    int G, c, NU; const PG8_LAS int* TE;
    __device__ __forceinline__ bool next(int i, Unit& u) const {
        const long L = (long)i * G + c; if (L >= NU) return false;
        const int q = NU / NXCD, r = NU % NXCD, xcd = (int)(L % NXCD), off = (int)(L / NXCD);
        const int id = (xcd < r ? xcd * (q + 1) : r * (q + 1) + (xcd - r) * q) + off;
        const int tile = id >> 2; u.pm = tile; u.pn = __builtin_amdgcn_readfirstlane(TE[tile]) * 4 + (id & 3); return true;
    }
    __device__ __forceinline__ void a_ready(const Unit&) const {}
    __device__ __forceinline__ void done(const Unit&) const {}
};
template <class Epi, class Sched, bool ALIGN_EPI = false, bool SP2 = false>
__device__ __forceinline__ void gemm_phase(PG8_LAS unsigned char* lds, const Gemm g, const Sched& S, const Epi& E) {
    const int tid = threadIdx.x, wid = __builtin_amdgcn_readfirstlane(tid >> 6), lane = tid & 63, wr = wid >> 2, wc = wid & 3, fr = lane & 15, fq = lane >> 4;
    const int K = g.K, nt = K / BK;
    unsigned voffA[2], voffB[2];
#pragma unroll
    for (int i = 0; i < 2; ++i) { int R, C; stage_rc(tid * 16 + i * 8192, R, C); const int Rb = Epi::PERM ? ((R & ~31) + perm32(R & 31)) : R;
        voffA[i] = (unsigned)(R * K + C) * 2u; voffB[i] = (unsigned)(Rb * K + C) * 2u; }
    const size_t kstep = (size_t)(BK * 2);
    const size_t hstep = (size_t)HALF * K * 2;
    const size_t tstep = 2 * hstep;
    const unsigned ldsw = (unsigned)wid * 1024u;
    const int aoff = lds_byte(wr * 64 + fr, fq * 8), boff = lds_byte(wc * 32 + fr, fq * 8);
#define PG8_SA(b, h) (((b) * 2 + (h)) * HTB)
#define PG8_SB(b, h) ((4 + (b) * 2 + (h)) * HTB)
#define PG8_STAGE(bufoff, gbase, voff) do { _Pragma("unroll") for (int _i = 0; _i < 2; ++_i) \
        __builtin_amdgcn_global_load_lds((const unsigned*)((const char*)(gbase) + (voff)[_i]), (PG8_LAS unsigned*)(lds + (bufoff) + ldsw + _i * 8192), 16, 0, 0); } while (0)
#define PG8_LDA(dst, b, h) do { _Pragma("unroll") for (int m = 0; m < 4; ++m) _Pragma("unroll") for (int k = 0; k < 2; ++k) dst[m][k] = *(const PG8_LAS bf16x8*)(lds + PG8_SA(b, h) + aoff + m * 2048 + k * 1024); } while (0)
#define PG8_LDB(dst, b, h) do { _Pragma("unroll") for (int n = 0; n < 2; ++n) _Pragma("unroll") for (int k = 0; k < 2; ++k) dst[n][k] = *(const PG8_LAS bf16x8*)(lds + PG8_SB(b, h) + boff + n * 2048 + k * 1024); } while (0)
#define PG8_MMA(ai, bj, At, Bt) do { __builtin_amdgcn_s_setprio(1); _Pragma("unroll") for (int m = 0; m < 4; ++m) _Pragma("unroll") for (int n = 0; n < 2; ++n) _Pragma("unroll") for (int k = 0; k < 2; ++k) \
        acc[ai][bj][m][n] = __builtin_amdgcn_mfma_f32_16x16x32_bf16(Bt[n][k], At[m][k], acc[ai][bj][m][n], 0, 0, 0); __builtin_amdgcn_s_setprio(0); } while (0)
#define PG8_WAIT_V(n) asm volatile("s_waitcnt vmcnt(" #n ")" ::: "memory")
#define PG8_WAIT_L(n) asm volatile("s_waitcnt lgkmcnt(" #n ")" ::: "memory")
#define PG8_BAR __builtin_amdgcn_s_barrier()
#define PG8_SCHED __builtin_amdgcn_sched_barrier(0)
    Unit cur, nxt; int ui = 0;
    if (!S.next(0, cur)) return;
    f32x4 acc[2][2][4][2];
#pragma unroll
    for (int a = 0; a < 2; ++a)
#pragma unroll
        for (int b = 0; b < 2; ++b)
#pragma unroll
            for (int m = 0; m < 4; ++m)
#pragma unroll
                for (int n = 0; n < 2; ++n) acc[a][b][m][n] = (f32x4){0.f, 0.f, 0.f, 0.f};
    bf16x8 At[4][2], B0[2][2], B1[2][2];
    const char* cA = (const char*)g.A + (size_t)cur.pm * tstep; const char* cB = (const char*)g.Bt + (size_t)cur.pn * tstep;
    S.a_ready(cur);
    if constexpr (SP2) {
        PG8_STAGE(PG8_SB(0, 0), cB, voffB); PG8_STAGE(PG8_SB(0, 1), cB + hstep, voffB); PG8_STAGE(PG8_SA(0, 0), cA, voffA); PG8_STAGE(PG8_SA(0, 1), cA + hstep, voffA);
        if (wr == 1) PG8_BAR;
        PG8_WAIT_V(2); PG8_BAR;
        PG8_STAGE(PG8_SB(1, 0), cB + kstep, voffB); PG8_STAGE(PG8_SA(1, 0), cA + kstep, voffA); PG8_STAGE(PG8_SB(1, 1), cB + hstep + kstep, voffB);
        PG8_WAIT_V(6); PG8_BAR;
    } else {
        PG8_STAGE(PG8_SB(0, 0), cB, voffB); PG8_STAGE(PG8_SA(0, 0), cA, voffA); PG8_STAGE(PG8_SB(0, 1), cB + hstep, voffB); PG8_STAGE(PG8_SA(0, 1), cA + hstep, voffA);
        if (wr == 1) PG8_BAR;
        PG8_WAIT_V(4); PG8_BAR;
        PG8_STAGE(PG8_SB(1, 0), cB + kstep, voffB); PG8_STAGE(PG8_SA(1, 0), cA + kstep, voffA); PG8_STAGE(PG8_SB(1, 1), cB + hstep + kstep, voffB);
        PG8_WAIT_V(6); PG8_BAR;
    }
    for (;;) {
        const bool has_next = S.next(ui + 1, nxt);
        const char* nA = has_next ? (const char*)g.A + (size_t)nxt.pm * tstep : cA; const char* nB = has_next ? (const char*)g.Bt + (size_t)nxt.pn * tstep : cB;
        for (int t = 0; t < nt; t += 2) {
            const bool last = (t == nt - 2);
            const char* a1 = cA + (size_t)(t + 1) * kstep;
            const char* a2 = last ? nA : cA + (size_t)(t + 2) * kstep; const char* b2 = last ? nB : cB + (size_t)(t + 2) * kstep;
            const char* a3 = a2 + kstep; const char* b3 = b2 + kstep;
            if (last && has_next) S.a_ready(nxt);
            if constexpr (SP2) {
            PG8_LDB(B0, 0, 0); PG8_LDB(B1, 0, 1); PG8_SCHED; PG8_LDA(At, 0, 0); PG8_STAGE(PG8_SA(1, 1), a1 + hstep, voffA);
            PG8_WAIT_V(8); PG8_WAIT_L(0); PG8_BAR; PG8_MMA(0, 0, At, B0); PG8_MMA(0, 1, At, B1); PG8_BAR; PG8_SCHED;
            PG8_LDA(At, 0, 1); PG8_STAGE(PG8_SB(0, 0), b2, voffB); PG8_STAGE(PG8_SB(0, 1), b2 + hstep, voffB); PG8_STAGE(PG8_SA(0, 0), a2, voffA);
            PG8_WAIT_V(8); PG8_WAIT_L(0); PG8_BAR; PG8_MMA(1, 0, At, B0); PG8_MMA(1, 1, At, B1); PG8_BAR; PG8_SCHED;
            PG8_LDB(B0, 1, 0); PG8_LDB(B1, 1, 1); PG8_SCHED; PG8_LDA(At, 1, 0); PG8_STAGE(PG8_SA(0, 1), a2 + hstep, voffA);
            PG8_WAIT_V(8); PG8_WAIT_L(0); PG8_BAR; PG8_MMA(0, 0, At, B0); PG8_MMA(0, 1, At, B1); PG8_BAR; PG8_SCHED;
            PG8_LDA(At, 1, 1); PG8_STAGE(PG8_SB(1, 0), b3, voffB); PG8_STAGE(PG8_SB(1, 1), b3 + hstep, voffB); PG8_STAGE(PG8_SA(1, 0), a3, voffA);
            PG8_WAIT_V(8); PG8_WAIT_L(0); PG8_BAR; PG8_MMA(1, 0, At, B0); PG8_MMA(1, 1, At, B1); PG8_BAR; PG8_SCHED;
            } else {
            PG8_LDB(B0, 0, 0); PG8_SCHED; PG8_LDA(At, 0, 0); PG8_STAGE(PG8_SA(1, 1), a1 + hstep, voffA);
            PG8_WAIT_L(8); PG8_BAR; PG8_WAIT_L(0); PG8_MMA(0, 0, At, B0); PG8_BAR; PG8_SCHED;
            PG8_LDB(B1, 0, 1); PG8_STAGE(PG8_SB(0, 0), b2, voffB);
            PG8_BAR; PG8_WAIT_L(0); PG8_MMA(0, 1, At, B1); PG8_BAR;
            PG8_LDA(At, 0, 1); PG8_STAGE(PG8_SA(0, 0), a2, voffA);
            PG8_BAR; PG8_WAIT_L(0); PG8_MMA(1, 0, At, B0); PG8_BAR; PG8_SCHED;
            PG8_STAGE(PG8_SB(0, 1), b2 + hstep, voffB);
            PG8_WAIT_V(6); PG8_BAR; PG8_MMA(1, 1, At, B1); PG8_BAR;
            PG8_LDB(B0, 1, 0); PG8_SCHED; PG8_LDA(At, 1, 0); PG8_STAGE(PG8_SA(0, 1), a2 + hstep, voffA);
            PG8_WAIT_L(8); PG8_BAR; PG8_WAIT_L(0); PG8_MMA(0, 0, At, B0); PG8_BAR; PG8_SCHED;
            PG8_LDB(B1, 1, 1); PG8_STAGE(PG8_SB(1, 0), b3, voffB);
            PG8_BAR; PG8_WAIT_L(0); PG8_MMA(0, 1, At, B1); PG8_BAR;
            PG8_LDA(At, 1, 1); PG8_STAGE(PG8_SA(1, 0), a3, voffA);
            PG8_BAR; PG8_WAIT_L(0); PG8_MMA(1, 0, At, B0); PG8_BAR; PG8_SCHED;
            PG8_STAGE(PG8_SB(1, 1), b3 + hstep, voffB);
            PG8_WAIT_V(6); PG8_BAR; PG8_MMA(1, 1, At, B1); PG8_BAR;
            }
        }
        if constexpr (ALIGN_EPI) { if (wr == 0) PG8_BAR; }
        if constexpr (!Epi::AFTER_DRAIN) { E(acc, cur, wr, wc, fr, fq); S.done(cur); }
        if (!has_next) break;
#pragma unroll
        for (int a = 0; a < 2; ++a)
#pragma unroll
            for (int b = 0; b < 2; ++b)
#pragma unroll
                for (int m = 0; m < 4; ++m)
#pragma unroll
                    for (int n = 0; n < 2; ++n) acc[a][b][m][n] = (f32x4){0.f, 0.f, 0.f, 0.f};
        cur = nxt; cA = nA; cB = nB; ++ui;
        if constexpr (ALIGN_EPI) { if (wr == 1) PG8_BAR; }
    }
    PG8_WAIT_V(0);
    if constexpr (!ALIGN_EPI) { if (wr == 0) PG8_BAR; }
    PG8_BAR;
    if constexpr (Epi::AFTER_DRAIN) { E.fused(acc, cur, wr, wc, fr, fq, lds, wid, lane); S.done(cur); }
#undef PG8_SA
#undef PG8_SB
#undef PG8_STAGE
#undef PG8_LDA
#undef PG8_LDB
#undef PG8_MMA
#undef PG8_WAIT_V
#undef PG8_WAIT_L
#undef PG8_BAR
#undef PG8_SCHED
}
typedef int i32x8 __attribute__((ext_vector_type(8)));
typedef int i32x4 __attribute__((ext_vector_type(4)));
__device__ __forceinline__ bf16x8 lo8(i32x8 v) { return __builtin_bit_cast(bf16x8, (i32x4){v[0], v[1], v[2], v[3]}); }
__device__ __forceinline__ bf16x8 hi8(i32x8 v) { return __builtin_bit_cast(bf16x8, (i32x4){v[4], v[5], v[6], v[7]}); }
constexpr int SCALE_A = 0x7D7D7D7D, SCALE_B = 0x7A7A7A7A;
template <class Epi, class Sched, bool ALIGN_EPI, bool F8 = false>
__device__ __forceinline__ void gemm_phase_g(PG8_LAS unsigned char* lds, const Gemm g, const Sched& S, const Epi& E, const PG8_LAS int* rowtab) {
    constexpr bool SP2 = true;
    const int tid = threadIdx.x, wid = __builtin_amdgcn_readfirstlane(tid >> 6), lane = tid & 63, wr = wid >> 2, wc = wid & 3, fr = lane & 15, fq = lane >> 4;
    const int K = g.K, nt = F8 ? K / 128 : K / BK;
    unsigned voffB[2], vc0[2], vc1[2], vn0[2], vn1[2]; int RA[2]; unsigned CA2[2];
#pragma unroll
    for (int i = 0; i < 2; ++i) { int R, C; stage_rc(tid * 16 + i * 8192, R, C); const int Rb = Epi::PERM ? ((R & ~31) + perm32(R & 31)) : R;
        RA[i] = R; CA2[i] = (unsigned)C * 2u; voffB[i] = F8 ? (unsigned)(Rb * K + 2 * C) : (unsigned)(Rb * K + C) * 2u; }
    const unsigned rowb = F8 ? (unsigned)K : (unsigned)K * 2u;
#define PG8_ROWS(ui_, o0, o1) do { _Pragma("unroll") for (int _i = 0; _i < 2; ++_i) { (o0)[_i] = (unsigned)rowtab[(ui_) * 256 + RA[_i]] * rowb + CA2[_i]; (o1)[_i] = (unsigned)rowtab[(ui_) * 256 + 128 + RA[_i]] * rowb + CA2[_i]; } } while (0)
    const size_t kstep = (size_t)(BK * 2);
    const size_t hstep = F8 ? (size_t)HALF * K : (size_t)HALF * K * 2;
    const size_t tstep = 2 * hstep;
    const unsigned ldsw = (unsigned)wid * 1024u;
    const int aoff = lds_byte(wr * 64 + fr, fq * 8), boff = lds_byte(wc * 32 + fr, fq * 8);
#define PG8_SA(b, h) (((b) * 2 + (h)) * HTB)
#define PG8_SB(b, h) ((4 + (b) * 2 + (h)) * HTB)
#define PG8_STAGE(bufoff, gbase, voff) do { _Pragma("unroll") for (int _i = 0; _i < 2; ++_i) \
        __builtin_amdgcn_global_load_lds((const unsigned*)((const char*)(gbase) + (voff)[_i]), (PG8_LAS unsigned*)(lds + (bufoff) + ldsw + _i * 8192), 16, 0, 0); } while (0)
#define PG8_LD16(off) (*(const PG8_LAS i32x4*)(lds + (off)))
#define PG8_LDA(dst, b, h) do { _Pragma("unroll") for (int m = 0; m < 4; ++m) { const i32x4 lo_ = PG8_LD16(PG8_SA(b, h) + aoff + m * 2048), hi_ = PG8_LD16(PG8_SA(b, h) + aoff + m * 2048 + 1024); \
        dst[m] = (i32x8){lo_[0], lo_[1], lo_[2], lo_[3], hi_[0], hi_[1], hi_[2], hi_[3]}; } } while (0)
#define PG8_LDB(dst, b, h) do { _Pragma("unroll") for (int n = 0; n < 2; ++n) { const i32x4 lo_ = PG8_LD16(PG8_SB(b, h) + boff + n * 2048), hi_ = PG8_LD16(PG8_SB(b, h) + boff + n * 2048 + 1024); \
        dst[n] = (i32x8){lo_[0], lo_[1], lo_[2], lo_[3], hi_[0], hi_[1], hi_[2], hi_[3]}; } } while (0)
#define PG8_MMA(ai, bj, At, Bt) do { __builtin_amdgcn_s_setprio(1); if constexpr (F8) { _Pragma("unroll") for (int m = 0; m < 4; ++m) _Pragma("unroll") for (int n = 0; n < 2; ++n) \
        asm volatile("v_mfma_scale_f32_16x16x128_f8f6f4 %0, %1, %2, %0, %3, %4 op_sel_hi:[0,0,0]" : "+v"(acc[ai][bj][m][n]) : "v"(Bt[n]), "v"(At[m]), "v"(scb_), "v"(sca_)); } else { \
        _Pragma("unroll") for (int m = 0; m < 4; ++m) _Pragma("unroll") for (int n = 0; n < 2; ++n) { \
        acc[ai][bj][m][n] = __builtin_amdgcn_mfma_f32_16x16x32_bf16(lo8(Bt[n]), lo8(At[m]), acc[ai][bj][m][n], 0, 0, 0); \
        acc[ai][bj][m][n] = __builtin_amdgcn_mfma_f32_16x16x32_bf16(hi8(Bt[n]), hi8(At[m]), acc[ai][bj][m][n], 0, 0, 0); } } __builtin_amdgcn_s_setprio(0); } while (0)
#define PG8_WAIT_V(n) asm volatile("s_waitcnt vmcnt(" #n ")" ::: "memory")
#define PG8_WAIT_L(n) asm volatile("s_waitcnt lgkmcnt(" #n ")" ::: "memory")
#define PG8_BAR __builtin_amdgcn_s_barrier()
#define PG8_SCHED __builtin_amdgcn_sched_barrier(0)
    Unit cur, nxt; int ui = 0;
    if (!S.next(0, cur)) return;
    f32x4 acc[2][2][4][2];
#pragma unroll
    for (int a = 0; a < 2; ++a)
#pragma unroll
        for (int b = 0; b < 2; ++b)
#pragma unroll
            for (int m = 0; m < 4; ++m)
#pragma unroll
                for (int n = 0; n < 2; ++n) acc[a][b][m][n] = (f32x4){0.f, 0.f, 0.f, 0.f};
    i32x8 At[4], B0[2], B1[2]; const int sca_ = SCALE_A, scb_ = SCALE_B;
    const char* const cA = (const char*)g.A; PG8_ROWS(0, vc0, vc1); const char* cB = (const char*)g.Bt + (size_t)cur.pn * tstep;
    S.a_ready(cur);
    if constexpr (SP2) {
        PG8_STAGE(PG8_SB(0, 0), cB, voffB); PG8_STAGE(PG8_SB(0, 1), cB + hstep, voffB); PG8_STAGE(PG8_SA(0, 0), cA, vc0); PG8_STAGE(PG8_SA(0, 1), cA, vc1);
        if (wr == 1) PG8_BAR;
        PG8_WAIT_V(2); PG8_BAR;
        PG8_STAGE(PG8_SB(1, 0), cB + kstep, voffB); PG8_STAGE(PG8_SA(1, 0), cA + kstep, vc0); PG8_STAGE(PG8_SB(1, 1), cB + hstep + kstep, voffB);
        PG8_WAIT_V(6); PG8_BAR;
    }
#pragma unroll 1
    for (;;) {
        const bool has_next = S.next(ui + 1, nxt);
        const char* nB = has_next ? (const char*)g.Bt + (size_t)nxt.pn * tstep : cB;
        if (has_next) PG8_ROWS(ui + 1, vn0, vn1); else { vn0[0] = vc0[0]; vn0[1] = vc0[1]; vn1[0] = vc1[0]; vn1[1] = vc1[1]; }
#pragma unroll 1
        for (int t = 0; t < nt; t += 2) {
            const bool last = (t == nt - 2);
            const char* a1 = cA + (size_t)(t + 1) * kstep;
            const char* a2 = last ? cA : cA + (size_t)(t + 2) * kstep; const char* b2 = last ? nB : cB + (size_t)(t + 2) * kstep;
            const unsigned s0_[2] = {last ? vn0[0] : vc0[0], last ? vn0[1] : vc0[1]}, s1_[2] = {last ? vn1[0] : vc1[0], last ? vn1[1] : vc1[1]};
            const char* a3 = a2 + kstep; const char* b3 = b2 + kstep;
            if (last && has_next) S.a_ready(nxt);
            if constexpr (SP2) {
            PG8_LDB(B0, 0, 0); PG8_LDB(B1, 0, 1); PG8_SCHED; PG8_LDA(At, 0, 0); PG8_STAGE(PG8_SA(1, 1), a1, vc1);
            PG8_WAIT_V(8); PG8_WAIT_L(0); PG8_BAR; PG8_MMA(0, 0, At, B0); PG8_MMA(0, 1, At, B1); PG8_BAR; PG8_SCHED;
            PG8_LDA(At, 0, 1); PG8_STAGE(PG8_SB(0, 0), b2, voffB); PG8_STAGE(PG8_SB(0, 1), b2 + hstep, voffB); PG8_STAGE(PG8_SA(0, 0), a2, s0_);
            PG8_WAIT_V(8); PG8_WAIT_L(0); PG8_BAR; PG8_MMA(1, 0, At, B0); PG8_MMA(1, 1, At, B1); PG8_BAR; PG8_SCHED;
            PG8_LDB(B0, 1, 0); PG8_LDB(B1, 1, 1); PG8_SCHED; PG8_LDA(At, 1, 0); PG8_STAGE(PG8_SA(0, 1), a2, s1_);
            PG8_WAIT_V(8); PG8_WAIT_L(0); PG8_BAR; PG8_MMA(0, 0, At, B0); PG8_MMA(0, 1, At, B1); PG8_BAR; PG8_SCHED;
            PG8_LDA(At, 1, 1); PG8_STAGE(PG8_SB(1, 0), b3, voffB); PG8_STAGE(PG8_SB(1, 1), b3 + hstep, voffB); PG8_STAGE(PG8_SA(1, 0), a3, s0_);
            PG8_WAIT_V(8); PG8_WAIT_L(0); PG8_BAR; PG8_MMA(1, 0, At, B0); PG8_MMA(1, 1, At, B1); PG8_BAR; PG8_SCHED;
            }
        }
        if constexpr (F8) asm volatile("s_nop 15\n\ts_nop 7" ::: "memory");
        if constexpr (ALIGN_EPI) { if (wr == 0) PG8_BAR; }
        if constexpr (!Epi::AFTER_DRAIN) { E(acc, cur, wr, wc, fr, fq); S.done(cur); }
        if (!has_next) break;
#pragma unroll
        for (int a = 0; a < 2; ++a)
#pragma unroll
            for (int b = 0; b < 2; ++b)
#pragma unroll
                for (int m = 0; m < 4; ++m)
#pragma unroll
                    for (int n = 0; n < 2; ++n) acc[a][b][m][n] = (f32x4){0.f, 0.f, 0.f, 0.f};
        cur = nxt; cB = nB; ++ui; vc0[0] = vn0[0]; vc0[1] = vn0[1]; vc1[0] = vn1[0]; vc1[1] = vn1[1];
        if constexpr (ALIGN_EPI) { if (wr == 1) PG8_BAR; }
    }
    PG8_WAIT_V(0);
    if constexpr (!ALIGN_EPI) { if (wr == 0) PG8_BAR; }
    PG8_BAR;
    if constexpr (Epi::AFTER_DRAIN) { E.fused(acc, cur, wr, wc, fr, fq, lds, wid, lane); S.done(cur); }
#undef PG8_ROWS
#undef PG8_LD16
#undef PG8_SA
#undef PG8_SB
#undef PG8_STAGE
#undef PG8_LDA
#undef PG8_LDB
#undef PG8_MMA
#undef PG8_WAIT_V
#undef PG8_WAIT_L
#undef PG8_BAR
#undef PG8_SCHED
}
}

#ifndef MK_N_LAUNCHES
#define MK_N_LAUNCHES 1
#endif
constexpr int N_PHASES = 11;
constexpr int NWAVES = 8;
#define GAS __attribute__((address_space(1)))
#define LAS __attribute__((address_space(3)))
typedef unsigned short bf16;
typedef unsigned v4u __attribute__((ext_vector_type(4)));
typedef unsigned v2u __attribute__((ext_vector_type(2)));
typedef float f32x4 __attribute__((ext_vector_type(4)));
typedef float f32x16 __attribute__((ext_vector_type(16)));
typedef short bf16x8 __attribute__((ext_vector_type(8)));
#define LDS_WAIT() asm volatile("s_waitcnt lgkmcnt(0)" ::: "memory")
#define RLX_AGENT __ATOMIC_RELAXED, __HIP_MEMORY_SCOPE_AGENT

constexpr int NB = 8, SEQ = 2048, DM = 1024, CTXL = 256, NTOK = NB * SEQ, NCTX = NB * CTXL, DIN = 2560, NEXP = 32;
constexpr float NORM_EPS = 1e-6f;
enum { I_X = 0, I_C, I_CTX, I_CCTX, I_ADAW, I_ADAB, I_N1G, I_N2G, I_WIN, I_RCW, I_RCB, I_RGWA, I_RGBA, I_RGWX, I_RGBX, I_RGLAM, I_SCW, I_WOUT, I_RGRW, I_RGRB, I_REW, I_REB, I_EWG, I_EWU, I_EWD, I_FNG, N_IN };

constexpr size_t MiB = 1u << 20;
constexpr size_t WS_CTL = 0, CTL_ZERO_BYTES = 1 * MiB;
constexpr size_t WS_MODP = 1 * MiB;
constexpr size_t WS_MOD = 5 * MiB;
constexpr size_t WS_WRT = 5 * MiB + 512 * 1024;
constexpr size_t WS_WRG = 5 * MiB + 768 * 1024;
constexpr size_t WS_WIN = 6 * MiB;
constexpr size_t WS_WOUT = 11 * MiB;
constexpr size_t WS_WGU = 13 * MiB;
constexpr size_t WS_WD = 77 * MiB;
constexpr size_t WS_AGG = 109 * MiB;
constexpr size_t WS_SLOT = 112 * MiB;
constexpr size_t WS_GATEW = 114 * MiB;
constexpr size_t WS_SMAP = 114 * MiB + 256 * 1024;
constexpr size_t WS_RA = 115 * MiB;
constexpr size_t WS_ZC = WS_RA + 80 * MiB;
constexpr size_t WS_RB = 197 * MiB;
constexpr size_t WS_END = 237 * MiB;
constexpr size_t WS_YA = WS_WGU;
constexpr int CW_BAR = 4096;
constexpr int CW_CNT = 16384;
constexpr int RING_BYTES = 131072, LDSCTL_OFF = 133120, TBL_OFF = LDSCTL_OFF + 512, LDS_BYTES = 147456;

__device__ __forceinline__ float bflo(unsigned w) { return __uint_as_float(w << 16); }
__device__ __forceinline__ float bfhi(unsigned w) { return __uint_as_float(w & 0xffff0000u); }
__device__ __forceinline__ unsigned pk2(float lo, float hi) { return pg8::cvt_pk_bf16(lo, hi); }
__device__ __forceinline__ float wave_sum(float v) {
#pragma unroll
    for (int o = 1; o < 64; o <<= 1) v += __shfl_xor(v, o);
    return v;
}

#define XB_TMO      128
#define XB_XCNT(j)  (256  + 64 * (j))
#define XB_XSUB(j)  (1280 + 64 * (j))
#define XB_XGEN(j)  (2304 + 64 * (j))
#define XB_TOP      3328
#define XB_TOPGEN   3392
#define XCD_BAR_WORDS 3456
#define XB_SPIN_CAP (1u << 18)
__device__ __forceinline__ unsigned xb_ld(unsigned* p)              { return __hip_atomic_load(p, __ATOMIC_RELAXED, __HIP_MEMORY_SCOPE_AGENT); }
__device__ __forceinline__ unsigned xb_add(unsigned* p, unsigned v) { return __hip_atomic_fetch_add(p, v, __ATOMIC_RELAXED, __HIP_MEMORY_SCOPE_AGENT); }
__device__ __forceinline__ unsigned xb_xcc_id() { return (unsigned)__builtin_amdgcn_s_getreg((3 << 11) | 20) & 0xFu; }
#define XB_SPIN(cond, bar) do { unsigned _sp = 0; while (cond) { __builtin_amdgcn_s_sleep(1); \
    if ((++_sp & 255u) == 0u) { if (xb_ld(&(bar)[XB_TMO])) break; if (_sp > XB_SPIN_CAP) { atomicAdd(&(bar)[XB_TMO], 1u); break; } } } } while (0)
struct XcdBarrier { unsigned* bar; unsigned x; volatile LAS unsigned* st; };
__device__ __forceinline__ XcdBarrier xcd_barrier_post(unsigned* bar, volatile LAS unsigned* st) {
    XcdBarrier b; b.bar = bar; b.x = xb_xcc_id(); b.st = st;
    if (threadIdx.x == 0) (void)xb_add(&bar[XB_XCNT(b.x)], 1u);
    return b;
}
__device__ __forceinline__ void xcd_barrier_complete(unsigned* bar, unsigned x, unsigned& nloc, unsigned& nx) {
    const unsigned G = gridDim.x * gridDim.y * gridDim.z;
    unsigned sum, cnt, mine, sp = 0u;
    for (;;) {
        sum = 0u; cnt = 0u; mine = 0u;
#pragma unroll
        for (unsigned j = 0; j < 16; ++j) { const unsigned c = xb_ld(&bar[XB_XCNT(j)]); sum += c; cnt += (c > 0u) ? 1u : 0u; mine = (j == x) ? c : mine; }
        if (sum == G) break;
        __builtin_amdgcn_s_sleep(1);
        if ((++sp & 255u) == 0u) { if (xb_ld(&bar[XB_TMO])) break; if (sp > XB_SPIN_CAP) { atomicAdd(&bar[XB_TMO], 1u); break; } }
    }
    nloc = mine > 0u ? mine : 1u; nx = cnt > 0u ? cnt : 1u;
}
__device__ __forceinline__ void xcd_barrier(const XcdBarrier& b) {
    asm volatile("s_waitcnt vmcnt(0)" ::: "memory");
    __syncthreads();
    if (threadIdx.x == 0) {
        unsigned* bar = b.bar;
        __builtin_amdgcn_s_waitcnt(0);
        unsigned nloc = b.st[0], nx = b.st[1];
        if (nloc == 0u) { xcd_barrier_complete(bar, b.x, nloc, nx); b.st[0] = nloc; b.st[1] = nx; }
        const unsigned old = xb_add(&bar[XB_XSUB(b.x)], 1u);
        const unsigned gen = old / nloc;
        if (old + 1u == (gen + 1u) * nloc) {
            __builtin_amdgcn_fence(__ATOMIC_RELEASE, "agent");
            asm volatile("s_waitcnt vmcnt(0)" ::: "memory");
            const unsigned og = xb_add(&bar[XB_TOP], 1u);
            const unsigned tg = og / nx;
            if (og + 1u == (tg + 1u) * nx) xb_add(&bar[XB_TOPGEN], 1u);
            else XB_SPIN(xb_ld(&bar[XB_TOPGEN]) == tg, bar);
            __builtin_amdgcn_fence(__ATOMIC_ACQUIRE, "agent");
            xb_add(&bar[XB_XGEN(b.x)], 1u);
            asm volatile("s_waitcnt vmcnt(0)" ::: "memory");
        } else {
            XB_SPIN(xb_ld(&bar[XB_XGEN(b.x)]) == gen, bar);
            __builtin_amdgcn_fence(__ATOMIC_ACQUIRE, "agent");
            asm volatile("s_waitcnt vmcnt(0)" ::: "memory");
        }
    }
    __syncthreads();
}

struct Args { const float* in[N_IN]; float* out; unsigned char* ws; int ph_lo, ph_hi; };
struct Frame { LAS unsigned char* lds; int tid, lane, wave, G, bid; };

struct TrItem { const float* src; bf16* dst; unsigned char* dst8; int N, KP, f8; };
__device__ __forceinline__ void tr_load(const TrItem& t, f32x4 (&v)[16]) {
#pragma unroll
    for (int i = 0; i < 16; ++i) v[i] = __builtin_nontemporal_load((const f32x4*)(t.src + (size_t)(4 * i) * t.N));
}
__device__ __forceinline__ void tr_finish(const TrItem& t, const f32x4 (&v)[16], LAS float* scr, int lane) {
    const int kq = lane >> 4, nb = 4 * (lane & 15);
#pragma unroll
    for (int i = 0; i < 16; ++i) { const int kk = 4 * i + kq;
        scr[(nb + 0) * 65 + kk] = v[i].x; scr[(nb + 1) * 65 + kk] = v[i].y; scr[(nb + 2) * 65 + kk] = v[i].z; scr[(nb + 3) * 65 + kk] = v[i].w; }
    LDS_WAIT(); asm volatile("" ::: "memory");
    if (t.f8) {
        const int c = lane & 3;
#pragma unroll
        for (int j = 0; j < 4; ++j) { const int n = (lane >> 2) + 16 * j; const LAS float* sp = scr + n * 65 + 16 * c; int o[4];
#pragma unroll
            for (int q = 0; q < 4; ++q) { o[q] = __builtin_amdgcn_cvt_pk_fp8_f32(32.0f * sp[4 * q], 32.0f * sp[4 * q + 1], 0, false); o[q] = __builtin_amdgcn_cvt_pk_fp8_f32(32.0f * sp[4 * q + 2], 32.0f * sp[4 * q + 3], o[q], true); }
            *(v4u*)(t.dst8 + (size_t)(16 * j) * t.KP) = (v4u){(unsigned)o[0], (unsigned)o[1], (unsigned)o[2], (unsigned)o[3]}; }
    } else {
    const int c = lane & 7;
#pragma unroll
    for (int j = 0; j < 8; ++j) { const int n = (lane >> 3) + 8 * j; const LAS float* sp = scr + n * 65 + 8 * c;
        v4u o; o.x = pk2(sp[0], sp[1]); o.y = pk2(sp[2], sp[3]); o.z = pk2(sp[4], sp[5]); o.w = pk2(sp[6], sp[7]);
        *(v4u*)(t.dst + (size_t)(8 * j) * t.KP) = o; }
    }
    LDS_WAIT(); asm volatile("" ::: "memory");
}
__device__ __forceinline__ void gemv_item(const Args& a, int item, LAS float* scr, int lane) {
    const int ks = item / 24, nb = item % 24, k0 = ks * 64, n0 = nb * 256 + 4 * lane;
    const float* cc = a.in[I_C]; const float* cx = a.in[I_CCTX]; const float* W = a.in[I_ADAW];
#pragma unroll
    for (int r = 0; r < 9; ++r) { const float v = r < 8 ? cc[r * 1024 + k0 + lane] : cx[k0 + lane]; scr[r * 64 + lane] = v / (1.0f + __expf(-v)); }
    LDS_WAIT(); asm volatile("" ::: "memory");
    f32x4 acc[9];
#pragma unroll
    for (int r = 0; r < 9; ++r) acc[r] = (f32x4){0.f, 0.f, 0.f, 0.f};
#pragma unroll 16
    for (int kk = 0; kk < 64; ++kk) { const f32x4 w = *(const f32x4*)(W + (size_t)(k0 + kk) * 6144 + n0);
#pragma unroll
        for (int r = 0; r < 9; ++r) acc[r] += scr[r * 64 + kk] * w; }
    float* MODP = (float*)(a.ws + WS_MODP);
#pragma unroll
    for (int r = 0; r < 9; ++r) *(f32x4*)(MODP + ((size_t)ks * 9 + r) * 6144 + n0) = acc[r];
    LDS_WAIT(); asm volatile("" ::: "memory");
}
constexpr int IT_GEMV = 384, IT_WRT = 96;
constexpr int TT_WIN = 16 * 40, TT_WOUT = 16 * 16, TT_RG = 32, TT_GU = 8192, TT_DOWN = 4096, TT_TOTAL = TT_WIN + TT_WOUT + TT_RG + TT_GU + TT_DOWN;
__device__ __forceinline__ TrItem tr_decode(const Args& a, int r, int lane) {
    const float* W; bf16* WT; int N, KP, drow0, k0, n0;
    if (r < TT_WIN) { const int kb = r / 40, nb = r % 40; W = a.in[I_WIN]; WT = (bf16*)(a.ws + WS_WIN); N = 2560; KP = 1024; drow0 = 64 * nb; k0 = 64 * kb; n0 = 64 * nb; }
    else if (r < TT_WIN + TT_WOUT) { const int q = r - TT_WIN, kb = q >> 4, nb = q & 15; W = a.in[I_WOUT]; WT = (bf16*)(a.ws + WS_WOUT); N = 1024; KP = 1024; drow0 = 64 * nb; k0 = 64 * kb; n0 = 64 * nb; }
    else if (r < TT_WIN + TT_WOUT + TT_RG) { const int mat = r - TT_WIN - TT_WOUT, g = mat >> 4, d = (mat >> 3) & 1, h = mat & 7;
        W = (g ? a.in[I_RGWX] : a.in[I_RGWA]) + (size_t)(d * 8 + h) * 4096; WT = (bf16*)(a.ws + WS_WRG); N = 64; KP = 64; drow0 = h * 256 + d * 128 + g * 64; k0 = 0; n0 = 0; }
    else if (r < TT_WIN + TT_WOUT + TT_RG + TT_GU) { int q = r - TT_WIN - TT_WOUT - TT_RG; const int up = q >> 12; q &= 4095; const int e = q >> 7, it2 = q & 127, kb = it2 >> 3, nb = it2 & 7;
        n0 = 64 * nb; k0 = 64 * kb; W = (up ? a.in[I_EWU] : a.in[I_EWG]) + (size_t)e * 524288; WT = (bf16*)(a.ws + WS_WGU); N = 512; KP = 1024; drow0 = e * 1024 + (n0 >> 7) * 256 + up * 128 + (n0 & 127); }
    else { const int q = r - TT_WIN - TT_WOUT - TT_RG - TT_GU, e = q >> 7, it2 = q & 127, kb = it2 >> 4, nb = it2 & 15;
        n0 = 64 * nb; k0 = 64 * kb; W = a.in[I_EWD] + (size_t)e * 524288; WT = (bf16*)(a.ws + WS_WD); N = 1024; KP = 512; drow0 = e * 1024 + n0; }
    TrItem t; t.N = N; t.KP = KP; t.f8 = r >= TT_WIN + TT_WOUT + TT_RG;
    t.src = W + (size_t)(k0 + (lane >> 4)) * N + n0 + 4 * (lane & 15);
    t.dst = WT + (size_t)(drow0 + (lane >> 3)) * KP + k0 + 8 * (lane & 7);
    t.dst8 = (unsigned char*)WT + (size_t)(drow0 + (lane >> 2)) * KP + k0 + 16 * (lane & 3);
    return t;
}
__device__ __forceinline__ void p0_prep(const Args& a, Frame& F) {
    LAS float* scr = (LAS float*)(F.lds + F.wave * 16640);
    const int gw = F.wave * F.G + F.bid, NGW = F.G * NWAVES, lane = F.lane;
    for (int it = gw; it < IT_GEMV + IT_WRT; it += NGW) {
        if (it < IT_GEMV) { gemv_item(a, it, scr, lane); continue; }
        const int r = it - IT_GEMV; const float* rgw = a.in[I_RGRW]; const float* rew = a.in[I_REW]; bf16* WRH = (bf16*)(a.ws + WS_WRT); bf16* WRL = WRH + 49152;
#pragma unroll
        for (int i = 0; i < 8; ++i) { const int idx = r * 512 + lane + 64 * i, j = idx >> 10, k = idx & 1023; const float w = j < 4 ? rgw[k * 4 + j] : j < 36 ? rew[k * 32 + (j - 4)] : 0.0f;
            const unsigned hi = pk2(w, 0.0f) & 0xffffu; const float rem = w - bflo(hi); WRH[idx] = (bf16)hi; WRL[idx] = (bf16)(pk2(rem, 0.0f) & 0xffffu); }
    }
    f32x4 vA[16], vB[16]; TrItem tA, tB;
    int it = gw;
    if (it < TT_TOTAL) { tA = tr_decode(a, TT_TOTAL - 1 - it, lane); tr_load(tA, vA); }
    while (it < TT_TOTAL) {
        int it2 = it + NGW;
        if (it2 < TT_TOTAL) { tB = tr_decode(a, TT_TOTAL - 1 - it2, lane); tr_load(tB, vB); }
        tr_finish(tA, vA, scr, lane);
        it = it2; if (it >= TT_TOTAL) break;
        it2 = it + NGW;
        if (it2 < TT_TOTAL) { tA = tr_decode(a, TT_TOTAL - 1 - it2, lane); tr_load(tA, vA); }
        tr_finish(tB, vB, scr, lane);
        it = it2;
    }
}

__device__ __forceinline__ void norm_row_mod(const float* src, bf16* dst, const LAS float* GS, const LAS float* SH, int lane) {
    const f32x4* xr = (const f32x4*)src + lane; f32x4 v[4]; float ss = 0.f;
#pragma unroll
    for (int j = 0; j < 4; ++j) { v[j] = xr[64 * j]; ss += (v[j].x * v[j].x + v[j].y * v[j].y) + (v[j].z * v[j].z + v[j].w * v[j].w); }
    const float rstd = 1.0f / sqrtf(wave_sum(ss) * (1.0f / 1024.0f) + NORM_EPS);
#pragma unroll
    for (int j = 0; j < 4; ++j) { const f32x4 g = *(const LAS f32x4*)(GS + 4 * lane + 256 * j), s = *(const LAS f32x4*)(SH + 4 * lane + 256 * j);
        const f32x4 y = (v[j] * rstd) * g + s; v2u o; o.x = pk2(y.x, y.y); o.y = pk2(y.z, y.w);
        *(v2u*)(dst + 4 * lane + 256 * j) = o; }
}
__device__ __forceinline__ void p1_norm(const Args& a, Frame& F) {
    const float* MODP = (const float*)(a.ws + WS_MODP); float* MOD = (float*)(a.ws + WS_MOD); bf16* XN = (bf16*)(a.ws + WS_RB);
    const float* adab = a.in[I_ADAB]; const float* n1g = a.in[I_N1G];
    LAS float* GS = (LAS float*)F.lds; LAS float* SH = GS + 1024; LAS float* GSC = GS + 2048; LAS float* SHC = GS + 3072;
    for (int blk = F.bid; blk < 256; blk += F.G) {
        const int b = blk >> 5;
        for (int k = F.tid; k < 1024; k += NWAVES * 64) {
            float s_sh = adab[k], s_sc = adab[1024 + k], c_sh = s_sh, c_sc = s_sc;
#pragma unroll 4
            for (int ks = 0; ks < 16; ++ks) { const float* base = MODP + (size_t)ks * 9 * 6144;
                s_sh += base[b * 6144 + k]; s_sc += base[b * 6144 + 1024 + k]; c_sh += base[8 * 6144 + k]; c_sc += base[8 * 6144 + 1024 + k]; }
            const float g = n1g[k]; GS[k] = g * (1.0f + s_sc); SH[k] = s_sh; GSC[k] = g * (1.0f + c_sc); SHC[k] = c_sh;
        }
        if (F.tid < 216) { const int r = F.tid / 24, n = blk * 24 + F.tid % 24; float s = adab[n];
#pragma unroll 4
            for (int ks = 0; ks < 16; ++ks) s += MODP[((size_t)ks * 9 + r) * 6144 + n];
            MOD[r * 6144 + n] = s; }
        __syncthreads();
#pragma unroll 1
        for (int j = 0; j < 9; ++j) { const bool isctx = j == 8;
            const int row = isctx ? NTOK + blk * 8 + F.wave : blk * 64 + F.wave * 8 + j;
            const float* src = isctx ? a.in[I_CTX] + (size_t)(blk * 8 + F.wave) * 1024 : a.in[I_X] + (size_t)row * 1024;
            norm_row_mod(src, XN + (size_t)row * 1024, isctx ? GSC : GS, isctx ? SHC : SH, F.lane); }
        __syncthreads();
    }
}

__device__ __forceinline__ void ld8(const bf16* p, float (&f)[8]) { const v4u w = *(const v4u*)p;
    f[0] = bflo(w.x); f[1] = bfhi(w.x); f[2] = bflo(w.y); f[3] = bfhi(w.y); f[4] = bflo(w.z); f[5] = bfhi(w.z); f[6] = bflo(w.w); f[7] = bfhi(w.w); }
__device__ __forceinline__ v4u pack8(const float (&f)[8]) { v4u w; w.x = pk2(f[0], f[1]); w.y = pk2(f[2], f[3]); w.z = pk2(f[4], f[5]); w.w = pk2(f[6], f[7]); return w; }

__device__ __forceinline__ void yconv_item(const Args& a, Frame& F, int b, int r) {
    const bf16* Z = (const bf16*)(a.ws + WS_RA); bf16* Y = (bf16*)(a.ws + WS_RB); const float* scw = a.in[I_SCW];
    const int cg = F.tid & 63, c0 = cg * 8; const bool vert = cg >= 32; const int stride = vert ? 64 : 1;
    float wk[3][8];
#pragma unroll
    for (int k = 0; k < 3; ++k)
#pragma unroll
        for (int i = 0; i < 8; ++i) wk[k][i] = scw[k * 512 + c0 + i];
#pragma unroll 2
    for (int j = 0; j < 8; ++j) { const int w = (F.tid >> 6) + 8 * j, t = r * 64 + w;
        float acc[8];
#pragma unroll
        for (int i = 0; i < 8; ++i) acc[i] = 0.f;
#pragma unroll
        for (int k = 0; k < 3; ++k) { const int p = (vert ? r : w) + k - 1; const bool valid = p >= 0 && p < (vert ? 32 : 64);
            const int tn = valid ? t + (k - 1) * stride : t; const bf16* zr = Z + (size_t)(b * SEQ + tn) * DIN;
            float cv[8], vv[8]; ld8(zr + 2048 + c0, cv); ld8(zr + 1024 + c0, vv);
            const float m = valid ? 1.0f : 0.0f;
#pragma unroll
            for (int i = 0; i < 8; ++i) acc[i] += (wk[k][i] * m) * (cv[i] * vv[i]); }
        float bg[8]; ld8(Z + (size_t)(b * SEQ + t) * DIN + 1536 + c0, bg);
#pragma unroll
        for (int i = 0; i < 8; ++i) acc[i] *= bg[i];
        *(v4u*)(Y + (size_t)(b * SEQ + t) * 1024 + 512 + c0) = pack8(acc); }
}

constexpr int SC_XC = 0, SC_AB = 9216, SC_BB = 9216 + 32768, SC_SEG = 9216 + 65536, SC_HALL = SC_SEG + 4096;
template <bool PASS2>
__device__ __forceinline__ void scan_range(const Args& a, Frame& F, int b, int h, int vc0, int nvc) {
    const int tid = F.tid, lane = F.lane, wave = F.wave;
    LAS bf16* XC = (LAS bf16*)(F.lds + SC_XC);
    LAS float* AB = (LAS float*)(F.lds + SC_AB);
    LAS float* BB = (LAS float*)(F.lds + SC_BB);
    LAS float* SEG = (LAS float*)(F.lds + SC_SEG);
    LAS float* HALL = (LAS float*)(F.lds + SC_HALL);
    const bf16* Z = (const bf16*)(a.ws + WS_RA); const bf16* Zc = (const bf16*)(a.ws + WS_ZC);
    const bf16* WrgT = (const bf16*)(a.ws + WS_WRG); float* AGG = (float*)(a.ws + WS_AGG); bf16* Y = (bf16*)(a.ws + WS_RB);
    const int d = wave >> 2, chh = (wave >> 1) & 1, shf = wave & 1, r = lane & 31, hh = lane >> 5;
    bf16x8 br[4], bi[4];
    { const bf16* wr_ = WrgT + (size_t)(h * 256 + d * 128 + chh * 32 + r) * 64 + hh * 8;
#pragma unroll
      for (int ks = 0; ks < 4; ++ks) { br[ks] = *(const bf16x8*)(wr_ + ks * 16); bi[ks] = *(const bf16x8*)(wr_ + 64 * 64 + ks * 16); } }
    const int ch = chh * 32 + r, gch = d * 512 + h * 64 + ch;
    const float ba = a.in[I_RGBA][gch] * -1.4426950408889634f, bx = a.in[I_RGBX][gch] * -1.4426950408889634f;
    const float Kc = -8.0f * 1.4426950408889634f * log1pf(expf(-a.in[I_RGLAM][gch]));
    const int cs = tid >> 3, ig = tid & 7, col = h * 64 + ig * 8;
    float cwv[4][8], cbv[8];
#pragma unroll
    for (int i = 0; i < 8; ++i) { cbv[i] = a.in[I_RCB][col + i];
#pragma unroll
        for (int k = 0; k < 4; ++k) cwv[k][i] = a.in[I_RCW][k * 512 + col + i]; }
    const int d2 = tid >> 8, seg = (tid >> 6) & 3, c = tid & 63;
    if (PASS2 && tid < 128) {
        const int dd = tid >> 6, cc = tid & 63; const float* ag = AGG + ((size_t)b * 36 * 2 + dd) * 1024 + (h * 64 + cc) * 2;
        float pv[36], sv[36];
#pragma unroll
        for (int k = 0; k < 36; ++k) { pv[k] = ag[(size_t)k * 2048]; sv[k] = ag[(size_t)k * 2048 + 1]; }
        float hc = 0.0f;
        if (dd == 0) {
#pragma unroll
            for (int k = 0; k < 36; ++k) { const int t = k - vc0; if (t >= 0 && t < nvc) HALL[(t * 2 + 0) * 64 + cc] = hc; hc = pv[k] * hc + sv[k]; }
        } else {
#pragma unroll
            for (int k = 3; k >= 0; --k) hc = pv[k] * hc + sv[k];
#pragma unroll
            for (int k = 35; k >= 4; --k) { const int t = k - vc0; if (t >= 0 && t < nvc) HALL[(t * 2 + 1) * 64 + cc] = hc; hc = pv[k] * hc + sv[k]; }
        }
    }
    v4u xq[4]; v4u gq = (v4u){0u, 0u, 0u, 0u}, gqn = gq;
    { const int vc = vc0; const bool isctx = vc < 4; const int s0 = isctx ? vc * 64 : (vc - 4) * 64, Ls = isctx ? CTXL : SEQ, pitch = isctx ? 512 : DIN;
      const bf16* src = isctx ? Zc + (size_t)b * CTXL * 512 : Z + (size_t)b * SEQ * DIN;
#pragma unroll
      for (int k = 0; k < 4; ++k) { const int sp = s0 + cs + k - 2; const int spc = (sp >= 0 && sp < Ls) ? sp : s0 + cs; xq[k] = *(const v4u*)(src + (size_t)spc * pitch + col); }
      if (PASS2) gq = *(const v4u*)(Z + ((size_t)b * SEQ + s0 + cs) * DIN + 512 + col); }
#pragma unroll 1
    for (int t = 0; t < nvc; ++t) {
        const int vc = vc0 + t; const bool isctx = vc < 4; const int s0 = isctx ? vc * 64 : (vc - 4) * 64, Ls = isctx ? CTXL : SEQ;
        { float acc[8];
#pragma unroll
          for (int i = 0; i < 8; ++i) acc[i] = cbv[i];
#pragma unroll
          for (int k = 0; k < 4; ++k) { const int sp = s0 + cs + k - 2; const float m = (sp >= 0 && sp < Ls) ? 1.0f : 0.0f;
              const v4u w = xq[k]; const float xv[8] = {bflo(w.x), bfhi(w.x), bflo(w.y), bfhi(w.y), bflo(w.z), bfhi(w.z), bflo(w.w), bfhi(w.w)};
#pragma unroll
              for (int i = 0; i < 8; ++i) acc[i] += (cwv[k][i] * m) * xv[i]; }
          *(LAS v4u*)(XC + cs * 72 + ig * 8) = pack8(acc); }
        if (t + 1 < nvc) { const int vn = vc + 1; const bool cx = vn < 4; const int s0n = cx ? vn * 64 : (vn - 4) * 64, Lsn = cx ? CTXL : SEQ, pitch = cx ? 512 : DIN;
            const bf16* src = cx ? Zc + (size_t)b * CTXL * 512 : Z + (size_t)b * SEQ * DIN;
#pragma unroll
            for (int k = 0; k < 4; ++k) { const int sp = s0n + cs + k - 2; const int spc = (sp >= 0 && sp < Lsn) ? sp : s0n + cs; xq[k] = *(const v4u*)(src + (size_t)spc * pitch + col); }
            if (PASS2) gqn = *(const v4u*)(Z + ((size_t)b * SEQ + s0n + cs) * DIN + 512 + col); }
        __syncthreads();
        { f32x16 accr, acci;
#pragma unroll
          for (int i = 0; i < 16; ++i) { accr[i] = 0.f; acci[i] = 0.f; }
#pragma unroll
          for (int ks = 0; ks < 4; ++ks) {
              const bf16x8 af = *(const LAS bf16x8*)(XC + (shf * 32 + r) * 72 + ks * 16 + hh * 8);
              accr = __builtin_amdgcn_mfma_f32_32x32x16_bf16(af, br[ks], accr, 0, 0, 0);
              acci = __builtin_amdgcn_mfma_f32_32x32x16_bf16(af, bi[ks], acci, 0, 0, 0); }
#pragma unroll
          for (int reg = 0; reg < 16; ++reg) { const int s = shf * 32 + (reg & 3) + 8 * (reg >> 2) + 4 * hh;
              const float rr = __builtin_amdgcn_rcpf(1.0f + __builtin_amdgcn_exp2f(fmaf(accr[reg], -1.4426950408889634f, ba)));
              const float ii = __builtin_amdgcn_rcpf(1.0f + __builtin_amdgcn_exp2f(fmaf(acci[reg], -1.4426950408889634f, bx)));
              const float av = __builtin_amdgcn_exp2f(Kc * rr);
              const float xcv = __uint_as_float((unsigned)XC[s * 72 + ch] << 16);
              const float bv = __builtin_amdgcn_sqrtf(fmaxf(fmaf(-av, av, 1.0f), 0.0f)) * (ii * xcv);
              AB[(d * 64 + s) * 64 + ch] = av; BB[(d * 64 + s) * 64 + ch] = bv; } }
        __syncthreads();
        float av16[16], bv16[16];
        { float P = 1.0f, Sv = 0.0f;
#pragma unroll
          for (int j = 0; j < 16; ++j) { const int vs = seg * 16 + j, s = d2 ? 63 - vs : vs; av16[j] = AB[(d2 * 64 + s) * 64 + c]; bv16[j] = BB[(d2 * 64 + s) * 64 + c]; }
#pragma unroll
          for (int j = 0; j < 16; ++j) { Sv = av16[j] * Sv + bv16[j]; P *= av16[j]; }
          SEG[((d2 * 4 + seg) * 64 + c) * 2 + 0] = P; SEG[((d2 * 4 + seg) * 64 + c) * 2 + 1] = Sv; }
        __syncthreads();
        if (!PASS2) {
            if (seg == 0) { float Pt = 1.0f, St = 0.0f;
#pragma unroll
                for (int k = 0; k < 4; ++k) { const float p = SEG[((d2 * 4 + k) * 64 + c) * 2], sg = SEG[((d2 * 4 + k) * 64 + c) * 2 + 1]; St = p * St + sg; Pt *= p; }
                float* ag = AGG + (((size_t)b * 36 + vc) * 2 + d2) * 1024 + (h * 64 + c) * 2; ag[0] = Pt; ag[1] = St; }
        } else {
            float hv = HALL[(t * 2 + d2) * 64 + c];
            for (int k = 0; k < seg; ++k) { const float p = SEG[((d2 * 4 + k) * 64 + c) * 2], sg = SEG[((d2 * 4 + k) * 64 + c) * 2 + 1]; hv = p * hv + sg; }
#pragma unroll
            for (int j = 0; j < 16; ++j) { const int vs = seg * 16 + j, s = d2 ? 63 - vs : vs; hv = av16[j] * hv + bv16[j]; BB[(d2 * 64 + s) * 64 + c] = hv; }
            __syncthreads();
            { const size_t trow = (size_t)b * SEQ + s0 + cs;
              const float g[8] = {bflo(gq.x), bfhi(gq.x), bflo(gq.y), bfhi(gq.y), bflo(gq.z), bfhi(gq.z), bflo(gq.w), bfhi(gq.w)}; float o[8];
              const f32x4 h0a = *(const LAS f32x4*)(BB + (0 * 64 + cs) * 64 + ig * 8), h0b = *(const LAS f32x4*)(BB + (0 * 64 + cs) * 64 + ig * 8 + 4);
              const f32x4 h1a = *(const LAS f32x4*)(BB + (1 * 64 + cs) * 64 + ig * 8), h1b = *(const LAS f32x4*)(BB + (1 * 64 + cs) * 64 + ig * 8 + 4);
              const float hs[8] = {h0a.x + h1a.x, h0a.y + h1a.y, h0a.z + h1a.z, h0a.w + h1a.w, h0b.x + h1b.x, h0b.y + h1b.y, h0b.z + h1b.z, h0b.w + h1b.w};
#pragma unroll
              for (int i = 0; i < 8; ++i) { const float z = g[i] + 0.044715f * g[i] * g[i] * g[i];
                  const float ge = g[i] * __builtin_amdgcn_rcpf(1.0f + __builtin_amdgcn_exp2f(-1.5957691216057308f * 1.4426950408889634f * z));
                  o[i] = ge * hs[i]; }
              *(v4u*)(Y + trow * 1024 + col) = pack8(o); }
            gq = gqn;
        }
    }
    __syncthreads();
}

template <int CTRL> __device__ __forceinline__ float dppf(float x) { return __builtin_bit_cast(float, __builtin_amdgcn_update_dpp(0, __builtin_bit_cast(int, x), CTRL, 0xF, 0xF, true)); }
__device__ __forceinline__ float xrow_sum(float s) {
    { unsigned a = __builtin_bit_cast(unsigned, s), b = a; asm volatile("v_nop\n\tv_nop\n\tv_permlane16_swap_b32 %0, %1" : "+v"(a), "+v"(b)); s = __builtin_bit_cast(float, a) + __builtin_bit_cast(float, b); }
    { unsigned a = __builtin_bit_cast(unsigned, s), b = a; asm volatile("v_nop\n\tv_nop\n\tv_permlane32_swap_b32 %0, %1" : "+v"(a), "+v"(b)); s = __builtin_bit_cast(float, a) + __builtin_bit_cast(float, b); }
    return s;
}
__device__ __forceinline__ float wave_sum_dpp(float s) {
    s += dppf<0xB1>(s); s += dppf<0x4E>(s); s += dppf<0x141>(s); s += dppf<0x128>(s); return xrow_sum(s);
}
__device__ __forceinline__ float red8(const float (&p)[8], int lane) {
    const bool b2 = lane & 4, e0 = ((lane ^ (lane >> 2)) & 1) != 0, e1 = (((lane >> 1) ^ (lane >> 2)) & 1) != 0;
    float q[4], r2[2];
#pragma unroll
    for (int i = 0; i < 4; ++i) { const float keep = e0 ? p[i + 4] : p[i], send = e0 ? p[i] : p[i + 4]; q[i] = keep + dppf<0xB1>(send); }
#pragma unroll
    for (int i = 0; i < 2; ++i) { const float keep = e1 ? q[i + 2] : q[i], send = e1 ? q[i] : q[i + 2]; r2[i] = keep + dppf<0x4E>(send); }
    float s; { const float keep = b2 ? r2[1] : r2[0], send = b2 ? r2[0] : r2[1]; s = keep + dppf<0x141>(send); }
    s += dppf<0x128>(s);
    return xrow_sum(s);
}
constexpr int P6_AH = 0, P6_AL = 33792, P6_BH = 67584, P6_BL = 92928, P6_PITCH = 264;
__device__ __forceinline__ void p6_route(const Args& a, Frame& F, bool commit) {
    const float* X1 = a.out; const float* MOD = (const float*)(a.ws + WS_MOD); const bf16* WRH = (const bf16*)(a.ws + WS_WRT); const bf16* WRL = WRH + 49152;
    unsigned char* ML = a.ws + WS_RB; int* SLOT = (int*)(a.ws + WS_SLOT); float* GATEW = (float*)(a.ws + WS_GATEW); unsigned* CNT = (unsigned*)(a.ws + WS_CTL) + CW_CNT;
    const float* n2g = a.in[I_N2G]; const float* rgb = a.in[I_RGRB]; const float* reb = a.in[I_REB];
    const int lane = F.lane, tid = F.tid, wave = F.wave;
    LAS bf16* AH = (LAS bf16*)(F.lds + P6_AH); LAS bf16* AL = (LAS bf16*)(F.lds + P6_AL); LAS bf16* BH = (LAS bf16*)(F.lds + P6_BH); LAS bf16* BL = (LAS bf16*)(F.lds + P6_BL);
    LAS float* LGP = (LAS float*)(F.lds + P6_AH);
    const int mblk = wave & 3, kh = wave >> 2, c16 = lane & 15, kq = lane >> 4;
    if (F.bid == 0 && tid < 64) *(v4u*)(ML + (size_t)NTOK * 1024 + tid * 16) = (v4u){0u, 0u, 0u, 0u};
    for (int base = F.bid; base < NTOK / 64; base += F.G) {
        const int row0 = (base * NWAVES + wave) * 8, b = row0 >> 11;
        f32x4 v[8][4]; float ss[8];
#pragma unroll
        for (int r = 0; r < 8; ++r) { ss[r] = 0.f;
#pragma unroll
            for (int j = 0; j < 4; ++j) { v[r][j] = *(const f32x4*)(X1 + (size_t)(row0 + r) * 1024 + 4 * lane + 256 * j);
                ss[r] += (v[r][j].x * v[r][j].x + v[r][j].y * v[r][j].y) + (v[r][j].z * v[r][j].z + v[r][j].w * v[r][j].w); } }
#pragma unroll
        for (int r = 0; r < 8; ++r) ss[r] = 1.0f / sqrtf(wave_sum_dpp(ss[r]) * (1.0f / 1024.0f) + NORM_EPS);
#pragma unroll
        for (int j = 0; j < 4; ++j) { const int col = 4 * lane + 256 * j;
            const f32x4 gn = *(const f32x4*)(n2g + col), sc = *(const f32x4*)(MOD + (size_t)b * 6144 + 4096 + col), sh = *(const f32x4*)(MOD + (size_t)b * 6144 + 3072 + col);
            const f32x4 gs = gn * (sc + 1.0f);
#pragma unroll
            for (int r = 0; r < 8; ++r) { v[r][j] = (v[r][j] * ss[r]) * gs + sh; int o = __builtin_amdgcn_cvt_pk_fp8_f32(4.0f * v[r][j].x, 4.0f * v[r][j].y, 0, false); o = __builtin_amdgcn_cvt_pk_fp8_f32(4.0f * v[r][j].z, 4.0f * v[r][j].w, o, true);
                *(int*)(ML + (size_t)(row0 + r) * 1024 + col) = o; } }
        f32x4 acc[3];
#pragma unroll
        for (int nb = 0; nb < 3; ++nb) acc[nb] = (f32x4){0.f, 0.f, 0.f, 0.f};
        v4u bq[6];
#define P6_BLOAD(j_) do { _Pragma("unroll") for (int i = 0; i < 6; ++i) { const int idx = tid + 512 * i, hl = idx >= 1536 ? 1 : 0, rem = idx - hl * 1536, row = rem >> 5, pc = rem & 31; \
            bq[i] = *(const v4u*)((hl ? WRL : WRH) + row * 1024 + (j_) * 256 + pc * 8); } } while (0)
        P6_BLOAD(0);
#pragma unroll
        for (int j = 0; j < 4; ++j) {
            __syncthreads();
#pragma unroll
            for (int r = 0; r < 8; ++r) { const f32x4 x = v[r][j];
                const unsigned h0 = pk2(x.x, x.y), h1 = pk2(x.z, x.w);
                const unsigned l0 = pk2(x.x - bflo(h0), x.y - bfhi(h0)), l1 = pk2(x.z - bflo(h1), x.w - bfhi(h1));
                *(LAS v2u*)(AH + (wave * 8 + r) * P6_PITCH + 4 * lane) = (v2u){h0, h1}; *(LAS v2u*)(AL + (wave * 8 + r) * P6_PITCH + 4 * lane) = (v2u){l0, l1}; }
#pragma unroll
            for (int i = 0; i < 6; ++i) { const int idx = tid + 512 * i, hl = idx >= 1536 ? 1 : 0, rem = idx - hl * 1536, row = rem >> 5, pc = rem & 31;
                *(LAS v4u*)((hl ? BL : BH) + row * P6_PITCH + pc * 8) = bq[i]; }
            if (j < 3) P6_BLOAD(j + 1);
            __syncthreads();
#pragma unroll
            for (int ks = 0; ks < 4; ++ks) { const int kk = (kh * 4 + ks) * 32 + kq * 8;
                const bf16x8 ah = *(const LAS bf16x8*)(AH + (mblk * 16 + c16) * P6_PITCH + kk), al = *(const LAS bf16x8*)(AL + (mblk * 16 + c16) * P6_PITCH + kk);
#pragma unroll
                for (int nb = 0; nb < 3; ++nb) { const bf16x8 bh = *(const LAS bf16x8*)(BH + (nb * 16 + c16) * P6_PITCH + kk), bl = *(const LAS bf16x8*)(BL + (nb * 16 + c16) * P6_PITCH + kk);
                    acc[nb] = __builtin_amdgcn_mfma_f32_16x16x32_bf16(ah, bh, acc[nb], 0, 0, 0);
                    acc[nb] = __builtin_amdgcn_mfma_f32_16x16x32_bf16(ah, bl, acc[nb], 0, 0, 0);
                    acc[nb] = __builtin_amdgcn_mfma_f32_16x16x32_bf16(al, bh, acc[nb], 0, 0, 0); } }
        }
#undef P6_BLOAD
        __syncthreads();
#pragma unroll
        for (int nb = 0; nb < 3; ++nb)
#pragma unroll
            for (int reg = 0; reg < 4; ++reg) LGP[(kh * 64 + mblk * 16 + 4 * kq + reg) * 48 + nb * 16 + c16] = acc[nb][reg];
        __syncthreads();
        if (tid < 64) {
            float lg[36];
#pragma unroll
            for (int jj = 0; jj < 36; ++jj) lg[jj] = LGP[tid * 48 + jj] + LGP[(64 + tid) * 48 + jj] + (jj < 4 ? rgb[jj] : reb[jj - 4]);
            int grp = 0; float gm = lg[0];
#pragma unroll
            for (int j = 1; j < 4; ++j) if (lg[j] > gm) { gm = lg[j]; grp = j; }
            float gz = 0.f;
#pragma unroll
            for (int j = 0; j < 4; ++j) gz += __expf(lg[j] - gm);
            const float pg = 1.0f / gz;
            float el[8];
#pragma unroll
            for (int i = 0; i < 8; ++i) el[i] = grp == 0 ? lg[4 + i] : grp == 1 ? lg[12 + i] : grp == 2 ? lg[20 + i] : lg[28 + i];
            int i1 = 0; float m1 = el[0];
#pragma unroll
            for (int i = 1; i < 8; ++i) if (el[i] > m1) { m1 = el[i]; i1 = i; }
            int i2 = -1; float m2 = -3.0e38f;
#pragma unroll
            for (int i = 0; i < 8; ++i) if (i != i1 && el[i] > m2) { m2 = el[i]; i2 = i; }
            const float e2 = __expf(m2 - m1), den = 1.0f / (1.0f + e2);
            LAS unsigned* LC = (LAS unsigned*)(F.lds + P6_BH);
            if (tid < 32) LC[tid] = 0u;
            const int ea = grp * 8 + i1, eb = grp * 8 + i2;
            const unsigned la = __hip_atomic_fetch_add(LC + ea, 1u, __ATOMIC_RELAXED, __HIP_MEMORY_SCOPE_WORKGROUP);
            const unsigned lb = __hip_atomic_fetch_add(LC + eb, 1u, __ATOMIC_RELAXED, __HIP_MEMORY_SCOPE_WORKGROUP);
            if (tid < 32) { const unsigned n = LC[tid]; LC[32 + tid] = (n && commit) ? __hip_atomic_fetch_add(CNT + 64 * tid, n, RLX_AGENT) : 0u; }
            if (commit) { const int tok = base * 64 + tid;
                SLOT[ea * 16384 + LC[32 + ea] + la] = tok * 2;     GATEW[tok * 2] = pg * den;
                SLOT[eb * 16384 + LC[32 + eb] + lb] = tok * 2 + 1; GATEW[tok * 2 + 1] = pg * e2 * den; }
        }
    }
    __syncthreads();
}

__device__ __forceinline__ void build_tiles(const Args& a, Frame& F) {
    LAS int* T = (LAS int*)(F.lds + TBL_OFF); unsigned* CNT = (unsigned*)(a.ws + WS_CTL) + CW_CNT;
    if (F.tid < 32) T[F.tid] = (int)__hip_atomic_load(CNT + 64 * F.tid, RLX_AGENT);
    __syncthreads();
    if (F.tid == 0) { int acc = 0;
        for (int e = 0; e < 32; ++e) { const int n = (T[e] + 255) >> 8; T[32 + e] = acc; for (int t = 0; t < n; ++t) T[96 + acc + t] = e; acc += n; }
        T[64] = acc; }
    __syncthreads();
}
constexpr int ROWTAB_OFF = TBL_OFF + 1024;
template <bool GATHER, class Sched>
__device__ __forceinline__ void build_rowtab(const Args& a, Frame& F, const Sched& S) {
    const LAS int* T = (const LAS int*)(F.lds + TBL_OFF); LAS int* RT = (LAS int*)(F.lds + ROWTAB_OFF); const int* SLOT = (const int*)(a.ws + WS_SLOT);
    pg8::Unit u;
    for (int i = 0; i < 4 && S.next(i, u); ++i)
        if (F.tid < 256) { const int e = u.pn >> 2, pos = (u.pm - T[32 + e]) * 256 + F.tid;
            RT[i * 256 + F.tid] = GATHER ? (pos < T[e] ? (SLOT[e * 16384 + pos] >> 1) : NTOK) : u.pm * 256 + F.tid; }
    __syncthreads();
}
__device__ __forceinline__ void p10_final(const Args& a, Frame& F, bool commit) {
    float* X1 = a.out; float* OUT = commit ? a.out : (float*)(a.ws + WS_RA); const float* MOD = (const float*)(a.ws + WS_MOD); const bf16* YA = (const bf16*)(a.ws + WS_YA); const float* fng = a.in[I_FNG];
    const int lane = F.lane;
    for (int t = F.bid * NWAVES + F.wave; t < NTOK; t += F.G * NWAVES) {
        const int b = t >> 11; f32x4 v[4]; float ss = 0.f;
#pragma unroll
        for (int j = 0; j < 4; ++j) { const int col = 4 * lane + 256 * j;
            const f32x4 x = *(const f32x4*)(X1 + (size_t)t * 1024 + col), g2 = *(const f32x4*)(MOD + (size_t)b * 6144 + 5120 + col);
            const v2u ya = *(const v2u*)(YA + (size_t)(2 * t) * 1024 + col), yb = *(const v2u*)(YA + (size_t)(2 * t + 1) * 1024 + col);
            f32x4 y; y.x = bflo(ya.x) + bflo(yb.x); y.y = bfhi(ya.x) + bfhi(yb.x); y.z = bflo(ya.y) + bflo(yb.y); y.w = bfhi(ya.y) + bfhi(yb.y);
            v[j] = x + g2 * y; ss += (v[j].x * v[j].x + v[j].y * v[j].y) + (v[j].z * v[j].z + v[j].w * v[j].w); }
        const float rstd = 1.0f / sqrtf(wave_sum(ss) * (1.0f / 1024.0f) + NORM_EPS);
#pragma unroll
        for (int j = 0; j < 4; ++j) { const int col = 4 * lane + 256 * j; const f32x4 g = *(const f32x4*)(fng + col);
            *(f32x4*)(OUT + (size_t)t * 1024 + col) = (v[j] * rstd) * g; }
    }
}

__global__ void __launch_bounds__(NWAVES * 64, 2) mk_fwd(Args a) {
    extern __shared__ __attribute__((aligned(16))) unsigned char lds_raw[];
    Frame F; F.lds = (LAS unsigned char*)lds_raw; F.tid = threadIdx.x; F.lane = F.tid & 63; F.wave = __builtin_amdgcn_readfirstlane(F.tid >> 6); F.G = gridDim.x; F.bid = blockIdx.x;
    for (int u = F.tid; u < (LDS_BYTES - LDSCTL_OFF) / 4; u += NWAVES * 64) ((LAS unsigned*)(F.lds + LDSCTL_OFF))[u] = 0u;
    __syncthreads();
    const int lo = a.ph_lo, hi = a.ph_hi;
    XcdBarrier bar; bar.bar = (unsigned*)(a.ws + WS_CTL) + CW_BAR; bar.x = 0; bar.st = nullptr;
    if (hi - lo > 1) bar = xcd_barrier_post((unsigned*)(a.ws + WS_CTL) + CW_BAR, (volatile LAS unsigned*)(F.lds + LDSCTL_OFF) + 8);
#ifndef PHMASK
#define PHMASK 0x7ff
#endif
#define IN(k) (((PHMASK >> (k)) & 1) && lo <= (k) && (k) < hi)
#define SEAM(k) do { if (IN(k) && IN((k) + 1)) xcd_barrier(bar); } while (0)
#ifndef PROBE_REP
#define PROBE_REP (-1)
#endif
#ifndef PROBE_N
#define PROBE_N 3
#endif
#ifndef PROBE_T
#define PROBE_T (-1)
#endif
#define TBEG(k) unsigned long long tb_ = 0; if (PROBE_T == (k) || PROBE_T == 99) tb_ = __builtin_amdgcn_s_memrealtime();
#define TEND(k) if (PROBE_T == (k) || PROBE_T == 99) { const unsigned long long te_ = __builtin_amdgcn_s_memrealtime(); while (__builtin_amdgcn_s_memrealtime() - te_ < te_ - tb_) __builtin_amdgcn_s_sleep(8); }
#define REPS(k) for (int rep_ = 0; rep_ < ((PROBE_REP == (k)) ? PROBE_N : 1); ++rep_)

    if (IN(0)) { TBEG(0) REPS(0) { p0_prep(a, F); } TEND(0) } SEAM(0);
    if (IN(1)) { TBEG(1) REPS(1) { p1_norm(a, F); } TEND(1) } SEAM(1);
    if (IN(2)) { TBEG(2) { {
        pg8::Gemm g{(const bf16*)(a.ws + WS_RB), (const bf16*)(a.ws + WS_WIN), NTOK + NCTX, DIN, DM}; pg8::OrderInProj S{F.G, F.bid};
        pg8::EpiInProj E{(bf16*)(a.ws + WS_RA), (bf16*)(a.ws + WS_ZC)};
        pg8::gemm_phase<pg8::EpiInProj, pg8::OrderInProj, true, true>(F.lds, g, S, E); }
    if (PROBE_REP == 2) {
        pg8::Gemm g{(const bf16*)(a.ws + WS_RB), (const bf16*)(a.ws + WS_WIN), NTOK + NCTX, DIN, DM}; pg8::OrderInProj S{F.G, F.bid};
        pg8::EpiInProj E{(bf16*)(a.ws + WS_RA), (bf16*)(a.ws + WS_ZC)};
        pg8::gemm_phase<pg8::EpiInProj, pg8::OrderInProj, true, true>(F.lds, g, S, E); } }
    TEND(2) } SEAM(2);
    if (IN(3)) { TBEG(3) REPS(3) {
        for (int it = F.bid; it < 256; it += F.G) yconv_item(a, F, it >> 5, it & 31);
        for (int w = F.bid; w < 256; w += F.G) { const int bh = w >> 2; scan_range<false>(a, F, bh >> 3, bh & 7, 9 * (w & 3), 9); } }
    TEND(3) } SEAM(3);
    if (IN(4)) { TBEG(4) REPS(4) {
        for (int w = F.bid; w < 256; w += F.G) { const int bh = w >> 2; scan_range<true>(a, F, bh >> 3, bh & 7, 4 + 8 * (w & 3), 8); } }
    TEND(4) } SEAM(4);
    if (IN(5)) { TBEG(5) REPS(5) {
        pg8::Gemm g{(const bf16*)(a.ws + WS_RB), (const bf16*)(a.ws + WS_WOUT), NTOK, DM, DM}; pg8::StaticOrder S; S.init(NTOK, DM, F.G, F.bid);
        pg8::EpiOutProj E{a.in[I_X], a.out, (const float*)(a.ws + WS_MOD)};
        pg8::gemm_phase<pg8::EpiOutProj, pg8::StaticOrder, true, true>(F.lds, g, S, E); }
    TEND(5) } SEAM(5);
    if (IN(6)) { TBEG(6) REPS(6) { p6_route(a, F, rep_ == ((PROBE_REP == 6) ? PROBE_N : 1) - 1); } TEND(6) } if (IN(6) && IN(8)) xcd_barrier(bar);
    if (IN(8)) { TBEG(8) {
        build_tiles(a, F); const LAS int* T = (const LAS int*)(F.lds + TBL_OFF);
        pg8::Gemm g{(const bf16*)(a.ws + WS_RB), (const bf16*)(a.ws + WS_WGU), 0, 0, DM}; pg8::OrderMoE S{F.G, F.bid, T[64] * 4, T + 96};
        build_rowtab<true>(a, F, S);
        pg8::EpiGateUp E{a.ws + WS_RA};
        pg8::gemm_phase_g<pg8::EpiGateUp, pg8::OrderMoE, true, true>(F.lds, g, S, E, (const LAS int*)(F.lds + ROWTAB_OFF));
        if (PROBE_REP == 8) pg8::gemm_phase_g<pg8::EpiGateUp, pg8::OrderMoE, true, true>(F.lds, g, S, E, (const LAS int*)(F.lds + ROWTAB_OFF)); }
    TEND(8) } SEAM(8);
    if (IN(9)) { TBEG(9) {
        build_tiles(a, F); const LAS int* T = (const LAS int*)(F.lds + TBL_OFF);
        pg8::Gemm g{(const bf16*)(a.ws + WS_RA), (const bf16*)(a.ws + WS_WD), 0, 0, 512}; pg8::OrderMoE S{F.G, F.bid, T[64] * 4, T + 96};
        build_rowtab<false>(a, F, S);
        pg8::EpiDown E{(bf16*)(a.ws + WS_YA), (const int*)(a.ws + WS_SLOT), (const float*)(a.ws + WS_GATEW), T};
        pg8::gemm_phase_g<pg8::EpiDown, pg8::OrderMoE, true, true>(F.lds, g, S, E, (const LAS int*)(F.lds + ROWTAB_OFF));
        if (PROBE_REP == 9) pg8::gemm_phase_g<pg8::EpiDown, pg8::OrderMoE, true, true>(F.lds, g, S, E, (const LAS int*)(F.lds + ROWTAB_OFF)); }
    TEND(9) } SEAM(9);
    if (IN(10)) { TBEG(10) REPS(10) { p10_final(a, F, rep_ == ((PROBE_REP == 10) ? PROBE_N : 1) - 1); }
    TEND(10) }
#undef IN
#undef SEAM
}

extern "C" void kernel_launch(void* const* d_in, const int* in_sizes, int n_in, void* d_out, int out_size, void* d_ws, size_t ws_size, hipStream_t stream) {
    static int grid = 0;
    if (grid == 0) {
        if (n_in != N_IN || out_size != NTOK * DM || ws_size < WS_END) { fprintf(stderr, "kernel_launch: unexpected shapes: n_in %d out %d ws %zu (need %zu)\n", n_in, out_size, ws_size, (size_t)WS_END); grid = -1; return; }
        int dev = 0, cus = 0, per_cu = 0;
        if (hipGetDevice(&dev) != hipSuccess || hipDeviceGetAttribute(&cus, hipDeviceAttributeMultiprocessorCount, dev) != hipSuccess) { grid = -1; return; }
        if (hipFuncSetAttribute((const void*)mk_fwd, hipFuncAttributeMaxDynamicSharedMemorySize, LDS_BYTES) != hipSuccess) { fprintf(stderr, "kernel_launch: hipFuncSetAttribute failed\n"); grid = -1; return; }
        if (hipOccupancyMaxActiveBlocksPerMultiprocessor(&per_cu, (const void*)mk_fwd, NWAVES * 64, LDS_BYTES) != hipSuccess || per_cu < 1) { fprintf(stderr, "kernel_launch: occupancy query says %d blocks per CU\n", per_cu); (void)hipGetLastError(); grid = -1; return; }
        grid = cus;
        if (grid > 256) grid = 256;
    }
    if (grid < 0) return;
    (void)hipMemsetAsync((char*)d_ws + WS_CTL, 0, CTL_ZERO_BYTES, stream);
    Args a{};
    for (int i = 0; i < N_IN; ++i) a.in[i] = (const float*)d_in[i];
    a.out = (float*)d_out; a.ws = (unsigned char*)d_ws;
    if (MK_N_LAUNCHES == 1) {
        a.ph_lo = 0; a.ph_hi = N_PHASES;
        void* args[] = {&a};
        hipError_t e = hipLaunchCooperativeKernel((const void*)mk_fwd, dim3(grid), dim3(NWAVES * 64), args, LDS_BYTES, stream);
        if (e != hipSuccess) fprintf(stderr, "kernel_launch: cooperative launch failed: %s (grid %d)\n", hipGetErrorString(e), grid);
    } else {
        for (int p = 0; p < N_PHASES; ++p) { a.ph_lo = p; a.ph_hi = p + 1; hipLaunchKernelGGL(mk_fwd, dim3(grid), dim3(NWAVES * 64), LDS_BYTES, stream, a); }
    }
}
```
